# Optimizing an MI355X kernel written in HIP

```python
import math
import jax, jax.numpy as jnp
from jax import lax
import numpy as np

D_MODEL = 2048
BATCH = 1
SEQ = 16384
DEPTH = 2

Q_BLOCK = 128
A_HEADS = 8
A_QK_DIM = 64
A_V_DIM = 2 * A_QK_DIM
B_HEADS = 8
B_Q_LORA = 512
B_KV_LORA = 512
B_NOPE_DIM = 128
B_ROPE_DIM = 64
B_V_DIM = 128
ROPE_THETA = 10000.0
C_HEADS = 16
C_HEAD_DIM = D_MODEL // C_HEADS
FFN_DIM = 5632
N_EXPERTS = 8
TOP_K = 2
EXPERT_DIM = 5632
EVEN_IN_DIM = 2 * A_HEADS * 2 * A_QK_DIM + A_HEADS * A_V_DIM + B_Q_LORA + B_KV_LORA + B_ROPE_DIM
EVEN_MIX_DIM = A_HEADS * A_V_DIM + B_HEADS * B_V_DIM
ODD_IN_DIM = 3 * C_HEADS * C_HEAD_DIM + C_HEADS
N_EVEN = (DEPTH + 1) // 2
N_ODD = DEPTH // 2

kernel_name = "hybrid_diffattn_mla_fox_moe"


def rms_norm(x, g, eps=1e-6):
    xf = x.astype(jnp.float32)
    y = xf * lax.rsqrt(jnp.mean(xf * xf, axis=-1, keepdims=True) + eps)
    return (y * g.astype(jnp.float32)).astype(x.dtype)


def split_sizes(x, sizes):
    idx, acc = [], 0
    for s in sizes[:-1]:
        acc += s
        idx.append(acc)
    return jnp.split(x, idx, axis=-1)


def rope_tables(seq, dim):
    inv = ROPE_THETA ** (-jnp.arange(0, dim, 2, dtype=jnp.float32) / dim)
    ang = jnp.arange(seq, dtype=jnp.float32)[:, None] * inv[None, :]
    return jnp.cos(ang), jnp.sin(ang)


def apply_rope(x, cos, sin):
    xf = x.astype(jnp.float32)
    x1, x2 = jnp.split(xf, 2, axis=-1)
    return jnp.concatenate([x1 * cos - x2 * sin, x2 * cos + x1 * sin], axis=-1).astype(x.dtype)


def block_offsets(i, seq):
    qpos = i * Q_BLOCK + jnp.arange(Q_BLOCK)
    return qpos[:, None] - jnp.arange(seq)[None, :]


def sweep_query_blocks(block_fn, seq):
    out = lax.map(block_fn, jnp.arange(seq // Q_BLOCK))
    nb, b, qb, h, d = out.shape
    return jnp.moveaxis(out, 0, 1).reshape(b, nb * qb, h, d)


def diff_attention(q, k, v, lam, slopes):
    seq = q.shape[1]
    scale = A_QK_DIM ** -0.5

    def block(i):
        qb = lax.dynamic_slice_in_dim(q, i * Q_BLOCK, Q_BLOCK, axis=1)
        dist = block_offsets(i, seq)
        logits = jnp.einsum('bqhmd,bkhmd->bhmqk', qb, k).astype(jnp.float32) * scale
        logits = logits - slopes[:, None, None, None] * dist.astype(jnp.float32)
        logits = jnp.where(dist >= 0, logits, -jnp.inf)
        p = jax.nn.softmax(logits, axis=-1)
        w = (p[:, :, 0] - lam * p[:, :, 1]).astype(v.dtype)
        return jnp.einsum('bhqk,bkhd->bqhd', w, v)

    return sweep_query_blocks(block, seq)


def mla_attention(q_nope, q_pe, k_nope, k_pe, v):
    seq = q_nope.shape[1]
    scale = (B_NOPE_DIM + B_ROPE_DIM) ** -0.5

    def block(i):
        qn = lax.dynamic_slice_in_dim(q_nope, i * Q_BLOCK, Q_BLOCK, axis=1)
        qp = lax.dynamic_slice_in_dim(q_pe, i * Q_BLOCK, Q_BLOCK, axis=1)
        dist = block_offsets(i, seq)
        logits = (jnp.einsum('bqhd,bkhd->bhqk', qn, k_nope)
                  + jnp.einsum('bqhr,bkr->bhqk', qp, k_pe)).astype(jnp.float32) * scale
        logits = jnp.where(dist >= 0, logits, -jnp.inf)
        p = jax.nn.softmax(logits, axis=-1).astype(v.dtype)
        return jnp.einsum('bhqk,bkhd->bqhd', p, v)

    return sweep_query_blocks(block, seq)


def forgetting_attention(q, k, v, log_f):
    seq = q.shape[1]
    scale = C_HEAD_DIM ** -0.5
    cum = jnp.cumsum(log_f, axis=1).transpose(0, 2, 1)

    def block(i):
        qb = lax.dynamic_slice_in_dim(q, i * Q_BLOCK, Q_BLOCK, axis=1)
        cq = lax.dynamic_slice_in_dim(cum, i * Q_BLOCK, Q_BLOCK, axis=2)
        dist = block_offsets(i, seq)
        logits = jnp.einsum('bqhd,bkhd->bhqk', qb, k).astype(jnp.float32) * scale
        logits = logits + (cq[..., :, None] - cum[..., None, :])
        logits = jnp.where(dist >= 0, logits, -jnp.inf)
        p = jax.nn.softmax(logits, axis=-1).astype(v.dtype)
        return jnp.einsum('bhqk,bkhd->bqhd', p, v)

    return sweep_query_blocks(block, seq)


def even_mixer(h, w_in, q_norm, w_uq, kv_norm, w_ukv, lq1, lk1, lq2, lk2, subln, w_out, lambda_init):
    b, s, _ = h.shape
    proj = h @ w_in
    aq, ak, av, cq, ckv, kpe = split_sizes(
        proj, [A_HEADS * 2 * A_QK_DIM, A_HEADS * 2 * A_QK_DIM, A_HEADS * A_V_DIM,
               B_Q_LORA, B_KV_LORA, B_ROPE_DIM])
    aq = aq.reshape(b, s, A_HEADS, 2, A_QK_DIM)
    ak = ak.reshape(b, s, A_HEADS, 2, A_QK_DIM)
    av = av.reshape(b, s, A_HEADS, A_V_DIM)
    f32 = jnp.float32
    lam = (jnp.exp(jnp.sum(lq1.astype(f32) * lk1.astype(f32)))
           - jnp.exp(jnp.sum(lq2.astype(f32) * lk2.astype(f32))) + lambda_init)
    slopes = jnp.exp2(-8.0 * jnp.arange(1, A_HEADS + 1, dtype=f32) / A_HEADS)
    oa = diff_attention(aq, ak, av, lam, slopes)
    oa = (rms_norm(oa, subln, eps=1e-5) * (1.0 - lambda_init)).reshape(b, s, A_HEADS * A_V_DIM)
    cos, sin = rope_tables(s, B_ROPE_DIM)
    qb = (rms_norm(cq, q_norm) @ w_uq).reshape(b, s, B_HEADS, B_NOPE_DIM + B_ROPE_DIM)
    q_nope, q_pe = jnp.split(qb, [B_NOPE_DIM], axis=-1)
    q_pe = apply_rope(q_pe, cos[None, :, None, :], sin[None, :, None, :])
    kv = (rms_norm(ckv, kv_norm) @ w_ukv).reshape(b, s, B_HEADS, B_NOPE_DIM + B_V_DIM)
    k_nope, vb = jnp.split(kv, [B_NOPE_DIM], axis=-1)
    k_pe = apply_rope(kpe, cos[None], sin[None])
    ob = mla_attention(q_nope, q_pe, k_nope, k_pe, vb).reshape(b, s, B_HEADS * B_V_DIM)
    return jnp.concatenate([oa, ob], axis=-1) @ w_out


def odd_mixer(h, w_in, forget_bias, w_out):
    b, s, _ = h.shape
    proj = h @ w_in
    width = C_HEADS * C_HEAD_DIM
    q, k, v, f = split_sizes(proj, [width, width, width, C_HEADS])
    log_f = jax.nn.log_sigmoid((f + forget_bias).astype(jnp.float32))
    shp = (b, s, C_HEADS, C_HEAD_DIM)
    o = forgetting_attention(q.reshape(shp), k.reshape(shp), v.reshape(shp), log_f)
    return o.reshape(b, s, width) @ w_out


def swiglu(h, w_gate, w_up, w_down):
    return (jax.nn.silu(h @ w_gate) * (h @ w_up)) @ w_down


def moe_swiglu(h, router, w_gate, w_up, w_down):
    logits = (h @ router).astype(jnp.float32)
    probs = jax.nn.softmax(logits, axis=-1)
    top_p, top_i = lax.top_k(probs, TOP_K)
    top_p = top_p / jnp.sum(top_p, axis=-1, keepdims=True)
    gates = jnp.sum(jax.nn.one_hot(top_i, N_EXPERTS, dtype=jnp.float32) * top_p[..., None], axis=-2)
    out = jnp.zeros_like(h)
    for e in range(N_EXPERTS):
        out = out + gates[..., e:e + 1].astype(h.dtype) * swiglu(h, w_gate[e], w_up[e], w_down[e])
    return out


def setup_inputs(seed: int = 0) -> dict:
    key = jax.random.key(seed)
    ks = iter(jax.random.split(key, 32))
    f32 = jnp.float32

    def w(shape, fan_in):
        return jax.random.normal(next(ks), shape, f32) * fan_in ** -0.5

    def gain(shape):
        return 1.0 + 0.02 * jax.random.normal(next(ks), shape, f32)

    E, O, D = N_EVEN, N_ODD, D_MODEL
    return {
        "x": jax.random.normal(next(ks), (BATCH, SEQ, D), f32),
        "ev_attn_norm": gain((E, D)),
        "ev_w_in": w((E, D, EVEN_IN_DIM), D),
        "ev_q_norm": gain((E, B_Q_LORA)),
        "ev_w_uq": w((E, B_Q_LORA, B_HEADS * (B_NOPE_DIM + B_ROPE_DIM)), B_Q_LORA),
        "ev_kv_norm": gain((E, B_KV_LORA)),
        "ev_w_ukv": w((E, B_KV_LORA, B_HEADS * (B_NOPE_DIM + B_V_DIM)), B_KV_LORA),
        "ev_lambda_q1": 0.1 * jax.random.normal(next(ks), (E, A_QK_DIM), f32),
        "ev_lambda_k1": 0.1 * jax.random.normal(next(ks), (E, A_QK_DIM), f32),
        "ev_lambda_q2": 0.1 * jax.random.normal(next(ks), (E, A_QK_DIM), f32),
        "ev_lambda_k2": 0.1 * jax.random.normal(next(ks), (E, A_QK_DIM), f32),
        "ev_subln": gain((E, A_V_DIM)),
        "ev_w_out": w((E, EVEN_MIX_DIM, D), EVEN_MIX_DIM),
        "ev_ffn_norm": gain((E, D)),
        "ev_ffn_w_gate": w((E, D, FFN_DIM), D),
        "ev_ffn_w_up": w((E, D, FFN_DIM), D),
        "ev_ffn_w_down": w((E, FFN_DIM, D), FFN_DIM),
        "od_attn_norm": gain((O, D)),
        "od_w_in": w((O, D, ODD_IN_DIM), D),
        "od_forget_bias": jax.random.uniform(next(ks), (O, C_HEADS), f32, 1.0, 4.0),
        "od_w_out": w((O, C_HEADS * C_HEAD_DIM, D), C_HEADS * C_HEAD_DIM),
        "od_ffn_norm": gain((O, D)),
        "od_router": w((O, D, N_EXPERTS), D),
        "od_moe_w_gate": w((O, N_EXPERTS, D, EXPERT_DIM), D),
        "od_moe_w_up": w((O, N_EXPERTS, D, EXPERT_DIM), D),
        "od_moe_w_down": w((O, N_EXPERTS, EXPERT_DIM, D), EXPERT_DIM),
        "final_norm": gain((D,)),
    }


def reference(x, ev_attn_norm, ev_w_in, ev_q_norm, ev_w_uq, ev_kv_norm, ev_w_ukv,
              ev_lambda_q1, ev_lambda_k1, ev_lambda_q2, ev_lambda_k2, ev_subln, ev_w_out,
              ev_ffn_norm, ev_ffn_w_gate, ev_ffn_w_up, ev_ffn_w_down,
              od_attn_norm, od_w_in, od_forget_bias, od_w_out,
              od_ffn_norm, od_router, od_moe_w_gate, od_moe_w_up, od_moe_w_down,
              final_norm):
    h = x
    for layer in range(DEPTH):
        j = layer // 2
        if layer % 2 == 0:
            lambda_init = 0.8 - 0.6 * math.exp(-0.3 * layer)
            h = h + even_mixer(rms_norm(h, ev_attn_norm[j]), ev_w_in[j], ev_q_norm[j], ev_w_uq[j],
                               ev_kv_norm[j], ev_w_ukv[j], ev_lambda_q1[j], ev_lambda_k1[j],
                               ev_lambda_q2[j], ev_lambda_k2[j], ev_subln[j], ev_w_out[j], lambda_init)
            h = h + swiglu(rms_norm(h, ev_ffn_norm[j]), ev_ffn_w_gate[j], ev_ffn_w_up[j], ev_ffn_w_down[j])
        else:
            h = h + odd_mixer(rms_norm(h, od_attn_norm[j]), od_w_in[j], od_forget_bias[j], od_w_out[j])
            h = h + moe_swiglu(rms_norm(h, od_ffn_norm[j]), od_router[j], od_moe_w_gate[j],
                               od_moe_w_up[j], od_moe_w_down[j])
    return rms_norm(h, final_norm)
```

```cpp
#include <hip/hip_runtime.h>
#include <cstdio>
#include <cstdint>
namespace pg8 {
#define PG8_LAS __attribute__((address_space(3)))
typedef unsigned short bf16_t;
typedef short bf16x8 __attribute__((ext_vector_type(8)));
typedef float f32x4 __attribute__((ext_vector_type(4)));
typedef unsigned u32x4 __attribute__((ext_vector_type(4)));
constexpr int BM = 256, BK = 64, HALF = 128, HTB = HALF * BK * 2  , STAGE_BYTES = 8 * HTB, NXCD = 8, WGM = 8;

__host__ __device__ __forceinline__ int lds_byte(int r, int c) { const int st = (r >> 4) * 2 + (c >> 5), rr = r & 15, cc = c & 31, ob = rr * 64 + cc * 2; return st * 1024 + (ob ^ (((ob >> 9) & 1) << 5)); }
__host__ __device__ __forceinline__ void stage_rc(int b, int& R, int& C) { const int st = b / 1024, sb = b % 1024, swz = sb ^ (((sb >> 9) & 1) << 5); R = (st >> 1) * 16 + swz / 64; C = (st & 1) * 32 + (swz % 64) / 2; }
__host__ __device__ __forceinline__ int perm32(int rho) { const int n = rho >> 4, i = rho & 15; return 8 * (i >> 2) + 4 * n + (i & 3); }

struct Unit { int pm, pn; };
struct Gemm { const bf16_t* A; const bf16_t* Bt; int M, N, K; };

struct StaticOrder {
    int nM, nN, nwg, G, c;
    __host__ __device__ void init(int M, int N, int G_, int c_) { nM = M / BM; nN = N / BM; nwg = nM * nN; G = G_; c = c_; }
    __host__ __device__ bool next(int i, Unit& u) const {
        const long L = (long)i * G + c; if (L >= nwg) return false;
        int wgid = (int)L; { const int q = nwg / NXCD, r = nwg % NXCD, xcd = wgid % NXCD, off = wgid / NXCD; wgid = (xcd < r ? xcd * (q + 1) : r * (q + 1) + (xcd - r) * q) + off; }
        const int nig = WGM * nN, gid = wgid / nig, fm = gid * WGM, gsz = (nM - fm) < WGM ? (nM - fm) : WGM;
        u.pm = fm + ((wgid % nig) % gsz); u.pn = (wgid % nig) / gsz; return true;
    }
    __device__ __forceinline__ void a_ready(const Unit&) const {}
    __device__ __forceinline__ void done(const Unit&) const {}
};

__device__ __forceinline__ unsigned cvt_pk_bf16(float lo, float hi) { unsigned r; asm volatile("v_cvt_pk_bf16_f32 %0, %1, %2" : "=v"(r) : "v"(lo), "v"(hi)); return r; }
typedef float f32x2 __attribute__((ext_vector_type(2)));
__device__ __forceinline__ f32x2 gelu_pk(f32x2 v) {
    const f32x2 av = __builtin_elementwise_abs(v), d = av * 0.2316418882f + 1.0f;
    f32x2 t; t.x = __builtin_amdgcn_rcpf(d.x); t.y = __builtin_amdgcn_rcpf(d.y);
    f32x2 q = t * 0.5307027145f + (-0.7265760135f); q = q * t + 0.7107068705f; q = q * t + (-0.142248368f); q = q * t + 0.127414796f; q = q * t;
    const f32x2 s = (v * v) * (-0.72134752044f);
    f32x2 e; e.x = __builtin_amdgcn_exp2f(s.x); e.y = __builtin_amdgcn_exp2f(s.y);
    const f32x2 m = v * (q * e), r = v - m;
    f32x2 o; o.x = v.x < 0.f ? m.x : r.x; o.y = v.y < 0.f ? m.y : r.y; return o;
}

template <int ACT  > struct EpiBf16 {
    static constexpr bool PERM = true, AFTER_DRAIN = false; static_assert(ACT == 0 || ACT == 1, "EpiBf16: ACT is 0 (none) or 1 (gelu_pk)");
    bf16_t* O; int ldc; const float* bias; int split_cols; size_t split_stride; float scale0;
    __device__ __forceinline__ void operator()(const f32x4 (&acc)[2][2][4][2], const Unit& u, int wr, int wc, int fr, int fq) const {
        const int row0 = u.pm * BM + wr * 64 + fr; int colt = u.pn * BM; bf16_t* base = O;
        float sc = 1.f; if (split_cols) { const int t = colt / split_cols; base += (size_t)t * split_stride; colt -= t * split_cols; if (t == 0) sc = scale0; }
        const int col0 = colt + wc * 32 + 8 * fq, bcol0 = u.pn * BM + wc * 32 + 8 * fq;
        f32x4 bv[2][2];
#pragma unroll
        for (int bj = 0; bj < 2; ++bj)
#pragma unroll
            for (int n = 0; n < 2; ++n) bv[bj][n] = bias ? *(const f32x4*)(bias + bcol0 + bj * HALF + 4 * n) : (f32x4){0.f, 0.f, 0.f, 0.f};
#pragma unroll
        for (int ai = 0; ai < 2; ++ai)
#pragma unroll
            for (int m = 0; m < 4; ++m) { bf16_t* rowp = base + (size_t)(row0 + ai * HALF + m * 16) * ldc + col0;
#pragma unroll
                for (int bj = 0; bj < 2; ++bj) { f32x4 v0 = acc[ai][bj][m][0] + bv[bj][0], v1 = acc[ai][bj][m][1] + bv[bj][1];
                    if (ACT == 1) { f32x2 a = gelu_pk((f32x2){v0[0], v0[1]}), b = gelu_pk((f32x2){v0[2], v0[3]}), c = gelu_pk((f32x2){v1[0], v1[1]}), d = gelu_pk((f32x2){v1[2], v1[3]});
                        v0 = (f32x4){a.x, a.y, b.x, b.y}; v1 = (f32x4){c.x, c.y, d.x, d.y}; }
                    v0 = v0 * sc; v1 = v1 * sc; u32x4 w; w.x = cvt_pk_bf16(v0[0], v0[1]); w.y = cvt_pk_bf16(v0[2], v0[3]); w.z = cvt_pk_bf16(v1[0], v1[1]); w.w = cvt_pk_bf16(v1[2], v1[3]);
                    *(u32x4*)(rowp + bj * HALF) = w; } }
    }
};

template <class Epi, class Sched, bool ALIGN_EPI = false, bool SP2 = false>
__device__ __forceinline__ void gemm_phase(PG8_LAS unsigned char* lds, const Gemm g, const Sched& S, const Epi& E) {
    const int tid = threadIdx.x, wid = __builtin_amdgcn_readfirstlane(tid >> 6), lane = tid & 63, wr = wid >> 2, wc = wid & 3, fr = lane & 15, fq = lane >> 4;
    const int K = g.K, nt = K / BK;
    unsigned voffA[2], voffB[2];
#pragma unroll
    for (int i = 0; i < 2; ++i) { int R, C; stage_rc(tid * 16 + i * 8192, R, C); const int Rb = Epi::PERM ? ((R & ~31) + perm32(R & 31)) : R;
        voffA[i] = (unsigned)(R * K + C) * 2u; voffB[i] = (unsigned)(Rb * K + C) * 2u; }
    const size_t kstep = (size_t)(BK * 2);
    const size_t hstep = (size_t)HALF * K * 2;
    const size_t tstep = 2 * hstep;
    const unsigned ldsw = (unsigned)wid * 1024u;
    const int aoff = lds_byte(wr * 64 + fr, fq * 8), boff = lds_byte(wc * 32 + fr, fq * 8);
#define PG8_SA(b, h) (((b) * 2 + (h)) * HTB)
#define PG8_SB(b, h) ((4 + (b) * 2 + (h)) * HTB)
#define PG8_STAGE(bufoff, gbase, voff) do { _Pragma("unroll") for (int _i = 0; _i < 2; ++_i) \
        __builtin_amdgcn_global_load_lds((const unsigned*)((const char*)(gbase) + (voff)[_i]), (PG8_LAS unsigned*)(lds + (bufoff) + ldsw + _i * 8192), 16, 0, 0); } while (0)
#define PG8_LDA(dst, b, h) do { _Pragma("unroll") for (int m = 0; m < 4; ++m) _Pragma("unroll") for (int k = 0; k < 2; ++k) dst[m][k] = *(const PG8_LAS bf16x8*)(lds + PG8_SA(b, h) + aoff + m * 2048 + k * 1024); } while (0)
#define PG8_LDB(dst, b, h) do { _Pragma("unroll") for (int n = 0; n < 2; ++n) _Pragma("unroll") for (int k = 0; k < 2; ++k) dst[n][k] = *(const PG8_LAS bf16x8*)(lds + PG8_SB(b, h) + boff + n * 2048 + k * 1024); } while (0)
#define PG8_MMA(ai, bj, At, Bt) do { __builtin_amdgcn_s_setprio(1); _Pragma("unroll") for (int m = 0; m < 4; ++m) _Pragma("unroll") for (int n = 0; n < 2; ++n) _Pragma("unroll") for (int k = 0; k < 2; ++k) \
        acc[ai][bj][m][n] = __builtin_amdgcn_mfma_f32_16x16x32_bf16(Bt[n][k], At[m][k], acc[ai][bj][m][n], 0, 0, 0); __builtin_amdgcn_s_setprio(0); } while (0)
#define PG8_WAIT_V(n) asm volatile("s_waitcnt vmcnt(" #n ")" ::: "memory")
#define PG8_WAIT_L(n) asm volatile("s_waitcnt lgkmcnt(" #n ")" ::: "memory")
#define PG8_BAR __builtin_amdgcn_s_barrier()
#define PG8_SCHED __builtin_amdgcn_sched_barrier(0)
    Unit cur, nxt; int ui = 0;
    if (!S.next(0, cur)) return;
    f32x4 acc[2][2][4][2];
#pragma unroll
    for (int a = 0; a < 2; ++a)
#pragma unroll
        for (int b = 0; b < 2; ++b)
#pragma unroll
            for (int m = 0; m < 4; ++m)
#pragma unroll
                for (int n = 0; n < 2; ++n) acc[a][b][m][n] = (f32x4){0.f, 0.f, 0.f, 0.f};
    bf16x8 At[4][2], B0[2][2], B1[2][2];
    const char* cA = (const char*)g.A + (size_t)cur.pm * tstep; const char* cB = (const char*)g.Bt + (size_t)cur.pn * tstep;
    S.a_ready(cur);
    if constexpr (SP2) {
        PG8_STAGE(PG8_SB(0, 0), cB, voffB); PG8_STAGE(PG8_SB(0, 1), cB + hstep, voffB); PG8_STAGE(PG8_SA(0, 0), cA, voffA); PG8_STAGE(PG8_SA(0, 1), cA + hstep, voffA);
        if (wr == 1) PG8_BAR;
        PG8_WAIT_V(2); PG8_BAR;
        PG8_STAGE(PG8_SB(1, 0), cB + kstep, voffB); PG8_STAGE(PG8_SA(1, 0), cA + kstep, voffA); PG8_STAGE(PG8_SB(1, 1), cB + hstep + kstep, voffB);
        PG8_WAIT_V(6); PG8_BAR;
    } else {
        PG8_STAGE(PG8_SB(0, 0), cB, voffB); PG8_STAGE(PG8_SA(0, 0), cA, voffA); PG8_STAGE(PG8_SB(0, 1), cB + hstep, voffB); PG8_STAGE(PG8_SA(0, 1), cA + hstep, voffA);
        if (wr == 1) PG8_BAR;
        PG8_WAIT_V(4); PG8_BAR;
        PG8_STAGE(PG8_SB(1, 0), cB + kstep, voffB); PG8_STAGE(PG8_SA(1, 0), cA + kstep, voffA); PG8_STAGE(PG8_SB(1, 1), cB + hstep + kstep, voffB);
        PG8_WAIT_V(6); PG8_BAR;
    }
    for (;;) {
        const bool has_next = S.next(ui + 1, nxt);
        const char* nA = has_next ? (const char*)g.A + (size_t)nxt.pm * tstep : cA; const char* nB = has_next ? (const char*)g.Bt + (size_t)nxt.pn * tstep : cB;
        for (int t = 0; t < nt; t += 2) {
            const bool last = (t == nt - 2);
            const char* a1 = cA + (size_t)(t + 1) * kstep;
            const char* a2 = last ? nA : cA + (size_t)(t + 2) * kstep; const char* b2 = last ? nB : cB + (size_t)(t + 2) * kstep;
            const char* a3 = a2 + kstep; const char* b3 = b2 + kstep;
            if (last && has_next) S.a_ready(nxt);
            if constexpr (SP2) {
            PG8_LDB(B0, 0, 0); PG8_LDB(B1, 0, 1); PG8_SCHED; PG8_LDA(At, 0, 0); PG8_STAGE(PG8_SA(1, 1), a1 + hstep, voffA);
            PG8_WAIT_V(8); PG8_WAIT_L(0); PG8_BAR; PG8_MMA(0, 0, At, B0); PG8_MMA(0, 1, At, B1); PG8_BAR; PG8_SCHED;
            PG8_LDA(At, 0, 1); PG8_STAGE(PG8_SB(0, 0), b2, voffB); PG8_STAGE(PG8_SB(0, 1), b2 + hstep, voffB); PG8_STAGE(PG8_SA(0, 0), a2, voffA);
            PG8_WAIT_V(8); PG8_WAIT_L(0); PG8_BAR; PG8_MMA(1, 0, At, B0); PG8_MMA(1, 1, At, B1); PG8_BAR; PG8_SCHED;
            PG8_LDB(B0, 1, 0); PG8_LDB(B1, 1, 1); PG8_SCHED; PG8_LDA(At, 1, 0); PG8_STAGE(PG8_SA(0, 1), a2 + hstep, voffA);
            PG8_WAIT_V(8); PG8_WAIT_L(0); PG8_BAR; PG8_MMA(0, 0, At, B0); PG8_MMA(0, 1, At, B1); PG8_BAR; PG8_SCHED;
            PG8_LDA(At, 1, 1); PG8_STAGE(PG8_SB(1, 0), b3, voffB); PG8_STAGE(PG8_SB(1, 1), b3 + hstep, voffB); PG8_STAGE(PG8_SA(1, 0), a3, voffA);
            PG8_WAIT_V(8); PG8_WAIT_L(0); PG8_BAR; PG8_MMA(1, 0, At, B0); PG8_MMA(1, 1, At, B1); PG8_BAR; PG8_SCHED;
            } else {
            PG8_LDB(B0, 0, 0); PG8_SCHED; PG8_LDA(At, 0, 0); PG8_STAGE(PG8_SA(1, 1), a1 + hstep, voffA);
            PG8_WAIT_L(8); PG8_BAR; PG8_WAIT_L(0); PG8_MMA(0, 0, At, B0); PG8_BAR; PG8_SCHED;
            PG8_LDB(B1, 0, 1); PG8_STAGE(PG8_SB(0, 0), b2, voffB);
            PG8_BAR; PG8_WAIT_L(0); PG8_MMA(0, 1, At, B1); PG8_BAR;
            PG8_LDA(At, 0, 1); PG8_STAGE(PG8_SA(0, 0), a2, voffA);
            PG8_BAR; PG8_WAIT_L(0); PG8_MMA(1, 0, At, B0); PG8_BAR; PG8_SCHED;
            PG8_STAGE(PG8_SB(0, 1), b2 + hstep, voffB);
            PG8_WAIT_V(6); PG8_BAR; PG8_MMA(1, 1, At, B1); PG8_BAR;
            PG8_LDB(B0, 1, 0); PG8_SCHED; PG8_LDA(At, 1, 0); PG8_STAGE(PG8_SA(0, 1), a2 + hstep, voffA);
            PG8_WAIT_L(8); PG8_BAR; PG8_WAIT_L(0); PG8_MMA(0, 0, At, B0); PG8_BAR; PG8_SCHED;
            PG8_LDB(B1, 1, 1); PG8_STAGE(PG8_SB(1, 0), b3, voffB);
            PG8_BAR; PG8_WAIT_L(0); PG8_MMA(0, 1, At, B1); PG8_BAR;
            PG8_LDA(At, 1, 1); PG8_STAGE(PG8_SA(1, 0), a3, voffA);
            PG8_BAR; PG8_WAIT_L(0); PG8_MMA(1, 0, At, B0); PG8_BAR; PG8_SCHED;
            PG8_STAGE(PG8_SB(1, 1), b3 + hstep, voffB);
            PG8_WAIT_V(6); PG8_BAR; PG8_MMA(1, 1, At, B1); PG8_BAR;
            }
        }
        if constexpr (ALIGN_EPI) { if (wr == 0) PG8_BAR; }
        if constexpr (!Epi::AFTER_DRAIN) { E(acc, cur, wr, wc, fr, fq); S.done(cur); }
        if (!has_next) break;
#pragma unroll
        for (int a = 0; a < 2; ++a)
#pragma unroll
            for (int b = 0; b < 2; ++b)
#pragma unroll
                for (int m = 0; m < 4; ++m)
#pragma unroll
                    for (int n = 0; n < 2; ++n) acc[a][b][m][n] = (f32x4){0.f, 0.f, 0.f, 0.f};
        cur = nxt; cA = nA; cB = nB; ++ui;
        if constexpr (ALIGN_EPI) { if (wr == 1) PG8_BAR; }
    }
    PG8_WAIT_V(0);
    if constexpr (!ALIGN_EPI) { if (wr == 0) PG8_BAR; }
    PG8_BAR;
    if constexpr (Epi::AFTER_DRAIN) { E.fused(acc, cur, wr, wc, fr, fq, lds, wid, lane); S.done(cur); }
#undef PG8_SA
#undef PG8_SB
#undef PG8_STAGE
#undef PG8_LDA
#undef PG8_LDB
#undef PG8_MMA
#undef PG8_WAIT_V
#undef PG8_WAIT_L
#undef PG8_BAR
#undef PG8_SCHED
}
}
namespace pg8 {
__device__ __forceinline__ u32x4 pack8bf(const f32x4 v0, const f32x4 v1) { u32x4 w; w.x = cvt_pk_bf16(v0[0], v0[1]); w.y = cvt_pk_bf16(v0[2], v0[3]); w.z = cvt_pk_bf16(v1[0], v1[1]); w.w = cvt_pk_bf16(v1[2], v1[3]); return w; }

struct EpiQRope {
    static constexpr bool PERM = true, AFTER_DRAIN = false;
    bf16_t* Qb; const float* cs;
    __device__ __forceinline__ void operator()(const f32x4 (&acc)[2][2][4][2], const Unit& u, int wr, int wc, int fr, int fq) const {
        const int row0 = u.pm * BM + wr * 64 + fr;
        if (u.pn < 4) {
#pragma unroll
            for (int ai = 0; ai < 2; ++ai)
#pragma unroll
                for (int m = 0; m < 4; ++m) { bf16_t* rowp = Qb + (size_t)(row0 + ai * HALF + m * 16) * 1536 + wc * 32 + 8 * fq;
#pragma unroll
                    for (int bj = 0; bj < 2; ++bj) *(u32x4*)(rowp + (2 * u.pn + bj) * 192) = pack8bf(acc[ai][bj][m][0], acc[ai][bj][m][1]); }
        } else {
            const int head = 4 * (u.pn - 4) + wc, i0 = 8 * fq;
#pragma unroll
            for (int ai = 0; ai < 2; ++ai)
#pragma unroll
                for (int m = 0; m < 4; ++m) { const int row = row0 + ai * HALF + m * 16; const float* c = cs + (size_t)row * 64 + i0;
                    const f32x4 c0 = *(const f32x4*)c, c1 = *(const f32x4*)(c + 4), s0 = *(const f32x4*)(c + 32), s1 = *(const f32x4*)(c + 36);
                    const f32x4 x1a = acc[ai][0][m][0], x1b = acc[ai][0][m][1], x2a = acc[ai][1][m][0], x2b = acc[ai][1][m][1];
                    const f32x4 o1a = x1a * c0 - x2a * s0, o1b = x1b * c1 - x2b * s1, o2a = x2a * c0 + x1a * s0, o2b = x2b * c1 + x1b * s1;
                    bf16_t* rowp = Qb + (size_t)row * 1536 + head * 192 + 128 + i0;
                    *(u32x4*)(rowp) = pack8bf(o1a, o1b); *(u32x4*)(rowp + 32) = pack8bf(o2a, o2b); }
        }
    }
};
struct EpiKV {
    static constexpr bool PERM = true, AFTER_DRAIN = false;
    bf16_t* KV;
    __device__ __forceinline__ void operator()(const f32x4 (&acc)[2][2][4][2], const Unit& u, int wr, int wc, int fr, int fq) const {
        const int row0 = u.pm * BM + wr * 64 + fr, d = wc * 32 + 8 * fq;
#pragma unroll
        for (int ai = 0; ai < 2; ++ai)
#pragma unroll
            for (int m = 0; m < 4; ++m) { const size_t row = (size_t)(row0 + ai * HALF + m * 16);
                *(u32x4*)(KV + row * 2560 + u.pn * 320 + d) = pack8bf(acc[ai][0][m][0], acc[ai][0][m][1]);
                *(u32x4*)(KV + row * 2560 + u.pn * 320 + 192 + d) = pack8bf(acc[ai][1][m][0], acc[ai][1][m][1]); }
    }
};
struct EpiResF32 {
    static constexpr bool PERM = false, AFTER_DRAIN = false;
    const float* base; float* out; int ldc;
    __device__ __forceinline__ void operator()(const f32x4 (&acc)[2][2][4][2], const Unit& u, int wr, int wc, int fr, int fq) const {
        const int row0 = u.pm * BM + wr * 64 + fr, col0 = u.pn * BM + wc * 32 + 4 * fq;
#pragma unroll
        for (int ai = 0; ai < 2; ++ai)
#pragma unroll
            for (int m = 0; m < 4; ++m) { const size_t off = (size_t)(row0 + ai * HALF + m * 16) * ldc + col0;
#pragma unroll
                for (int bj = 0; bj < 2; ++bj)
#pragma unroll
                    for (int n = 0; n < 2; ++n) { const f32x4 b = *(const f32x4*)(base + off + bj * HALF + n * 16); *(f32x4*)(out + off + bj * HALF + n * 16) = b + acc[ai][bj][m][n]; }
                if (m & 1) asm volatile("" ::: "memory"); }
    }
};
struct EpiSwiGLU {
    static constexpr bool PERM = true, AFTER_DRAIN = false;
    bf16_t* Hm; int ldh; int ntn;
    __device__ __forceinline__ void operator()(const f32x4 (&acc)[2][2][4][2], const Unit& u, int wr, int wc, int fr, int fq) const {
        const int row0 = u.pm * BM + wr * 64 + fr, col = (u.pn % ntn) * 128 + wc * 32 + 8 * fq;
#pragma unroll
        for (int ai = 0; ai < 2; ++ai)
#pragma unroll
            for (int m = 0; m < 4; ++m) { f32x4 h[2];
#pragma unroll
                for (int n = 0; n < 2; ++n) { const f32x4 g = acc[ai][0][m][n], up = acc[ai][1][m][n];
#pragma unroll
                    for (int e = 0; e < 4; ++e) { const float s = __builtin_amdgcn_rcpf(1.0f + __builtin_amdgcn_exp2f(-1.4426950408889634f * g[e])); h[n][e] = g[e] * s * up[e]; } }
                *(u32x4*)(Hm + (size_t)(row0 + ai * HALF + m * 16) * ldh + col) = pack8bf(h[0], h[1]); }
    }
};
struct EpiQKVF {
    static constexpr bool PERM = true, AFTER_DRAIN = false;
    bf16_t* QKV; float* logf; const float* fbias;
    __device__ __forceinline__ void operator()(const f32x4 (&acc)[2][2][4][2], const Unit& u, int wr, int wc, int fr, int fq) const {
        const int row0 = u.pm * BM + wr * 64 + fr;
        if (u.pn < 24) {
            const int col0 = u.pn * BM + wc * 32 + 8 * fq;
#pragma unroll
            for (int ai = 0; ai < 2; ++ai)
#pragma unroll
                for (int m = 0; m < 4; ++m) { bf16_t* rowp = QKV + (size_t)(row0 + ai * HALF + m * 16) * 6144 + col0;
#pragma unroll
                    for (int bj = 0; bj < 2; ++bj) *(u32x4*)(rowp + bj * HALF) = pack8bf(acc[ai][bj][m][0], acc[ai][bj][m][1]); }
        } else if (wc == 0 && fq < 2) {
            const f32x4 b0 = *(const f32x4*)(fbias + 8 * fq), b1 = *(const f32x4*)(fbias + 8 * fq + 4);
#pragma unroll
            for (int ai = 0; ai < 2; ++ai)
#pragma unroll
                for (int m = 0; m < 4; ++m) { f32x4 v0 = acc[ai][0][m][0] + b0, v1 = acc[ai][0][m][1] + b1;
#pragma unroll
                    for (int e = 0; e < 4; ++e) { v0[e] = fminf(v0[e], 0.f) - log1pf(__expf(-fabsf(v0[e]))); v1[e] = fminf(v1[e], 0.f) - log1pf(__expf(-fabsf(v1[e]))); }
                    float* p = logf + (size_t)(row0 + ai * HALF + m * 16) * 16 + 8 * fq; *(f32x4*)p = v0; *(f32x4*)(p + 4) = v1; }
        }
    }
};
struct EpiMoEDown {
    static constexpr bool PERM = false, AFTER_DRAIN = false;
    float* Y; const float* gate; int ntn;
    __device__ __forceinline__ void operator()(const f32x4 (&acc)[2][2][4][2], const Unit& u, int wr, int wc, int fr, int fq) const {
        const int row0 = u.pm * BM + wr * 64 + fr, col0 = (u.pn % ntn) * BM + wc * 32 + 4 * fq;
#pragma unroll
        for (int ai = 0; ai < 2; ++ai)
#pragma unroll
            for (int m = 0; m < 4; ++m) { const int row = row0 + ai * HALF + m * 16; const float gt = gate[row]; float* rowp = Y + (size_t)row * 2048 + col0;
#pragma unroll
                for (int bj = 0; bj < 2; ++bj)
#pragma unroll
                    for (int n = 0; n < 2; ++n) *(f32x4*)(rowp + bj * HALF + n * 16) = acc[ai][bj][m][n] * gt; }
    }
};
struct GroupedOrder {
    int nN, nwg, G, c, MT, t1, t2, t3, t4, t5, t6, t7;
    __device__ __forceinline__ void init(const unsigned* tot, int nN_, int G_, int c_) {
        int t = 0; nN = nN_; G = G_; c = c_;
        t += (int)((tot[0] + 255u) >> 8); t1 = t; t += (int)((tot[1] + 255u) >> 8); t2 = t; t += (int)((tot[2] + 255u) >> 8); t3 = t; t += (int)((tot[3] + 255u) >> 8); t4 = t;
        t += (int)((tot[4] + 255u) >> 8); t5 = t; t += (int)((tot[5] + 255u) >> 8); t6 = t; t += (int)((tot[6] + 255u) >> 8); t7 = t; t += (int)((tot[7] + 255u) >> 8); MT = t; nwg = MT * nN;
    }
    __device__ __forceinline__ bool next(int i, Unit& u) const {
        const long L = (long)i * G + c; if (L >= nwg) return false;
        int wgid = (int)L; { const int q = nwg / NXCD, r = nwg % NXCD, xcd = wgid % NXCD, off = wgid / NXCD; wgid = (xcd < r ? xcd * (q + 1) : r * (q + 1) + (xcd - r) * q) + off; }
        const int nig = WGM * nN, gid = wgid / nig, fm = gid * WGM, gsz = (MT - fm) < WGM ? (MT - fm) : WGM;
        const int pm = fm + ((wgid % nig) % gsz), pn = (wgid % nig) / gsz;
        const int e = (pm >= t1) + (pm >= t2) + (pm >= t3) + (pm >= t4) + (pm >= t5) + (pm >= t6) + (pm >= t7);
        u.pm = pm; u.pn = e * nN + pn; return true;
    }
    __device__ __forceinline__ void a_ready(const Unit&) const {}
    __device__ __forceinline__ void done(const Unit&) const {}
};
}
#include <cmath>
#define ATT_PV_SPLIT 1
namespace att {
typedef unsigned short bf16_t;
typedef short bf16x8 __attribute__((ext_vector_type(8)));
typedef short s16x4 __attribute__((ext_vector_type(4)));
typedef float f32x16 __attribute__((ext_vector_type(16)));
typedef float f32x4 __attribute__((ext_vector_type(4)));
typedef unsigned u32x4 __attribute__((ext_vector_type(4)));
constexpr int NW = 8, QBLK = 32, KVBLK = 64, QB = NW * QBLK, DV = 128, SHM_V = KVBLK * DV * 2;
constexpr float THR = 8.f;
#define ATT_SBAR() __builtin_amdgcn_sched_barrier(0)
__device__ __forceinline__ int v_st(int k, int c) { const int kk = (k & ~0xC) | ((k & 4) << 1) | ((k & 8) >> 1); return ((kk >> 3) * 4 + (c >> 5)) * 512 + ((kk & 7) * 32 + (c & 31)) * 2; }
__device__ __forceinline__ int v_rd_base(int lane) { return ((lane & 3) << 3) | (((lane >> 2) & 3) << 6) | (((lane >> 4) & 1) << 5) | (((lane >> 5) & 1) << 8); }
constexpr int v_rd_off(int d0, int ks, int half) { return d0 * 512 + ks * 4096 + half * 2048; }
__device__ __forceinline__ int crow(int r, int hi) { return (r & 3) + 8 * (r >> 2) + 4 * hi; }
__device__ __forceinline__ unsigned cvtpk(float lo, float hi) { unsigned r; asm volatile("v_cvt_pk_bf16_f32 %0, %1, %2" : "=v"(r) : "v"(lo), "v"(hi)); return r; }
__device__ __forceinline__ bf16x8 ld8(const bf16_t* p) { return *reinterpret_cast<const bf16x8*>(p); }
__device__ __forceinline__ void mask_tile(f32x16& p0, f32x16& p1, int dq) {
    const float NEG = -__builtin_inff();
#pragma unroll
    for (int r = 0; r < 16; ++r) { const int c = (r & 3) + 8 * (r >> 2); if (dq - c < 0) p0[r] = NEG; if (dq - c - 32 < 0) p1[r] = NEG; }
}
__device__ __forceinline__ void partialSM(f32x16& p0, f32x16& p1, float& m_reg, float& mn, float& alpha, const float SCALE) {
    float pmax = p0[0];
#pragma unroll
    for (int r = 1; r < 16; ++r) pmax = fmaxf(pmax, p0[r]);
#pragma unroll
    for (int r = 0; r < 16; ++r) pmax = fmaxf(pmax, p1[r]);
    { auto rr = __builtin_amdgcn_permlane32_swap(__float_as_uint(pmax), __float_as_uint(pmax), false, false);
      pmax = fmaxf(__uint_as_float(rr[0]), __uint_as_float(rr[1])); }
    const float C2 = 1.4426950408889634f * SCALE;
    if (__builtin_expect(__all((pmax - m_reg) * SCALE <= THR), 1)) { mn = m_reg; alpha = 1.f; }
    else { mn = fmaxf(m_reg, pmax); alpha = __builtin_amdgcn_exp2f((m_reg - mn) * C2); m_reg = mn; }
    const float mnL = -mn * C2;
#pragma unroll
    for (int r = 0; r < 16; ++r) p0[r] = fmaf(p0[r], C2, mnL);
#pragma unroll
    for (int r = 0; r < 16; ++r) p1[r] = fmaf(p1[r], C2, mnL);
#pragma unroll
    for (int r = 0; r < 16; ++r) p0[r] = __builtin_amdgcn_exp2f(p0[r]);
}
__device__ __forceinline__ void finishSM(f32x16& p0, f32x16& p1, float alpha, float& l_reg, bf16x8& pa0, bf16x8& pa1, bf16x8& pa2, bf16x8& pa3) {
#pragma unroll
    for (int r = 0; r < 16; ++r) p1[r] = __builtin_amdgcn_exp2f(p1[r]);
    float ps = 0;
#pragma unroll
    for (int r = 0; r < 16; ++r) ps += p0[r];
#pragma unroll
    for (int r = 0; r < 16; ++r) ps += p1[r];
    { auto rr = __builtin_amdgcn_permlane32_swap(__float_as_uint(ps), __float_as_uint(ps), false, false);
      ps = __uint_as_float(rr[0]) + __uint_as_float(rr[1]); }
    l_reg = l_reg * alpha + ps;
#define ATT_PK4(P, B_, OUT) do { unsigned a0 = cvtpk(P[B_+0], P[B_+1]), a1 = cvtpk(P[B_+2], P[B_+3]);                          \
        unsigned b0 = cvtpk(P[B_+4], P[B_+5]), b1 = cvtpk(P[B_+6], P[B_+7]);                                             \
        auto r0 = __builtin_amdgcn_permlane32_swap(a0, b0, false, false); auto r1 = __builtin_amdgcn_permlane32_swap(a1, b1, false, false); \
        u32x4 w = {r0[0], r1[0], r0[1], r1[1]}; OUT = *reinterpret_cast<bf16x8*>(&w); } while (0)
    ATT_PK4(p0, 0, pa0); ATT_PK4(p0, 8, pa1); ATT_PK4(p1, 0, pa2); ATT_PK4(p1, 8, pa3);
#undef ATT_PK4
}
template <int VB>
__device__ __forceinline__ void pv_tile(f32x16* o, int vb0, bf16x8 pa0, bf16x8 pa1, bf16x8 pa2, bf16x8 pa3) {
#define ATT_TRRD(dst, off) asm volatile("ds_read_b64_tr_b16 %0, %1 offset:%2" : "=&v"(dst) : "v"(vb0), "i"(off) : "memory")
#ifndef ATT_PV_SPLIT
#define ATT_PV_SPLIT 0
#endif
#if ATT_PV_SPLIT
#define ATT_PV_D0(d0) do { s16x4 l0, l1, h0, h1; constexpr int b_ = VB * SHM_V + v_rd_off(d0, 0, 0); \
        ATT_TRRD(l0, b_); ATT_TRRD(h0, b_ + 2048); ATT_TRRD(l1, b_ + 4096); ATT_TRRD(h1, b_ + 6144); \
        asm volatile("s_waitcnt lgkmcnt(0)" ::: "memory"); ATT_SBAR();   \
        o[d0] = __builtin_amdgcn_mfma_f32_32x32x16_bf16(pa0, (bf16x8){l0[0], l0[1], l0[2], l0[3], h0[0], h0[1], h0[2], h0[3]}, o[d0], 0, 0, 0);   \
        o[d0] = __builtin_amdgcn_mfma_f32_32x32x16_bf16(pa1, (bf16x8){l1[0], l1[1], l1[2], l1[3], h1[0], h1[1], h1[2], h1[3]}, o[d0], 0, 0, 0);   \
        ATT_SBAR(); ATT_TRRD(l0, b_ + 8192); ATT_TRRD(h0, b_ + 10240); ATT_TRRD(l1, b_ + 12288); ATT_TRRD(h1, b_ + 14336); \
        asm volatile("s_waitcnt lgkmcnt(0)" ::: "memory"); ATT_SBAR();   \
        o[d0] = __builtin_amdgcn_mfma_f32_32x32x16_bf16(pa2, (bf16x8){l0[0], l0[1], l0[2], l0[3], h0[0], h0[1], h0[2], h0[3]}, o[d0], 0, 0, 0);   \
        o[d0] = __builtin_amdgcn_mfma_f32_32x32x16_bf16(pa3, (bf16x8){l1[0], l1[1], l1[2], l1[3], h1[0], h1[1], h1[2], h1[3]}, o[d0], 0, 0, 0); } while (0)
#else
#define ATT_PV_D0(d0) do { s16x4 l0, l1, l2, l3, h0, h1, h2, h3; constexpr int b_ = VB * SHM_V + v_rd_off(d0, 0, 0); \
        ATT_TRRD(l0, b_); ATT_TRRD(h0, b_ + 2048); ATT_TRRD(l1, b_ + 4096); ATT_TRRD(h1, b_ + 6144); ATT_TRRD(l2, b_ + 8192); ATT_TRRD(h2, b_ + 10240); ATT_TRRD(l3, b_ + 12288); ATT_TRRD(h3, b_ + 14336); \
        asm volatile("s_waitcnt lgkmcnt(0)" ::: "memory"); ATT_SBAR();   \
        o[d0] = __builtin_amdgcn_mfma_f32_32x32x16_bf16(pa0, (bf16x8){l0[0], l0[1], l0[2], l0[3], h0[0], h0[1], h0[2], h0[3]}, o[d0], 0, 0, 0);   \
        o[d0] = __builtin_amdgcn_mfma_f32_32x32x16_bf16(pa1, (bf16x8){l1[0], l1[1], l1[2], l1[3], h1[0], h1[1], h1[2], h1[3]}, o[d0], 0, 0, 0);   \
        o[d0] = __builtin_amdgcn_mfma_f32_32x32x16_bf16(pa2, (bf16x8){l2[0], l2[1], l2[2], l2[3], h2[0], h2[1], h2[2], h2[3]}, o[d0], 0, 0, 0);   \
        o[d0] = __builtin_amdgcn_mfma_f32_32x32x16_bf16(pa3, (bf16x8){l3[0], l3[1], l3[2], l3[3], h3[0], h3[1], h3[2], h3[3]}, o[d0], 0, 0, 0); } while (0)
#endif
    ATT_PV_D0(0); ATT_PV_D0(1); ATT_PV_D0(2); ATT_PV_D0(3);
#undef ATT_PV_D0
#undef ATT_TRRD
}

template <int DQK, int LDQ, int LDKV, int LDO, int BIAS, int QL, class TOut>
struct Body {
    static constexpr int RB = DQK * 2, SHM_K = KVBLK * RB, NKL = (DQK == 192) ? 4 : 2, ND0 = DQK / 16, ND0R = ND0 - QL;
    static constexpr bool TAB = (BIAS == 1 || BIAS == 2);
    static constexpr int OFF_K = 2 * SHM_V, OFF_WS = OFF_K + 2 * SHM_K, OFF_B = OFF_WS + NW * 64 * 4, OFF_Q = OFF_B + 512, LDS_BYTES = OFF_Q + NW * QL * 1024;
    struct Ref { const bf16_t* Q; const bf16_t* K; const bf16_t* V; TOut* O; const float* kb; float bs; int P0, jlo; };
    struct Seam { bf16x8 qr[ND0R > 0 ? ND0R : 1]; bf16x8 qx[QL > 0 ? QL : 1]; bf16x8 st_v0, st_v1; bf16x8 st_k[NKL]; float st_b; };
    template <int KB>
    static __device__ __forceinline__ void qkt(f32x16& p0, f32x16& p1, const char* K_lds, const char* B_lds, const char* Q_lds, int r32, int hi, const bf16x8* qr, float bs, float lb) {
        if (BIAS == 1) { p0 = *reinterpret_cast<const f32x16*>(B_lds + KB * 256 + hi * 128); p1 = *reinterpret_cast<const f32x16*>(B_lds + KB * 256 + hi * 128 + 64); }
        else if (BIAS == 3) {
            const float bs8 = 8.f * bs, bs32 = 32.f * bs;
            p0[0] = lb; p0[1] = p0[0] + bs; p0[2] = p0[1] + bs; p0[3] = p0[2] + bs;
#pragma unroll
            for (int r = 4; r < 16; ++r) p0[r] = p0[r - 4] + bs8;
#pragma unroll
            for (int r = 0; r < 16; ++r) p1[r] = p0[r] + bs32;
        }
        else { p0 = f32x16{}; p1 = f32x16{}; }
        const char* kb[4];
#pragma unroll
        for (int dd = 0; dd < 4; ++dd) kb[dd] = K_lds + KB * SHM_K + r32 * RB + ((dd * 32 + hi * 16) ^ ((r32 & 7) << 4));
#pragma unroll
        for (int d0 = 0; d0 < ND0; ++d0) { const char* a = kb[d0 & 3] + (d0 >> 2) * 128;
            bf16x8 b0 = *reinterpret_cast<const bf16x8*>(a);
            bf16x8 b1 = *reinterpret_cast<const bf16x8*>(a + 32 * RB);
            bf16x8 q; if (d0 < ND0R) q = qr[d0 < ND0R ? d0 : 0]; else q = *reinterpret_cast<const bf16x8*>(Q_lds + (d0 - ND0R) * 1024);
            p0 = __builtin_amdgcn_mfma_f32_32x32x16_bf16(b0, q, p0, 0, 0, 0);
            p1 = __builtin_amdgcn_mfma_f32_32x32x16_bf16(b1, q, p1, 0, 0, 0); }
    }
    static __device__ __forceinline__ void add_bias(f32x16& p0, f32x16& p1, const char* B_lds, int kbuf, int hi) {
#pragma unroll
        for (int g = 0; g < 4; ++g) { const f32x4 b0 = *reinterpret_cast<const f32x4*>(B_lds + kbuf * 256 + hi * 128 + g * 16), b1 = *reinterpret_cast<const f32x4*>(B_lds + kbuf * 256 + hi * 128 + 64 + g * 16);
            p0[4 * g + 0] += b0[0]; p0[4 * g + 1] += b0[1]; p0[4 * g + 2] += b0[2]; p0[4 * g + 3] += b0[3]; p1[4 * g + 0] += b1[0]; p1[4 * g + 1] += b1[1]; p1[4 * g + 2] += b1[2]; p1[4 * g + 3] += b1[3]; }
    }
#define ATT_VMW() asm volatile("s_waitcnt vmcnt(0)" ::: "memory")
#define ATT_VMWN(n) asm volatile("s_waitcnt vmcnt(%0)" :: "i"(n) : "memory")
#define ATT_SLOAD(Kp, Vp, Bp, k0) do { const size_t o_ = (size_t)((k0) + sr) * LDKV + sc; S.st_v0 = ld8((Vp) + o_); S.st_v1 = ld8((Vp) + o_ + 32 * LDKV);              \
        if (DQK >= 128 || sc < 64) { S.st_k[0] = ld8((Kp) + o_); S.st_k[1] = ld8((Kp) + o_ + 32 * LDKV); }                                                             \
        if (DQK == 192) { if (sc < 64) { S.st_k[NKL - 2] = ld8((Kp) + o_ + 128); S.st_k[NKL - 1] = ld8((Kp) + o_ + 32 * LDKV + 128); } }                                \
        if (TAB) { S.st_b = (Bp)[(k0) + lane]; } } while (0)
#define ATT_SWRITE_K(bf) do { if (DQK >= 128 || sc < 64) { *(bf16x8*)(K_lds + (bf) * SHM_K + kws) = S.st_k[0]; *(bf16x8*)(K_lds + (bf) * SHM_K + kws + 32 * RB) = S.st_k[1]; }   \
        if (DQK == 192) { if (sc < 64) { *(bf16x8*)(K_lds + (bf) * SHM_K + kws + 256) = S.st_k[NKL - 2]; *(bf16x8*)(K_lds + (bf) * SHM_K + kws + 32 * RB + 256) = S.st_k[NKL - 1]; } }  \
        if (TAB) { *(float*)(B_lds + (bf) * 256 + bws) = S.st_b; } } while (0)
#define ATT_SWRITE_V(bf) do { *(bf16x8*)(V_lds + (bf) * SHM_V + vst0) = S.st_v0; *(bf16x8*)(V_lds + (bf) * SHM_V + vst1) = S.st_v1; } while (0)
#define ATT_QLOAD(Qp) do { _Pragma("unroll") for (int d0 = 0; d0 < ND0; ++d0) { const bf16x8 t_ = ld8((Qp) + (size_t)(wid * QBLK + r32) * LDQ + d0 * 16 + hi * 8); if (d0 < ND0R) S.qr[d0 < ND0R ? d0 : 0] = t_; else S.qx[d0 >= ND0R ? d0 - ND0R : 0] = t_; } } while (0)
#define ATT_QSPILL() do { if (QL > 0) { _Pragma("unroll") for (int j_ = 0; j_ < QL; ++j_) *(bf16x8*)(Q_lds + j_ * 1024) = S.qx[j_]; } } while (0)
    static __device__ __forceinline__ void prime(const Ref& cur, char* lds, Seam& S) {
        const int tid = threadIdx.x, wid = __builtin_amdgcn_readfirstlane(tid >> 6), lane = tid & 63, r32 = lane & 31, hi = lane >> 5;
        const int sr = tid >> 4, sc = (tid & 15) * 8, kws = sr * RB + (sc >> 6) * 128 + (((sc & 63) * 2) ^ ((sr & 7) << 4));
        const int bws = ((((lane & 31) >> 2) & 1) * 32 + (lane >> 5) * 16 + (lane & 3) + 4 * ((lane & 31) >> 3)) * 4; (void)bws;
        char* K_lds = lds + OFF_K; char* B_lds = lds + OFF_B; (void)B_lds; char* Q_lds = lds + OFF_Q + wid * (QL * 1024) + lane * 16; (void)Q_lds;
        const int kb0 = cur.jlo * KVBLK;
        ATT_QLOAD(cur.Q);
        ATT_SLOAD(cur.K, cur.V, cur.kb, kb0); ATT_VMW(); ATT_SWRITE_K(0); ATT_QSPILL();
        __syncthreads();
    }
    static __device__ __forceinline__ void block(const Ref& cur, const Ref& nxt, char* lds, Seam& S, const float SCALE) {
        const int tid = threadIdx.x, wid = __builtin_amdgcn_readfirstlane(tid >> 6), lane = tid & 63, r32 = lane & 31, hi = lane >> 5;
        const int j_lo = cur.jlo, j_hi = (cur.P0 + QB - 1) / KVBLK + 1;
        const int NT = j_hi - j_lo;
        const int kbn = nxt.jlo * KVBLK;
        const int qlo = cur.P0 + wid * QBLK, qm = qlo + r32 - 4 * hi;
        char* V_lds = lds; char* K_lds = lds + OFF_K; char* B_lds = lds + OFF_B; (void)B_lds; char* Q_lds = lds + OFF_Q + wid * (QL * 1024) + lane * 16; (void)Q_lds;
        float* ws = (float*)(lds + OFF_WS) + wid * 64; float* li_l = ws, * al_l = ws + 32;
        float m_reg = -1e30f, l_reg = 0; f32x16 o[4] = {};
        const int sr = tid >> 4, sc = (tid & 15) * 8, vst0 = v_st(sr, sc), vst1 = v_st(32 + sr, sc);
        const int kws = sr * RB + (sc >> 6) * 128 + (((sc & 63) * 2) ^ ((sr & 7) << 4));
        const int bws = ((((lane & 31) >> 2) & 1) * 32 + (lane >> 5) * 16 + (lane & 3) + 4 * ((lane & 31) >> 3)) * 4; (void)bws;
        const int vb0 = (int)(uintptr_t)V_lds + v_rd_base(lane);
        const bf16_t* Kh = cur.K; const bf16_t* Vh = cur.V; const float* Bh = cur.kb; const float bs = cur.bs; (void)bs;
#define ATT_RESC(a) do { if (__any((a) < 1.f)) { if (hi == 0) al_l[r32] = (a); asm volatile("s_waitcnt lgkmcnt(0)" ::: "memory");              \
                     _Pragma("unroll") for (int d_ = 0; d_ < 4; ++d_) _Pragma("unroll") for (int r = 0; r < 16; ++r) o[d_][r] *= al_l[crow(r, hi)]; } } while (0)
#define ATT_KBASE(t) ((j_lo + (t)) * KVBLK)
#define ATT_LB(t) ((BIAS == 3) ? bs * (float)(ATT_KBASE(t) - cur.P0 + 4 * hi) : 0.f)
#define ATT_MASKT(P0_, P1_, t, KB_) do { const int kb_ = ATT_KBASE(t); if (BIAS == 2) add_bias(P0_, P1_, B_lds, KB_, hi);                              \
        if (kb_ + KVBLK - 1 > qlo) mask_tile(P0_, P1_, qm - kb_); } while (0)
#define ATT_SEAM_K0() do { ATT_VMWN(ND0); ATT_SWRITE_K(0); ATT_SBAR(); } while (0)
        f32x16 pA0, pA1, pB0, pB1; float mnA, mnB, alA, alB; bf16x8 pa0, pa1, pa2, pa3;
        ATT_SWRITE_V(0); ATT_SBAR();
        if (NT > 1) { ATT_SLOAD(Kh, Vh, Bh, ATT_KBASE(1)); }
        ATT_SBAR(); qkt<0>(pA0, pA1, K_lds, B_lds, Q_lds, r32, hi, S.qr, bs, ATT_LB(0));
        ATT_MASKT(pA0, pA1, 0, 0); partialSM(pA0, pA1, m_reg, mnA, alA, SCALE);
        if (NT > 1) { ATT_VMW(); ATT_SWRITE_V(1); ATT_SWRITE_K(1); }
        __syncthreads();
#define ATT_HALF_STEP(PX0, PX1, mnX, alX, PY0, PY1, alY, t, KB, VB, SB) do {                                                      \
        ATT_SBAR(); qkt<KB>(PX0, PX1, K_lds, B_lds, Q_lds, r32, hi, S.qr, bs, ATT_LB(t));                                                    \
        finishSM(PY0, PY1, alY, l_reg, pa0, pa1, pa2, pa3); ATT_SBAR();                                                           \
        if ((t) + 1 < NT) { ATT_SLOAD(Kh, Vh, Bh, ATT_KBASE((t) + 1)); ATT_SBAR(); }                                              \
        pv_tile<VB>(o, vb0, pa0, pa1, pa2, pa3); ATT_MASKT(PX0, PX1, (t), KB); partialSM(PX0, PX1, m_reg, mnX, alX, SCALE);       \
        __syncthreads();                                                                                                      \
        if ((t) + 1 < NT) { ATT_VMW(); ATT_SWRITE_V(SB); ATT_SWRITE_K(SB); }                                                      \
        ATT_RESC(alX); __syncthreads(); } while (0)
        for (int t = 1; t + 1 < NT; t += 2) {
            ATT_HALF_STEP(pB0, pB1, mnB, alB, pA0, pA1, alA, t, 1, 0, 0);
            ATT_HALF_STEP(pA0, pA1, mnA, alA, pB0, pB1, alB, t + 1, 0, 1, 1);
        }
        const bool even = (NT & 1) == 0;
        if (even) { ATT_SBAR(); qkt<1>(pB0, pB1, K_lds, B_lds, Q_lds, r32, hi, S.qr, bs, ATT_LB(NT - 1)); ATT_SBAR(); }
        ATT_SLOAD(nxt.K, nxt.V, nxt.kb, kbn); ATT_SBAR();
        ATT_QLOAD(nxt.Q);
        ATT_SBAR();
        finishSM(pA0, pA1, alA, l_reg, pa0, pa1, pa2, pa3); ATT_SBAR();
        pv_tile<0>(o, vb0, pa0, pa1, pa2, pa3);
        if (even) { ATT_MASKT(pB0, pB1, NT - 1, 1); partialSM(pB0, pB1, m_reg, mnB, alB, SCALE); __syncthreads(); ATT_RESC(alB);
            finishSM(pB0, pB1, alB, l_reg, pa0, pa1, pa2, pa3); ATT_SBAR(); pv_tile<1>(o, vb0, pa0, pa1, pa2, pa3); }
        ATT_SBAR(); ATT_SEAM_K0();
        if (hi == 0) li_l[r32] = l_reg; asm volatile("s_waitcnt lgkmcnt(0)" ::: "memory");
        float rli[16];
#pragma unroll
        for (int r = 0; r < 16; ++r) rli[r] = __builtin_amdgcn_rcpf(li_l[crow(r, hi)]);
        TOut* Ow = cur.O + (size_t)(wid * QBLK) * LDO;
#pragma unroll
        for (int r = 0; r < 16; ++r) { const int orow = crow(r, hi);
#pragma unroll
            for (int d0 = 0; d0 < 4; ++d0) { const float v = o[d0][r] * rli[r];
                if constexpr (sizeof(TOut) == 4) { Ow[(size_t)orow * LDO + d0 * 32 + r32] = v; }
                else { const float vn = __shfl_xor(v, 1);
                       if ((r32 & 1) == 0) *(unsigned*)(Ow + (size_t)orow * LDO + d0 * 32 + r32) = cvtpk(v, vn); } } }
        ATT_QSPILL();
        __syncthreads();
#undef ATT_RESC
#undef ATT_KBASE
#undef ATT_LB
#undef ATT_MASKT
#undef ATT_SEAM_K0
#undef ATT_HALF_STEP
    }
#undef ATT_VMW
#undef ATT_VMWN
#undef ATT_SLOAD
#undef ATT_SWRITE_K
#undef ATT_SWRITE_V
#undef ATT_QLOAD
#undef ATT_QSPILL
};
template <class B, class Dec>
__device__ __forceinline__ void stream(char* lds, int nblk, const Dec& dec, const float scale) {
    if (nblk <= 0) return;
    typename B::Ref cur = dec(0); typename B::Seam S;
    B::prime(cur, lds, S);
    for (int n = 0; n < nblk; ++n) {
        const typename B::Ref nxt = (n + 1 < nblk) ? dec(n + 1) : cur;
        B::block(cur, nxt, lds, S, scale);
        cur = nxt;
    }
}
#undef ATT_SBAR
}
#define GAS __attribute__((address_space(1)))
#define LAS __attribute__((address_space(3)))
typedef unsigned short bf16;
typedef unsigned v4u __attribute__((ext_vector_type(4)));
typedef float f32x4 __attribute__((ext_vector_type(4)));
typedef short bf16x8 __attribute__((ext_vector_type(8)));
typedef GAS unsigned gu32;
typedef GAS unsigned long long gu64;
#define RLX_AGENT __ATOMIC_RELAXED, __HIP_MEMORY_SCOPE_AGENT
#define LDS_WAIT() asm volatile("s_waitcnt lgkmcnt(0)" ::: "memory")
#define VM_WAIT() asm volatile("s_waitcnt vmcnt(0)" ::: "memory")
__device__ __forceinline__ unsigned long long rt() { return __builtin_amdgcn_s_memrealtime(); }
__device__ __forceinline__ unsigned f2bf(float f) { unsigned u = __builtin_bit_cast(unsigned, f); return (u + 0x7fffu + ((u >> 16) & 1u)) >> 16; }
__device__ __forceinline__ unsigned pk2(float lo, float hi) { return f2bf(lo) | (f2bf(hi) << 16); }

#define XB_TMO      128
#define XB_XCNT(j)  (256  + 64 * (j))
#define XB_XSUB(j)  (1280 + 64 * (j))
#define XB_XGEN(j)  (2304 + 64 * (j))
#define XB_TOP      3328
#define XB_TOPGEN   3392
#define XCD_BAR_WORDS 3456
#define XB_SPIN_CAP (1u << 18)

__device__ __forceinline__ unsigned xb_ld(unsigned* p)              { return __hip_atomic_load(p, __ATOMIC_RELAXED, __HIP_MEMORY_SCOPE_AGENT); }
__device__ __forceinline__ unsigned xb_add(unsigned* p, unsigned v) { return __hip_atomic_fetch_add(p, v, __ATOMIC_RELAXED, __HIP_MEMORY_SCOPE_AGENT); }
__device__ __forceinline__ unsigned xb_xcc_id() { return (unsigned)__builtin_amdgcn_s_getreg((3 << 11) | 20) & 0xFu; }
#define XB_SPIN(cond, bar) do { unsigned _sp = 0; while (cond) { __builtin_amdgcn_s_sleep(1); \
    if ((++_sp & 255u) == 0u) { if (xb_ld(&(bar)[XB_TMO])) break; if (_sp > XB_SPIN_CAP) { atomicAdd(&(bar)[XB_TMO], 1u); break; } } } } while (0)

struct XcdBarrier {
    unsigned* bar; unsigned x;
    volatile LAS unsigned* st;
};

__device__ __forceinline__ XcdBarrier xcd_barrier_post(unsigned* bar, volatile LAS unsigned* st) {
    XcdBarrier b; b.bar = bar; b.x = xb_xcc_id(); b.st = st;
    if (threadIdx.x == 0) (void)xb_add(&bar[XB_XCNT(b.x)], 1u);
    return b;
}
__device__ __forceinline__ void xcd_barrier_complete(unsigned* bar, unsigned x, unsigned& nloc, unsigned& nx) {
    const unsigned G = gridDim.x * gridDim.y * gridDim.z;
    unsigned sum, cnt, mine, sp = 0u;
    for (;;) {
        sum = 0u; cnt = 0u; mine = 0u;
#pragma unroll
        for (unsigned j = 0; j < 16; ++j) { const unsigned c = xb_ld(&bar[XB_XCNT(j)]); sum += c; cnt += (c > 0u) ? 1u : 0u; mine = (j == x) ? c : mine; }
        if (sum == G) break;
        __builtin_amdgcn_s_sleep(1);
        if ((++sp & 255u) == 0u) { if (xb_ld(&bar[XB_TMO])) break; if (sp > XB_SPIN_CAP) { atomicAdd(&bar[XB_TMO], 1u); break; } }
    }
    nloc = mine > 0u ? mine : 1u; nx = cnt > 0u ? cnt : 1u;
}

__device__ __forceinline__ void xcd_barrier(const XcdBarrier& b) {
    asm volatile("s_waitcnt vmcnt(0)" ::: "memory");
    __syncthreads();
    if (threadIdx.x == 0) {
        unsigned* bar = b.bar;
        __builtin_amdgcn_s_waitcnt(0);
        unsigned nloc = b.st[0], nx = b.st[1];
        if (nloc == 0u) { xcd_barrier_complete(bar, b.x, nloc, nx); b.st[0] = nloc; b.st[1] = nx; }
        const unsigned old = xb_add(&bar[XB_XSUB(b.x)], 1u);
        const unsigned gen = old / nloc;
        if (old + 1u == (gen + 1u) * nloc) {
            __builtin_amdgcn_fence(__ATOMIC_RELEASE, "agent");
            asm volatile("s_waitcnt vmcnt(0)" ::: "memory");
            const unsigned og = xb_add(&bar[XB_TOP], 1u);
            const unsigned tg = og / nx;
            if (og + 1u == (tg + 1u) * nx) xb_add(&bar[XB_TOPGEN], 1u);
            else XB_SPIN(xb_ld(&bar[XB_TOPGEN]) == tg, bar);
            __builtin_amdgcn_fence(__ATOMIC_ACQUIRE, "agent");
            xb_add(&bar[XB_XGEN(b.x)], 1u);
            asm volatile("s_waitcnt vmcnt(0)" ::: "memory");
        } else {
            XB_SPIN(xb_ld(&bar[XB_XGEN(b.x)]) == gen, bar);
            __builtin_amdgcn_fence(__ATOMIC_ACQUIRE, "agent");
            asm volatile("s_waitcnt vmcnt(0)" ::: "memory");
        }
    }
    __syncthreads();
}
constexpr int NWAVES = 8;
#ifndef MK_PER_PHASE
#define MK_PER_PHASE 0
#endif
constexpr int NPH = 21;

constexpr int S = 16384, DM = 2048, FF = 5632, NE = 8;
constexpr int N_IN0 = 4160, N_IN0P = 4352, N_IN1 = 6160, N_IN1P = 6400;
constexpr float SCALE_A = 0.125f, SCALE_B = 0.07216878364870322f, SCALE_C = 0.08838834764831845f;

constexpr size_t MiB = 1u << 20;
constexpr size_t WS_CTL = 0, CTL_ZERO_BYTES = 1 * MiB;
constexpr size_t WS_ROPE = 1 * MiB, WS_KBA = 5 * MiB, WS_KBC = 6 * MiB, WS_LOGF = 7 * MiB, WS_CSUM = 8 * MiB, WS_ROUTE = 8 * MiB + 512 * 1024, WS_CNTG = 9 * MiB, WS_TOT = 9 * MiB + 64 * 1024,
                 WS_TOKPOS = 9 * MiB + 512 * 1024, WS_GATES = 10 * MiB;
constexpr size_t WS_WIN0 = 16 * MiB, WS_WUQ = 33 * MiB, WS_WUKV = 35 * MiB, WS_WOUT0 = 37 * MiB, WS_WGU0 = 45 * MiB, WS_WD0 = 89 * MiB, WS_WIN1 = 111 * MiB, WS_WOUT1 = 136 * MiB,
                 WS_WGU1 = 144 * MiB, WS_WD1 = 496 * MiB;
constexpr size_t WS_XN = 672 * MiB;
constexpr size_t WS_PROJ0 = 736 * MiB, WS_CQN = 872 * MiB, WS_CKVN = 888 * MiB, WS_KF = 904 * MiB, WS_VB = 952 * MiB, WS_QB = 984 * MiB, WS_OA = 1032 * MiB, WS_MIX = 1160 * MiB, WS_HMID0 = 736 * MiB;
constexpr size_t WS_QKV1 = 736 * MiB, WS_O1 = 928 * MiB, WS_AS = 736 * MiB, WS_HMS = 1024 * MiB, WS_YS = 736 * MiB;
constexpr size_t WS_END = 1398 * MiB;
constexpr int MPAD = 34816;
static_assert(WS_WD1 + (size_t)NE * DM * FF * 2 <= WS_XN && WS_HMS + (size_t)MPAD * FF * 2 <= WS_END && WS_YS + (size_t)MPAD * DM * 4 <= WS_HMS && WS_MIX + (size_t)S * DM * 2 <= WS_END, "d_ws map");
constexpr int CW_TMO = 0, CW_CODE = 1, CW_BAR = 4096;

constexpr int RING_BYTES = 150528;
constexpr int LDSCTL_OFF = RING_BYTES, MISC_OFF = LDSCTL_OFF + 320;
constexpr int LDS_BYTES = RING_BYTES + 512;
static_assert(MISC_OFF + 128 <= LDS_BYTES, "LDS map");

typedef unsigned v2u __attribute__((ext_vector_type(2)));
__device__ __forceinline__ float bflo(unsigned w) { return __builtin_bit_cast(float, w << 16); }
__device__ __forceinline__ float bfhi(unsigned w) { return __builtin_bit_cast(float, w & 0xffff0000u); }
__device__ __forceinline__ float wave_sum(float v) {
#pragma unroll
    for (int o = 1; o < 64; o <<= 1) v += __shfl_xor(v, o);
    return v;
}
__device__ const float ROPE_INV[32] = {1.000000000e+00f, 7.498942614e-01f, 5.623413324e-01f, 4.216965139e-01f, 3.162277639e-01f, 2.371373773e-01f, 1.778279394e-01f, 1.333521307e-01f,
    1.000000015e-01f, 7.498941571e-02f, 5.623413250e-02f, 4.216965288e-02f, 3.162277490e-02f, 2.371373773e-02f, 1.778279431e-02f, 1.333521493e-02f, 9.999999776e-03f, 7.498941850e-03f,
    5.623413250e-03f, 4.216964822e-03f, 3.162277630e-03f, 2.371373586e-03f, 1.778279431e-03f, 1.333521446e-03f, 1.000000047e-03f, 7.498942432e-04f, 5.623413017e-04f, 4.216965172e-04f,
    3.162277571e-04f, 2.371373703e-04f, 1.778279402e-04f, 1.333521504e-04f};

struct Args { const float* in[27]; float* out; unsigned char* ws; int ph_lo, ph_hi; };
enum { I_X = 0, I_EV_ATTN_NORM, I_EV_W_IN, I_EV_Q_NORM, I_EV_W_UQ, I_EV_KV_NORM, I_EV_W_UKV, I_EV_LQ1, I_EV_LK1, I_EV_LQ2, I_EV_LK2, I_EV_SUBLN, I_EV_W_OUT, I_EV_FFN_NORM, I_EV_W_GATE, I_EV_W_UP,
       I_EV_W_DOWN, I_OD_ATTN_NORM, I_OD_W_IN, I_OD_FBIAS, I_OD_W_OUT, I_OD_FFN_NORM, I_OD_ROUTER, I_OD_W_GATE, I_OD_W_UP, I_OD_W_DOWN, I_FINAL_NORM };

__device__ __forceinline__ int rowmap(int type, int n) {
    if (type == 1) return (n >> 7) * 256 + (n & 127);
    if (type == 2) return (n >> 7) * 256 + 128 + (n & 127);
    if (type == 3) { const int h = n / 192, w = n - h * 192; if (w < 128) return h * 128 + w; const int i = w & 31, half = (w - 128) >> 5; return (4 + (h >> 2)) * 256 + half * 128 + (h & 3) * 32 + i; }
    return n;
}
__device__ __forceinline__ void tr_item(const float* W, int K, int N, bf16* WT, int type, LAS float* scr, int kb, int nb, int lane) {
    const int k0 = 64 * kb, n0 = 64 * nb, n4 = (lane & 15) * 4, kq = lane >> 4;
    f32x4 v[16];
#pragma unroll
    for (int j = 0; j < 16; ++j) { const int k = 4 * j + kq; v[j] = (n0 + n4 < N) ? *(const GAS f32x4*)(W + (size_t)(k0 + k) * N + n0 + n4) : (f32x4){0.f, 0.f, 0.f, 0.f}; }
#pragma unroll
    for (int j = 0; j < 16; ++j) { const int k = 4 * j + kq; LAS float* d = scr + k * 65 + n4; d[0] = v[j].x; d[1] = v[j].y; d[2] = v[j].z; d[3] = v[j].w; }
    LDS_WAIT(); asm volatile("" ::: "memory");
    const int c = lane & 7;
#pragma unroll
    for (int i = 0; i < 8; ++i) { const int n = 8 * i + (lane >> 3); const LAS float* s = scr + (8 * c) * 65 + n;
        v4u o; o.x = pk2(s[0 * 65], s[1 * 65]); o.y = pk2(s[2 * 65], s[3 * 65]); o.z = pk2(s[4 * 65], s[5 * 65]); o.w = pk2(s[6 * 65], s[7 * 65]);
        if (n0 + n < ((N + 31) & ~31)) *(GAS v4u*)(WT + (size_t)rowmap(type, n0 + n) * K + k0 + 8 * c) = o; }
    LDS_WAIT(); asm volatile("" ::: "memory");
}
__device__ __forceinline__ void tr_matrix(const float* W, int K, int N, int NS, int rows_per, bf16* WT, int type, LAS float* scr, int gw, int NGW, int lane) {
    const int nbn = (N + 63) / 64, nbk = K / 64, per = nbn * nbk, total = per * NS;
    for (int it = gw; it < total; it += NGW) { const int s = it / per, r = it - s * per, kb = r / nbn, nb = r - kb * nbn;
        tr_item(W + (size_t)s * K * N, K, N, WT + (size_t)s * rows_per * K, type, scr, kb, nb, lane); }
}
__device__ __forceinline__ void rms_row_bf16(const float* xrow, const float* g, bf16* orow, float eps, int lane) {
    const GAS f32x4* xr = (const GAS f32x4*)xrow + lane; const GAS f32x4* gr = (const GAS f32x4*)g + lane;
    f32x4 v[8]; float s = 0.f;
#pragma unroll
    for (int j = 0; j < 8; ++j) { v[j] = xr[64 * j]; s += (v[j].x * v[j].x + v[j].y * v[j].y) + (v[j].z * v[j].z + v[j].w * v[j].w); }
    const float rstd = 1.0f / sqrtf(wave_sum(s) * (1.f / DM) + eps);
    GAS unsigned long long* o8 = (GAS unsigned long long*)orow + lane;
#pragma unroll
    for (int j = 0; j < 8; ++j) { const f32x4 gg = gr[64 * j]; const f32x4 y = (v[j] * rstd) * gg; o8[64 * j] = (unsigned long long)pk2(y.x, y.y) | ((unsigned long long)pk2(y.z, y.w) << 32); }
}
__device__ __forceinline__ void rms512_bf16(const bf16* src, const float* g, bf16* dst, int lane) {
    const v4u raw = *(const GAS v4u*)(src + 8 * lane);
    float x[8] = {bflo(raw.x), bfhi(raw.x), bflo(raw.y), bfhi(raw.y), bflo(raw.z), bfhi(raw.z), bflo(raw.w), bfhi(raw.w)};
    float s = 0.f;
#pragma unroll
    for (int e = 0; e < 8; ++e) s += x[e] * x[e];
    const float rstd = 1.0f / sqrtf(wave_sum(s) * (1.f / 512.f) + 1e-6f);
    const f32x4 g0 = *(const GAS f32x4*)(g + 8 * lane), g1 = *(const GAS f32x4*)(g + 8 * lane + 4);
    v4u o; o.x = pk2(x[0] * rstd * g0.x, x[1] * rstd * g0.y); o.y = pk2(x[2] * rstd * g0.z, x[3] * rstd * g0.w); o.z = pk2(x[4] * rstd * g1.x, x[5] * rstd * g1.y); o.w = pk2(x[6] * rstd * g1.z, x[7] * rstd * g1.w);
    *(GAS v4u*)(dst + 8 * lane) = o;
}
__device__ __forceinline__ void sincos_d(float ang, float& sn, float& cs) {
    const double t0 = (double)ang * 0.15915494309189535; const double t = t0 - __builtin_rint(t0); const double x = t * 6.283185307179586, x2 = x * x;
    double sp = -1.0 / 51090942171709440000.0;
    sp = sp * x2 + 1.0 / 121645100408832000.0; sp = sp * x2 - 1.0 / 355687428096000.0; sp = sp * x2 + 1.0 / 1307674368000.0; sp = sp * x2 - 1.0 / 6227020800.0; sp = sp * x2 + 1.0 / 39916800.0;
    sp = sp * x2 - 1.0 / 362880.0; sp = sp * x2 + 1.0 / 5040.0; sp = sp * x2 - 1.0 / 120.0; sp = sp * x2 + 1.0 / 6.0; sp = sp * x2 - 1.0; sn = (float)(-sp * x);
    double cp = 1.0 / 1124000727777607680000.0;
    cp = cp * x2 - 1.0 / 2432902008176640000.0; cp = cp * x2 + 1.0 / 6402373705728000.0; cp = cp * x2 - 1.0 / 20922789888000.0; cp = cp * x2 + 1.0 / 87178291200.0; cp = cp * x2 - 1.0 / 479001600.0;
    cp = cp * x2 + 1.0 / 3628800.0; cp = cp * x2 - 1.0 / 40320.0; cp = cp * x2 + 1.0 / 720.0; cp = cp * x2 - 1.0 / 24.0; cp = cp * x2 + 0.5; cp = cp * x2 - 1.0; cs = (float)(-cp);
}

typedef att::Body<64, N_IN0P, N_IN0P, 2048, 3, 0, float> BodyA;
typedef att::Body<192, 1536, 2560, 2048, 0, 8, bf16> BodyB;
typedef att::Body<128, 6144, 6144, 2048, 1, 4, bf16> BodyC;
struct DecA { const bf16* proj; float* OA; int vcu, G;
    __device__ __forceinline__ BodyA::Ref operator()(int n) const { const int it = vcu + (n >> 2) * G, sub = n & 3, h = it >> 5, x = it & 31, qb = (sub < 2) ? x : 63 - x, vh = 2 * h + (sub & 1);
        BodyA::Ref r; r.Q = proj + (size_t)(qb * 256) * N_IN0P + vh * 64; r.K = proj + 1024 + vh * 64; r.V = proj + 2048 + h * 128; r.O = OA + (size_t)(qb * 256) * 2048 + vh * 128; r.kb = nullptr; r.bs = 4.0f / (float)(1 << h); r.P0 = qb * 256; r.jlo = 0; return r; } };
struct DecB { const bf16* Qb; const bf16* KV; bf16* MIX; int vcu, G;
    __device__ __forceinline__ BodyB::Ref operator()(int n) const { const int it = vcu + (n >> 1) * G, h = it >> 5, x = it & 31, qb = (n & 1) ? 63 - x : x;
        BodyB::Ref r; r.Q = Qb + (size_t)(qb * 256) * 1536 + h * 192; r.K = KV + h * 320; r.V = KV + h * 320 + 192; r.O = MIX + (size_t)(qb * 256) * 2048 + 1024 + h * 128; r.kb = nullptr; r.bs = 0.f; r.P0 = qb * 256; r.jlo = 0; return r; } };
struct DecC { const bf16* QKV; bf16* O1; const float* kb; int vcu, G;
    __device__ __forceinline__ BodyC::Ref operator()(int n) const { const int it = vcu + (n >> 1) * G, h = it >> 5, x = it & 31, qb = (n & 1) ? 63 - x : x;
        BodyC::Ref r; r.Q = QKV + (size_t)(qb * 256) * 6144 + h * 128; r.K = QKV + 2048 + h * 128; r.V = QKV + 4096 + h * 128; r.O = O1 + (size_t)(qb * 256) * 2048 + h * 128; r.kb = kb + h * S; r.bs = 0.f; r.P0 = qb * 256; r.jlo = 0; return r; } };
static_assert(BodyA::LDS_BYTES <= RING_BYTES && BodyB::LDS_BYTES <= RING_BYTES && BodyC::LDS_BYTES <= RING_BYTES, "attention LDS");

__global__ void __launch_bounds__(NWAVES * 64, 2) mk_fwd(Args args) {
    extern __shared__ __attribute__((aligned(16))) unsigned char lds[];
    LAS unsigned char* const ldsl = (LAS unsigned char*)lds;
    volatile LAS unsigned* const MISC = (volatile LAS unsigned*)(ldsl + MISC_OFF);
    const int tid = threadIdx.x, lane = tid & 63, wave = __builtin_amdgcn_readfirstlane(tid >> 6);
    const int G = gridDim.x; const int vcu = (G % 8 == 0) ? ((int)blockIdx.x % 8) * (G / 8) + (int)blockIdx.x / 8 : (int)blockIdx.x;
    unsigned char* const ws = args.ws;
    gu32* const ctl = (gu32*)(ws + WS_CTL);
    for (int u = tid; u < (LDS_BYTES - LDSCTL_OFF) / 4; u += NWAVES * 64) ((LAS unsigned*)(ldsl + LDSCTL_OFF))[u] = 0u;
    __syncthreads();
#if MK_PER_PHASE
    XcdBarrier bar; bar.bar = (unsigned*)(ctl + CW_BAR); bar.x = 0; bar.st = nullptr; (void)bar;
#define GRID_BAR() do { } while (0)
#else
    XcdBarrier bar = xcd_barrier_post((unsigned*)(ctl + CW_BAR), MISC + 8);
#define GRID_BAR() xcd_barrier(bar)
#endif
    const int lo = args.ph_lo, hi = args.ph_hi;
#define IN(k) (lo <= (k) && (k) < hi)
#define SEAM(k) do { if (IN((k) + 1)) GRID_BAR(); } while (0)
    const int gw = vcu * NWAVES + wave, NGW = G * NWAVES;
    float* const H = args.out;

    if (IN(0)) {
        LAS float* scr = (LAS float*)(ldsl + wave * 16640);
        tr_matrix(args.in[I_EV_W_IN], DM, N_IN0, 1, 0, (bf16*)(ws + WS_WIN0), 0, scr, gw, NGW, lane);
        tr_matrix(args.in[I_EV_W_UQ], 512, 1536, 1, 0, (bf16*)(ws + WS_WUQ), 3, scr, gw, NGW, lane);
        tr_matrix(args.in[I_EV_W_UKV], 512, 2048, 1, 0, (bf16*)(ws + WS_WUKV), 0, scr, gw, NGW, lane);
        tr_matrix(args.in[I_EV_W_OUT], DM, DM, 1, 0, (bf16*)(ws + WS_WOUT0), 0, scr, gw, NGW, lane);
        tr_matrix(args.in[I_EV_W_GATE], DM, FF, 1, 0, (bf16*)(ws + WS_WGU0), 1, scr, gw, NGW, lane);
        tr_matrix(args.in[I_EV_W_UP], DM, FF, 1, 0, (bf16*)(ws + WS_WGU0), 2, scr, gw, NGW, lane);
        tr_matrix(args.in[I_EV_W_DOWN], FF, DM, 1, 0, (bf16*)(ws + WS_WD0), 0, scr, gw, NGW, lane);
        tr_matrix(args.in[I_OD_W_IN], DM, N_IN1, 1, 0, (bf16*)(ws + WS_WIN1), 0, scr, gw, NGW, lane);
        tr_matrix(args.in[I_OD_W_OUT], DM, DM, 1, 0, (bf16*)(ws + WS_WOUT1), 0, scr, gw, NGW, lane);
        tr_matrix(args.in[I_OD_W_GATE], DM, FF, NE, 2 * FF, (bf16*)(ws + WS_WGU1), 1, scr, gw, NGW, lane);
        tr_matrix(args.in[I_OD_W_UP], DM, FF, NE, 2 * FF, (bf16*)(ws + WS_WGU1), 2, scr, gw, NGW, lane);
        tr_matrix(args.in[I_OD_W_DOWN], FF, DM, NE, DM, (bf16*)(ws + WS_WD1), 0, scr, gw, NGW, lane);
        { const int gt = gw * 64 + lane, NGT = NGW * 64;
          GAS v4u* z0 = (GAS v4u*)((bf16*)(ws + WS_WIN0) + (size_t)N_IN0 * DM); const int n0 = (N_IN0P - N_IN0) * DM / 8;
          for (int i = gt; i < n0; i += NGT) z0[i] = (v4u){0u, 0u, 0u, 0u};
          GAS v4u* z1 = (GAS v4u*)((bf16*)(ws + WS_WIN1) + (size_t)(N_IN1 + 16) * DM); const int n1 = (N_IN1P - N_IN1 - 16) * DM / 8;
          for (int i = gt; i < n1; i += NGT) z1[i] = (v4u){0u, 0u, 0u, 0u};
          float* cs = (float*)(ws + WS_ROPE);
          for (int i = gt; i < S * 32; i += NGT) { const int pos = i >> 5, k = i & 31; const float ang = (float)pos * ROPE_INV[k]; float sn, c; sincos_d(ang, sn, c); cs[pos * 64 + k] = c; cs[pos * 64 + 32 + k] = sn; }
        }
        for (int m = gw; m < S; m += NGW) rms_row_bf16(args.in[I_X] + (size_t)m * DM, args.in[I_EV_ATTN_NORM], (bf16*)(ws + WS_XN) + (size_t)m * DM, 1e-6f, lane);
        SEAM(0);
    }
    if (IN(1)) {
        pg8::Gemm g{(const bf16*)(ws + WS_XN), (const bf16*)(ws + WS_WIN0), S, N_IN0P, DM}; pg8::StaticOrder so; so.init(S, N_IN0P, G, (int)blockIdx.x);
        pg8::EpiBf16<0> E{(bf16*)(ws + WS_PROJ0), N_IN0P, nullptr, 0, 0, 1.f};
        pg8::gemm_phase<pg8::EpiBf16<0>, pg8::StaticOrder, true, true>(ldsl, g, so, E);
        SEAM(1);
    }
    if (IN(2)) {
        const bf16* proj = (const bf16*)(ws + WS_PROJ0); const float* cs = (const float*)(ws + WS_ROPE); bf16* Kf = (bf16*)(ws + WS_KF);
        for (int m = gw; m < S; m += NGW) { const bf16* prow = proj + (size_t)m * N_IN0P;
            rms512_bf16(prow + 3072, args.in[I_EV_Q_NORM], (bf16*)(ws + WS_CQN) + (size_t)m * 512, lane);
            rms512_bf16(prow + 3584, args.in[I_EV_KV_NORM], (bf16*)(ws + WS_CKVN) + (size_t)m * 512, lane);
            if (lane < 32) { const float x1 = bflo((unsigned)prow[4096 + lane]), x2 = bflo((unsigned)prow[4096 + 32 + lane]); const float c = cs[m * 64 + lane], sn = cs[m * 64 + 32 + lane];
                const bf16 o1 = (bf16)f2bf(x1 * c - x2 * sn), o2 = (bf16)f2bf(x2 * c + x1 * sn); bf16* kr = Kf + (size_t)m * 2560 + 128 + lane;
#pragma unroll
                for (int h = 0; h < 8; ++h) { kr[h * 320] = o1; kr[h * 320 + 32] = o2; } } }
        SEAM(2);
    }
    if (IN(3)) {
        { pg8::Gemm g{(const bf16*)(ws + WS_CQN), (const bf16*)(ws + WS_WUQ), S, 1536, 512}; pg8::StaticOrder so; so.init(S, 1536, G, (int)blockIdx.x);
          pg8::EpiQRope E{(bf16*)(ws + WS_QB), (const float*)(ws + WS_ROPE)};
          pg8::gemm_phase<pg8::EpiQRope, pg8::StaticOrder, true, true>(ldsl, g, so, E); }
        __syncthreads();
        { pg8::Gemm g{(const bf16*)(ws + WS_CKVN), (const bf16*)(ws + WS_WUKV), S, 2048, 512}; pg8::StaticOrder so; so.init(S, 2048, G, (int)blockIdx.x);
          pg8::EpiKV E{(bf16*)(ws + WS_KF)};
          pg8::gemm_phase<pg8::EpiKV, pg8::StaticOrder, true, true>(ldsl, g, so, E); }
        SEAM(3);
    }
    if (IN(4)) {
        const int nit = (vcu < 256) ? (256 - vcu + G - 1) / G : 0;
        { DecA d{(const bf16*)(ws + WS_PROJ0), (float*)(ws + WS_OA), vcu, G}; att::stream<BodyA, DecA>((char*)lds, 4 * nit, d, SCALE_A); }
        __syncthreads();
        { DecB d{(const bf16*)(ws + WS_QB), (const bf16*)(ws + WS_KF), (bf16*)(ws + WS_MIX), vcu, G}; att::stream<BodyB, DecB>((char*)lds, 2 * nit, d, SCALE_B); }
        SEAM(4);
    }
    if (IN(5)) {
        const float a1 = wave_sum(args.in[I_EV_LQ1][lane] * args.in[I_EV_LK1][lane]), a2 = wave_sum(args.in[I_EV_LQ2][lane] * args.in[I_EV_LK2][lane]);
        const float lam = expf(a1) - expf(a2) + 0.2f;
        const float* OA = (const float*)(ws + WS_OA); bf16* MIX = (bf16*)(ws + WS_MIX); const int h = lane >> 3, d0 = (lane & 7) * 16;
        f32x4 sg[4];
#pragma unroll
        for (int q = 0; q < 4; ++q) sg[q] = *(const GAS f32x4*)(args.in[I_EV_SUBLN] + d0 + 4 * q) * 0.8f;
        for (int m = gw; m < S; m += NGW) { const float* p0 = OA + (size_t)m * 2048 + (2 * h) * 128 + d0; f32x4 d[4]; float ss = 0.f;
#pragma unroll
            for (int q = 0; q < 4; ++q) { const f32x4 a = *(const GAS f32x4*)(p0 + 4 * q), b = *(const GAS f32x4*)(p0 + 128 + 4 * q); d[q] = a - b * lam; ss += (d[q].x * d[q].x + d[q].y * d[q].y) + (d[q].z * d[q].z + d[q].w * d[q].w); }
            ss += __shfl_xor(ss, 1); ss += __shfl_xor(ss, 2); ss += __shfl_xor(ss, 4);
            const float rstd = 1.0f / sqrtf(ss * (1.f / 128.f) + 1e-5f);
            v4u o0, o1; { const f32x4 y0 = d[0] * rstd * sg[0], y1 = d[1] * rstd * sg[1], y2 = d[2] * rstd * sg[2], y3 = d[3] * rstd * sg[3];
              o0.x = pk2(y0.x, y0.y); o0.y = pk2(y0.z, y0.w); o0.z = pk2(y1.x, y1.y); o0.w = pk2(y1.z, y1.w); o1.x = pk2(y2.x, y2.y); o1.y = pk2(y2.z, y2.w); o1.z = pk2(y3.x, y3.y); o1.w = pk2(y3.z, y3.w); }
            GAS v4u* dst = (GAS v4u*)(MIX + (size_t)m * 2048 + h * 128 + d0); dst[0] = o0; dst[1] = o1; }
        SEAM(5);
    }
    if (IN(6)) {
        pg8::Gemm g{(const bf16*)(ws + WS_MIX), (const bf16*)(ws + WS_WOUT0), S, DM, DM}; pg8::StaticOrder so; so.init(S, DM, G, (int)blockIdx.x);
        pg8::EpiResF32 E{args.in[I_X], H, DM};
        pg8::gemm_phase<pg8::EpiResF32, pg8::StaticOrder, true, true>(ldsl, g, so, E);
        SEAM(6);
    }
    if (IN(7)) {
        for (int m = gw; m < S; m += NGW) rms_row_bf16(H + (size_t)m * DM, args.in[I_EV_FFN_NORM], (bf16*)(ws + WS_XN) + (size_t)m * DM, 1e-6f, lane);
        SEAM(7);
    }
    if (IN(8)) {
        pg8::Gemm g{(const bf16*)(ws + WS_XN), (const bf16*)(ws + WS_WGU0), S, 2 * FF, DM}; pg8::StaticOrder so; so.init(S, 2 * FF, G, (int)blockIdx.x);
        pg8::EpiSwiGLU E{(bf16*)(ws + WS_HMID0), FF, 2 * FF / 256};
        pg8::gemm_phase<pg8::EpiSwiGLU, pg8::StaticOrder, true, true>(ldsl, g, so, E);
        SEAM(8);
    }
    if (IN(9)) {
        pg8::Gemm g{(const bf16*)(ws + WS_HMID0), (const bf16*)(ws + WS_WD0), S, DM, FF}; pg8::StaticOrder so; so.init(S, DM, G, (int)blockIdx.x);
        pg8::EpiResF32 E{H, H, DM};
        pg8::gemm_phase<pg8::EpiResF32, pg8::StaticOrder, true, true>(ldsl, g, so, E);
        SEAM(9);
    }
    if (IN(10)) {
        for (int m = gw; m < S; m += NGW) rms_row_bf16(H + (size_t)m * DM, args.in[I_OD_ATTN_NORM], (bf16*)(ws + WS_XN) + (size_t)m * DM, 1e-6f, lane);
        SEAM(10);
    }
    if (IN(11)) {
        pg8::Gemm g{(const bf16*)(ws + WS_XN), (const bf16*)(ws + WS_WIN1), S, N_IN1P, DM}; pg8::StaticOrder so; so.init(S, N_IN1P, G, (int)blockIdx.x);
        pg8::EpiQKVF E{(bf16*)(ws + WS_QKV1), (float*)(ws + WS_LOGF), args.in[I_OD_FBIAS]};
        pg8::gemm_phase<pg8::EpiQKVF, pg8::StaticOrder, true, true>(ldsl, g, so, E);
        SEAM(11);
    }
    if (IN(12)) {
        const float* logf = (const float*)(ws + WS_LOGF); float* csum = (float*)(ws + WS_CSUM); LAS float* red = (LAS float*)ldsl;
        for (int c = (int)blockIdx.x; c < 256; c += G) { const int r = tid >> 4, h = tid & 15;
            red[r * 16 + h] = logf[(size_t)(64 * c + r) * 16 + h] + logf[(size_t)(64 * c + 32 + r) * 16 + h];
            __syncthreads();
            if (tid < 16) { float s = 0.f; for (int q = 0; q < 32; ++q) s += red[q * 16 + tid]; csum[c * 16 + tid] = s; }
            __syncthreads(); }
        SEAM(12);
    }
    if (IN(13)) {
        const float* logf = (const float*)(ws + WS_LOGF); const float* csum = (const float*)(ws + WS_CSUM); float* kbC = (float*)(ws + WS_KBC);
        LAS float* red = (LAS float*)ldsl; LAS float* pre = red + 512; LAS float* val = red + 1024;
        for (int c = (int)blockIdx.x; c < 256; c += G) { const int part = tid >> 4, h = tid & 15;
            { float s = 0.f; for (int cc = part; cc < c; cc += 32) s += csum[cc * 16 + h]; red[part * 16 + h] = s; }
            val[tid] = logf[(size_t)(64 * c) * 16 + tid]; val[512 + tid] = logf[(size_t)(64 * c) * 16 + 512 + tid];
            __syncthreads();
            if (tid < 16) { float s = 0.f; for (int q = 0; q < 32; ++q) s += red[q * 16 + tid]; pre[tid] = s; }
            __syncthreads();
            if (tid < 16) { float run = pre[tid]; for (int r = 0; r < 64; ++r) { run += val[r * 16 + tid]; val[r * 16 + tid] = run; } }
            __syncthreads();
            { const int r = tid & 63, hh = tid >> 6; kbC[(size_t)hh * S + 64 * c + r] = val[r * 16 + hh] * (-1.0f / SCALE_C); kbC[(size_t)(hh + 8) * S + 64 * c + r] = val[r * 16 + hh + 8] * (-1.0f / SCALE_C); }
            __syncthreads(); }
        SEAM(13);
    }
    if (IN(14)) {
        const int nit = (vcu < 512) ? (512 - vcu + G - 1) / G : 0;
        DecC d{(const bf16*)(ws + WS_QKV1), (bf16*)(ws + WS_O1), (const float*)(ws + WS_KBC), vcu, G}; att::stream<BodyC, DecC>((char*)lds, 2 * nit, d, SCALE_C);
        SEAM(14);
    }
    if (IN(15)) {
        pg8::Gemm g{(const bf16*)(ws + WS_O1), (const bf16*)(ws + WS_WOUT1), S, DM, DM}; pg8::StaticOrder so; so.init(S, DM, G, (int)blockIdx.x);
        pg8::EpiResF32 E{H, H, DM};
        pg8::gemm_phase<pg8::EpiResF32, pg8::StaticOrder, true, true>(ldsl, g, so, E);
        SEAM(15);
    }
    if (IN(16)) {
        LAS float* rt = (LAS float*)ldsl; LAS unsigned* cnt = (LAS unsigned*)(ldsl + 65536);
        for (int idx = tid; idx < DM * NE; idx += NWAVES * 64) { const int k = idx >> 3, e = idx & 7; rt[e * DM + k] = args.in[I_OD_ROUTER][idx]; }
        __syncthreads();
        const GAS f32x4* gr = (const GAS f32x4*)args.in[I_OD_FFN_NORM] + lane;
        for (int c = (int)blockIdx.x; c < 256; c += G) {
            if (tid < 8) cnt[tid] = 0u;
            __syncthreads();
            for (int i = 0; i < 8; ++i) { const int row = 64 * c + 8 * wave + i;
                const GAS f32x4* xr = (const GAS f32x4*)(H + (size_t)row * DM) + lane; f32x4 v[8]; float s = 0.f;
#pragma unroll
                for (int j = 0; j < 8; ++j) { v[j] = xr[64 * j]; s += (v[j].x * v[j].x + v[j].y * v[j].y) + (v[j].z * v[j].z + v[j].w * v[j].w); }
                const float rstd = 1.0f / sqrtf(wave_sum(s) * (1.f / DM) + 1e-6f);
                GAS unsigned long long* o8 = (GAS unsigned long long*)((bf16*)(ws + WS_XN) + (size_t)row * DM) + lane;
#pragma unroll
                for (int j = 0; j < 8; ++j) { const f32x4 gg = gr[64 * j]; v[j] = (v[j] * rstd) * gg; o8[64 * j] = (unsigned long long)pk2(v[j].x, v[j].y) | ((unsigned long long)pk2(v[j].z, v[j].w) << 32); }
                float lg[8];
#pragma unroll
                for (int e = 0; e < 8; ++e) { float a = 0.f;
#pragma unroll
                    for (int j = 0; j < 8; ++j) { const f32x4 w = *(const LAS f32x4*)(rt + e * DM + 4 * lane + 256 * j); a += (v[j].x * w.x + v[j].y * w.y) + (v[j].z * w.z + v[j].w * w.w); }
                    lg[e] = wave_sum(a); }
                int e1 = 0; float l1 = lg[0];
#pragma unroll
                for (int e = 1; e < 8; ++e) if (lg[e] > l1) { l1 = lg[e]; e1 = e; }
                int e2 = -1; float l2 = -__builtin_inff();
#pragma unroll
                for (int e = 0; e < 8; ++e) if (e != e1 && lg[e] > l2) { l2 = lg[e]; e2 = e; }
                const float g1 = 1.0f / (1.0f + expf(l2 - l1)), g2 = 1.0f - g1;
                if (lane == 0) { *(GAS v4u*)(ws + WS_ROUTE + (size_t)row * 16) = (v4u){(unsigned)e1, (unsigned)e2, __builtin_bit_cast(unsigned, g1), __builtin_bit_cast(unsigned, g2)};
                    __hip_atomic_fetch_add(cnt + e1, 1u, __ATOMIC_RELAXED, __HIP_MEMORY_SCOPE_WORKGROUP); __hip_atomic_fetch_add(cnt + e2, 1u, __ATOMIC_RELAXED, __HIP_MEMORY_SCOPE_WORKGROUP); } }
            __syncthreads();
            if (tid < 8) ((unsigned*)(ws + WS_CNTG))[c * 8 + tid] = cnt[tid];
            __syncthreads(); }
        SEAM(16);
    }
    if (IN(17)) {
        const unsigned* cntg = (const unsigned*)(ws + WS_CNTG); LAS unsigned* red = (LAS unsigned*)ldsl; LAS unsigned* red2 = red + 512; LAS unsigned* T = red + 1024; LAS unsigned* P = red + 1032;
        LAS unsigned* st = red + 1040; LAS unsigned* rl = red + 1056; LAS unsigned* posl = red + 1056 + 256;
        bf16* As = (bf16*)(ws + WS_AS); float* gates = (float*)(ws + WS_GATES); unsigned* tokpos = (unsigned*)(ws + WS_TOKPOS);
        for (int c = (int)blockIdx.x; c < 256; c += G) {
            { const int e = tid & 7, part = tid >> 3; unsigned tot = 0u, pre = 0u; for (int cc = part; cc < 256; cc += 64) { const unsigned x = cntg[cc * 8 + e]; tot += x; if (cc < c) pre += x; } red[part * 8 + e] = tot; red2[part * 8 + e] = pre; }
            if (tid < 64) { const v4u r = *(const GAS v4u*)(ws + WS_ROUTE + (size_t)(64 * c + tid) * 16); rl[tid * 4 + 0] = r.x; rl[tid * 4 + 1] = r.y; rl[tid * 4 + 2] = r.z; rl[tid * 4 + 3] = r.w; }
            __syncthreads();
            if (tid < 8) { unsigned a = 0u, b = 0u; for (int q = 0; q < 64; ++q) { a += red[q * 8 + tid]; b += red2[q * 8 + tid]; } T[tid] = a; P[tid] = b; }
            __syncthreads();
            if (tid < 8) { unsigned s0 = 0u; for (int e = 0; e < tid; ++e) s0 += (T[e] + 255u) & ~255u; st[tid] = s0;
                unsigned run = s0 + P[tid]; for (int r = 0; r < 64; ++r) { if (rl[r * 4 + 0] == (unsigned)tid) posl[r * 2 + 0] = run++; if (rl[r * 4 + 1] == (unsigned)tid) posl[r * 2 + 1] = run++; }
                if (c == 0) ((unsigned*)(ws + WS_TOT))[tid] = T[tid]; }
            __syncthreads();
            for (int i = 0; i < 8; ++i) { const int r = 8 * wave + i, row = 64 * c + r; const GAS v4u* src = (const GAS v4u*)((const bf16*)(ws + WS_XN) + (size_t)row * DM) + lane;
                const v4u x0 = src[0], x1 = src[64], x2 = src[128], x3 = src[192];
#pragma unroll
                for (int sl = 0; sl < 2; ++sl) { const unsigned p = posl[r * 2 + sl]; GAS v4u* dst = (GAS v4u*)(As + (size_t)p * DM) + lane; dst[0] = x0; dst[64] = x1; dst[128] = x2; dst[192] = x3;
                    if (lane == 0) { gates[p] = __builtin_bit_cast(float, rl[r * 4 + 2 + sl]); tokpos[row * 2 + sl] = p; } } }
            { const unsigned e = (unsigned)wave, te = T[e], pad = ((te + 255u) & ~255u) - te;
              if ((unsigned)c < pad) { const unsigned p = st[e] + te + (unsigned)c; GAS v4u* dst = (GAS v4u*)(As + (size_t)p * DM) + lane; const v4u z = (v4u){0u, 0u, 0u, 0u}; dst[0] = z; dst[64] = z; dst[128] = z; dst[192] = z; if (lane == 0) gates[p] = 0.f; } }
            __syncthreads(); }
        SEAM(17);
    }
    if (IN(18)) {
        pg8::Gemm g{(const bf16*)(ws + WS_AS), (const bf16*)(ws + WS_WGU1), MPAD, NE * 2 * FF, DM}; pg8::GroupedOrder so; so.init((const unsigned*)(ws + WS_TOT), 2 * FF / 256, G, (int)blockIdx.x);
        pg8::EpiSwiGLU E{(bf16*)(ws + WS_HMS), FF, 2 * FF / 256};
        pg8::gemm_phase<pg8::EpiSwiGLU, pg8::GroupedOrder, true, true>(ldsl, g, so, E);
        SEAM(18);
    }
    if (IN(19)) {
        pg8::Gemm g{(const bf16*)(ws + WS_HMS), (const bf16*)(ws + WS_WD1), MPAD, NE * DM, FF}; pg8::GroupedOrder so; so.init((const unsigned*)(ws + WS_TOT), DM / 256, G, (int)blockIdx.x);
        pg8::EpiMoEDown E{(float*)(ws + WS_YS), (const float*)(ws + WS_GATES), DM / 256};
        pg8::gemm_phase<pg8::EpiMoEDown, pg8::GroupedOrder, true, true>(ldsl, g, so, E);
        SEAM(19);
    }
    if (IN(20)) {
        const float* Y = (const float*)(ws + WS_YS); const unsigned* tokpos = (const unsigned*)(ws + WS_TOKPOS); const GAS f32x4* gr = (const GAS f32x4*)args.in[I_FINAL_NORM] + lane;
        unsigned bad = __hip_atomic_load(ctl + CW_TMO, RLX_AGENT) | __hip_atomic_load(ctl + CW_BAR + XB_TMO, RLX_AGENT);
        for (int m = gw; m < S; m += NGW) { const unsigned p0 = tokpos[m * 2], p1 = tokpos[m * 2 + 1];
            GAS f32x4* xr = (GAS f32x4*)(H + (size_t)m * DM) + lane; const GAS f32x4* y0 = (const GAS f32x4*)(Y + (size_t)p0 * DM) + lane; const GAS f32x4* y1 = (const GAS f32x4*)(Y + (size_t)p1 * DM) + lane;
            f32x4 v[8]; float s = 0.f;
#pragma unroll
            for (int j = 0; j < 8; ++j) { v[j] = xr[64 * j] + y0[64 * j] + y1[64 * j]; s += (v[j].x * v[j].x + v[j].y * v[j].y) + (v[j].z * v[j].z + v[j].w * v[j].w); }
            float rstd = 1.0f / sqrtf(wave_sum(s) * (1.f / DM) + 1e-6f); if (bad) rstd = __builtin_nanf("");
#pragma unroll
            for (int j = 0; j < 8; ++j) xr[64 * j] = (v[j] * rstd) * gr[64 * j]; }
    }
#undef IN
#undef SEAM
#undef GRID_BAR
}

extern "C" void kernel_launch(void* const* d_in, const int* in_sizes, int n_in, void* d_out, int out_size, void* d_ws, size_t ws_size, hipStream_t stream) {
    static int grid = 0;
    if (grid == 0) {
        if (n_in != 27 || in_sizes[0] != S * DM || out_size != S * DM || ws_size < WS_END) { fprintf(stderr, "kernel_launch: shape/workspace mismatch (n_in %d, in0 %d, out %d, ws %zu, need %zu); nothing launched\n", n_in, n_in > 0 ? in_sizes[0] : -1, out_size, ws_size, (size_t)WS_END); grid = -1; return; }
        int dev = 0, cus = 0, per_cu = 0;
        if (hipGetDevice(&dev) != hipSuccess || hipDeviceGetAttribute(&cus, hipDeviceAttributeMultiprocessorCount, dev) != hipSuccess) { fprintf(stderr, "kernel_launch: device query failed\n"); grid = -1; return; }
        if (hipFuncSetAttribute((const void*)mk_fwd, hipFuncAttributeMaxDynamicSharedMemorySize, LDS_BYTES) != hipSuccess) { fprintf(stderr, "kernel_launch: hipFuncSetAttribute failed\n"); grid = -1; return; }
        if (hipOccupancyMaxActiveBlocksPerMultiprocessor(&per_cu, (const void*)mk_fwd, NWAVES * 64, LDS_BYTES) != hipSuccess || per_cu < 1) fprintf(stderr, "kernel_launch: note: occupancy query reports %d workgroups per CU\n", per_cu);
        (void)hipGetLastError();
        grid = cus;
    }
    if (grid < 0) return;
    if (hipMemsetAsync((char*)d_ws + WS_CTL, 0, CTL_ZERO_BYTES, stream) != hipSuccess) { fprintf(stderr, "kernel_launch: hipMemsetAsync failed\n"); return; }
    Args a{};
    for (int i = 0; i < 27; ++i) a.in[i] = (const float*)d_in[i];
    a.out = (float*)d_out; a.ws = (unsigned char*)d_ws;
#if MK_PER_PHASE
    for (int p = 0; p < NPH; ++p) { a.ph_lo = p; a.ph_hi = p + 1; hipLaunchKernelGGL(mk_fwd, dim3(grid), dim3(NWAVES * 64), LDS_BYTES, stream, a); }
#else
    a.ph_lo = 0; a.ph_hi = NPH; hipLaunchKernelGGL(mk_fwd, dim3(grid), dim3(NWAVES * 64), LDS_BYTES, stream, a);
#endif
    const hipError_t le = hipPeekAtLastError();
    if (le != hipSuccess) fprintf(stderr, "kernel_launch: launch failed: %s\n", hipGetErrorName(le));
}
```

```cpp
#include <hip/hip_runtime.h>
#include <cstdio>
#include <cstdint>
namespace pg8 {
#define PG8_LAS __attribute__((address_space(3)))
typedef unsigned short bf16_t;
typedef short bf16x8 __attribute__((ext_vector_type(8)));
typedef float f32x4 __attribute__((ext_vector_type(4)));
typedef unsigned u32x4 __attribute__((ext_vector_type(4)));
typedef int i32x4 __attribute__((ext_vector_type(4)));
typedef int i32x8 __attribute__((ext_vector_type(8)));
constexpr int BM = 256, BK = 64, HALF = 128, HTB = HALF * BK * 2  , STAGE_BYTES = 8 * HTB, NXCD = 8, WGM = 8;

__host__ __device__ __forceinline__ int lds_byte(int r, int c) { const int st = (r >> 4) * 2 + (c >> 5), rr = r & 15, cc = c & 31, ob = rr * 64 + cc * 2; return st * 1024 + (ob ^ (((ob >> 9) & 1) << 5)); }
__host__ __device__ __forceinline__ void stage_rc(int b, int& R, int& C) { const int st = b / 1024, sb = b % 1024, swz = sb ^ (((sb >> 9) & 1) << 5); R = (st >> 1) * 16 + swz / 64; C = (st & 1) * 32 + (swz % 64) / 2; }
__host__ __device__ __forceinline__ int perm32(int rho) { const int n = rho >> 4, i = rho & 15; return 8 * (i >> 2) + 4 * n + (i & 3); }

struct Unit { int pm, pn, ko, aux; };
struct Gemm { const bf16_t* A; const bf16_t* Bt; int M, N, K, ld; };

struct StaticOrder {
    int nM, nN, nwg, G, c;
    __host__ __device__ void init(int M, int N, int G_, int c_) { nM = M / BM; nN = N / BM; nwg = nM * nN; G = G_; c = c_; }
    __host__ __device__ bool next(int i, Unit& u) const {
        const long L = (long)i * G + c; if (L >= nwg) return false;
        int wgid = (int)L; { const int q = nwg / NXCD, r = nwg % NXCD, xcd = wgid % NXCD, off = wgid / NXCD; wgid = (xcd < r ? xcd * (q + 1) : r * (q + 1) + (xcd - r) * q) + off; }
        const int nig = WGM * nN, gid = wgid / nig, fm = gid * WGM, gsz = (nM - fm) < WGM ? (nM - fm) : WGM;
        u.pm = fm + ((wgid % nig) % gsz); u.pn = (wgid % nig) / gsz; return true;
    }
    __device__ __forceinline__ void a_ready(const Unit&) const {}
    __device__ __forceinline__ void done(const Unit&) const {}
};

__device__ __forceinline__ float sat8(float x) { return __builtin_amdgcn_fmed3f(x, -448.f, 448.f); }
__device__ __forceinline__ unsigned pk8x4(float a, float b, float c, float d) { int w = __builtin_amdgcn_cvt_pk_fp8_f32(sat8(a), sat8(b), 0, false); w = __builtin_amdgcn_cvt_pk_fp8_f32(sat8(c), sat8(d), w, true); return (unsigned)w; }
__device__ __forceinline__ unsigned cvt_pk_bf16(float lo, float hi) { unsigned r; asm volatile("v_cvt_pk_bf16_f32 %0, %1, %2" : "=v"(r) : "v"(lo), "v"(hi)); return r; }
typedef float f32x2 __attribute__((ext_vector_type(2)));
__device__ __forceinline__ f32x2 gelu_pk(f32x2 v) {
    const f32x2 av = __builtin_elementwise_abs(v), d = av * 0.2316418882f + 1.0f;
    f32x2 t; t.x = __builtin_amdgcn_rcpf(d.x); t.y = __builtin_amdgcn_rcpf(d.y);
    f32x2 q = t * 0.5307027145f + (-0.7265760135f); q = q * t + 0.7107068705f; q = q * t + (-0.142248368f); q = q * t + 0.127414796f; q = q * t;
    const f32x2 s = (v * v) * (-0.72134752044f);
    f32x2 e; e.x = __builtin_amdgcn_exp2f(s.x); e.y = __builtin_amdgcn_exp2f(s.y);
    const f32x2 m = v * (q * e), r = v - m;
    f32x2 o; o.x = v.x < 0.f ? m.x : r.x; o.y = v.y < 0.f ? m.y : r.y; return o;
}

template <int ACT  > struct EpiBf16 {
    static constexpr bool PERM = true, AFTER_DRAIN = false; static_assert(ACT == 0 || ACT == 1, "EpiBf16: ACT is 0 (none) or 1 (gelu_pk)");
    bf16_t* O; int ldc; const float* bias; int split_cols; size_t split_stride; float scale0;
    __device__ __forceinline__ void operator()(const f32x4 (&acc)[2][2][4][2], const Unit& u, int wr, int wc, int fr, int fq) const {
        const int row0 = u.pm * BM + wr * 64 + fr; int colt = u.pn * BM; bf16_t* base = O;
        float sc = 1.f; if (split_cols) { const int t = colt / split_cols; base += (size_t)t * split_stride; colt -= t * split_cols; if (t == 0) sc = scale0; }
        const int col0 = colt + wc * 32 + 8 * fq, bcol0 = u.pn * BM + wc * 32 + 8 * fq;
        f32x4 bv[2][2];
#pragma unroll
        for (int bj = 0; bj < 2; ++bj)
#pragma unroll
            for (int n = 0; n < 2; ++n) bv[bj][n] = bias ? *(const f32x4*)(bias + bcol0 + bj * HALF + 4 * n) : (f32x4){0.f, 0.f, 0.f, 0.f};
#pragma unroll
        for (int ai = 0; ai < 2; ++ai)
#pragma unroll
            for (int m = 0; m < 4; ++m) { bf16_t* rowp = base + (size_t)(row0 + ai * HALF + m * 16) * ldc + col0;
#pragma unroll
                for (int bj = 0; bj < 2; ++bj) { f32x4 v0 = acc[ai][bj][m][0] + bv[bj][0], v1 = acc[ai][bj][m][1] + bv[bj][1];
                    if (ACT == 1) { f32x2 a = gelu_pk((f32x2){v0[0], v0[1]}), b = gelu_pk((f32x2){v0[2], v0[3]}), c = gelu_pk((f32x2){v1[0], v1[1]}), d = gelu_pk((f32x2){v1[2], v1[3]});
                        v0 = (f32x4){a.x, a.y, b.x, b.y}; v1 = (f32x4){c.x, c.y, d.x, d.y}; }
                    v0 = v0 * sc; v1 = v1 * sc; u32x4 w; w.x = cvt_pk_bf16(v0[0], v0[1]); w.y = cvt_pk_bf16(v0[2], v0[3]); w.z = cvt_pk_bf16(v1[0], v1[1]); w.w = cvt_pk_bf16(v1[2], v1[3]);
                    *(u32x4*)(rowp + bj * HALF) = w; } }
    }
};

template <class Epi, class Sched, bool ALIGN_EPI = false, bool SP2 = false, int QM = 0>
__device__ __forceinline__ void gemm_phase(PG8_LAS unsigned char* lds, const Gemm g, const Sched& S, const Epi& E) {
    constexpr bool F8 = (QM == 1), I8 = (QM == 2);
    const int tid = threadIdx.x, wid = __builtin_amdgcn_readfirstlane(tid >> 6), lane = tid & 63, wr = wid >> 2, wc = wid & 3, fr = lane & 15, fq = lane >> 4;
    const int K = g.K, nt = K / BK, ld = g.ld ? g.ld : g.K;
    unsigned voffA[2], voffB[2];
#pragma unroll
    for (int i = 0; i < 2; ++i) { int R, C; stage_rc(tid * 16 + i * 8192, R, C); const int Rb = Epi::PERM ? ((R & ~31) + perm32(R & 31)) : R;
        voffA[i] = (unsigned)(R * ld + C) * 2u; voffB[i] = (unsigned)(Rb * ld + C) * 2u; }
    const size_t kstep = (size_t)(BK * 2);
    const size_t hstep = (size_t)HALF * ld * 2;
    const size_t tstep = 2 * hstep;
    const unsigned ldsw = (unsigned)wid * 1024u;
    const int aoff = lds_byte(wr * 64 + fr, fq * 8), boff = lds_byte(wc * 32 + fr, fq * 8);
#define PG8_SA(b, h) (((b) * 2 + (h)) * HTB)
#define PG8_SB(b, h) ((4 + (b) * 2 + (h)) * HTB)
#define PG8_STAGE(bufoff, gbase, voff) do { _Pragma("unroll") for (int _i = 0; _i < 2; ++_i) \
        __builtin_amdgcn_global_load_lds((const unsigned*)((const char*)(gbase) + (voff)[_i]), (PG8_LAS unsigned*)(lds + (bufoff) + ldsw + _i * 8192), 16, 0, 0); } while (0)
#define PG8_RD8(p_) __builtin_shufflevector(*(const PG8_LAS i32x4*)(p_), *(const PG8_LAS i32x4*)((p_) + 1024), 0, 1, 2, 3, 4, 5, 6, 7)
#define PG8_LDA(dst, b, h) do { if constexpr (F8) { _Pragma("unroll") for (int m = 0; m < 4; ++m) dst##8[m] = PG8_RD8(lds + PG8_SA(b, h) + aoff + m * 2048); }                                       \
        else { _Pragma("unroll") for (int m = 0; m < 4; ++m) _Pragma("unroll") for (int k = 0; k < 2; ++k) dst[m][k] = *(const PG8_LAS bf16x8*)(lds + PG8_SA(b, h) + aoff + m * 2048 + k * 1024); } } while (0)
#define PG8_LDB(dst, b, h) do { if constexpr (F8) { _Pragma("unroll") for (int n = 0; n < 2; ++n) dst##8[n] = PG8_RD8(lds + PG8_SB(b, h) + boff + n * 2048); }                                       \
        else { _Pragma("unroll") for (int n = 0; n < 2; ++n) _Pragma("unroll") for (int k = 0; k < 2; ++k) dst[n][k] = *(const PG8_LAS bf16x8*)(lds + PG8_SB(b, h) + boff + n * 2048 + k * 1024); } } while (0)
#define PG8_MMA(ai, bj, At, Bt) do { __builtin_amdgcn_s_setprio(1); _Pragma("unroll") for (int m = 0; m < 4; ++m) _Pragma("unroll") for (int n = 0; n < 2; ++n) {                               \
        if constexpr (F8) asm volatile("v_mfma_f32_16x16x128_f8f6f4 %0, %1, %2, %0" : "+v"(acc[ai][bj][m][n]) : "v"(Bt##8[n]), "v"(At##8[m]));     \
        else if constexpr (I8) { _Pragma("unroll") for (int k = 0; k < 2; ++k) acc[ai][bj][m][n] = __builtin_bit_cast(f32x4, __builtin_amdgcn_mfma_i32_16x16x64_i8(__builtin_bit_cast(i32x4, Bt[n][k]), __builtin_bit_cast(i32x4, At[m][k]), __builtin_bit_cast(i32x4, acc[ai][bj][m][n]), 0, 0, 0)); } \
        else { _Pragma("unroll") for (int k = 0; k < 2; ++k) acc[ai][bj][m][n] = __builtin_amdgcn_mfma_f32_16x16x32_bf16(Bt[n][k], At[m][k], acc[ai][bj][m][n], 0, 0, 0); } }                \
        __builtin_amdgcn_s_setprio(0); } while (0)
#define PG8_WAIT_V(n) asm volatile("s_waitcnt vmcnt(" #n ")" ::: "memory")
#define PG8_WAIT_L(n) asm volatile("s_waitcnt lgkmcnt(" #n ")" ::: "memory")
#define PG8_BAR __builtin_amdgcn_s_barrier()
#define PG8_SCHED __builtin_amdgcn_sched_barrier(0)
    Unit cur, nxt; int ui = 0; cur.ko = 0; nxt.ko = 0; cur.aux = 0; nxt.aux = 0;
    if (!S.next(0, cur)) return;
    f32x4 acc[2][2][4][2];
#pragma unroll
    for (int a = 0; a < 2; ++a)
#pragma unroll
        for (int b = 0; b < 2; ++b)
#pragma unroll
            for (int m = 0; m < 4; ++m)
#pragma unroll
                for (int n = 0; n < 2; ++n) acc[a][b][m][n] = (f32x4){0.f, 0.f, 0.f, 0.f};
    bf16x8 At[4][2], B0[2][2], B1[2][2]; i32x8 At8[4], B08[2], B18[2]; (void)At; (void)B0; (void)B1; (void)At8; (void)B08; (void)B18;
    const char* cA = (const char*)g.A + (size_t)cur.pm * tstep + cur.ko; const char* cB = (const char*)g.Bt + (size_t)cur.pn * tstep + cur.ko;
    S.a_ready(cur);
    if constexpr (SP2) {
        PG8_STAGE(PG8_SB(0, 0), cB, voffB); PG8_STAGE(PG8_SB(0, 1), cB + hstep, voffB); PG8_STAGE(PG8_SA(0, 0), cA, voffA); PG8_STAGE(PG8_SA(0, 1), cA + hstep, voffA);
        if (wr == 1) PG8_BAR;
        PG8_WAIT_V(2); PG8_BAR;
        PG8_STAGE(PG8_SB(1, 0), cB + kstep, voffB); PG8_STAGE(PG8_SA(1, 0), cA + kstep, voffA); PG8_STAGE(PG8_SB(1, 1), cB + hstep + kstep, voffB);
        PG8_WAIT_V(6); PG8_BAR;
    } else {
        PG8_STAGE(PG8_SB(0, 0), cB, voffB); PG8_STAGE(PG8_SA(0, 0), cA, voffA); PG8_STAGE(PG8_SB(0, 1), cB + hstep, voffB); PG8_STAGE(PG8_SA(0, 1), cA + hstep, voffA);
        if (wr == 1) PG8_BAR;
        PG8_WAIT_V(4); PG8_BAR;
        PG8_STAGE(PG8_SB(1, 0), cB + kstep, voffB); PG8_STAGE(PG8_SA(1, 0), cA + kstep, voffA); PG8_STAGE(PG8_SB(1, 1), cB + hstep + kstep, voffB);
        PG8_WAIT_V(6); PG8_BAR;
    }
    for (;;) {
        const bool has_next = S.next(ui + 1, nxt);
        const char* nA = has_next ? (const char*)g.A + (size_t)nxt.pm * tstep + nxt.ko : cA; const char* nB = has_next ? (const char*)g.Bt + (size_t)nxt.pn * tstep + nxt.ko : cB;
        for (int t = 0; t < nt; t += 2) {
            const bool last = (t == nt - 2);
            const char* a1 = cA + (size_t)(t + 1) * kstep;
            const char* a2 = last ? nA : cA + (size_t)(t + 2) * kstep; const char* b2 = last ? nB : cB + (size_t)(t + 2) * kstep;
            const char* a3 = a2 + kstep; const char* b3 = b2 + kstep;
            if (last && has_next) S.a_ready(nxt);
            if constexpr (SP2) {
            PG8_LDB(B0, 0, 0); PG8_LDB(B1, 0, 1); PG8_SCHED; PG8_LDA(At, 0, 0); PG8_STAGE(PG8_SA(1, 1), a1 + hstep, voffA);
            PG8_WAIT_V(8); PG8_WAIT_L(0); PG8_BAR; PG8_MMA(0, 0, At, B0); PG8_MMA(0, 1, At, B1); PG8_BAR; PG8_SCHED;
            PG8_LDA(At, 0, 1); PG8_STAGE(PG8_SB(0, 0), b2, voffB); PG8_STAGE(PG8_SB(0, 1), b2 + hstep, voffB); PG8_STAGE(PG8_SA(0, 0), a2, voffA);
            PG8_WAIT_V(8); PG8_WAIT_L(0); PG8_BAR; PG8_MMA(1, 0, At, B0); PG8_MMA(1, 1, At, B1); PG8_BAR; PG8_SCHED;
            PG8_LDB(B0, 1, 0); PG8_LDB(B1, 1, 1); PG8_SCHED; PG8_LDA(At, 1, 0); PG8_STAGE(PG8_SA(0, 1), a2 + hstep, voffA);
            PG8_WAIT_V(8); PG8_WAIT_L(0); PG8_BAR; PG8_MMA(0, 0, At, B0); PG8_MMA(0, 1, At, B1); PG8_BAR; PG8_SCHED;
            PG8_LDA(At, 1, 1); PG8_STAGE(PG8_SB(1, 0), b3, voffB); PG8_STAGE(PG8_SB(1, 1), b3 + hstep, voffB); PG8_STAGE(PG8_SA(1, 0), a3, voffA);
            PG8_WAIT_V(8); PG8_WAIT_L(0); PG8_BAR; PG8_MMA(1, 0, At, B0); PG8_MMA(1, 1, At, B1); PG8_BAR; PG8_SCHED;
            } else {
            PG8_LDB(B0, 0, 0); PG8_SCHED; PG8_LDA(At, 0, 0); PG8_STAGE(PG8_SA(1, 1), a1 + hstep, voffA);
            PG8_WAIT_L(8); PG8_BAR; PG8_WAIT_L(0); PG8_MMA(0, 0, At, B0); PG8_BAR; PG8_SCHED;
            PG8_LDB(B1, 0, 1); PG8_STAGE(PG8_SB(0, 0), b2, voffB);
            PG8_BAR; PG8_WAIT_L(0); PG8_MMA(0, 1, At, B1); PG8_BAR;
            PG8_LDA(At, 0, 1); PG8_STAGE(PG8_SA(0, 0), a2, voffA);
            PG8_BAR; PG8_WAIT_L(0); PG8_MMA(1, 0, At, B0); PG8_BAR; PG8_SCHED;
            PG8_STAGE(PG8_SB(0, 1), b2 + hstep, voffB);
            PG8_WAIT_V(6); PG8_BAR; PG8_MMA(1, 1, At, B1); PG8_BAR;
            PG8_LDB(B0, 1, 0); PG8_SCHED; PG8_LDA(At, 1, 0); PG8_STAGE(PG8_SA(0, 1), a2 + hstep, voffA);
            PG8_WAIT_L(8); PG8_BAR; PG8_WAIT_L(0); PG8_MMA(0, 0, At, B0); PG8_BAR; PG8_SCHED;
            PG8_LDB(B1, 1, 1); PG8_STAGE(PG8_SB(1, 0), b3, voffB);
            PG8_BAR; PG8_WAIT_L(0); PG8_MMA(0, 1, At, B1); PG8_BAR;
            PG8_LDA(At, 1, 1); PG8_STAGE(PG8_SA(1, 0), a3, voffA);
            PG8_BAR; PG8_WAIT_L(0); PG8_MMA(1, 0, At, B0); PG8_BAR; PG8_SCHED;
            PG8_STAGE(PG8_SB(1, 1), b3 + hstep, voffB);
            PG8_WAIT_V(6); PG8_BAR; PG8_MMA(1, 1, At, B1); PG8_BAR;
            }
        }
        if constexpr (ALIGN_EPI) { if (wr == 0) PG8_BAR; }
        if constexpr (F8) asm volatile("s_nop 15\n\ts_nop 15" ::: "memory");
        if constexpr (I8) {
#pragma unroll
            for (int a = 0; a < 2; ++a)
#pragma unroll
                for (int b = 0; b < 2; ++b)
#pragma unroll
                    for (int m = 0; m < 4; ++m)
#pragma unroll
                        for (int n = 0; n < 2; ++n) { const i32x4 iv = __builtin_bit_cast(i32x4, acc[a][b][m][n]); acc[a][b][m][n] = (f32x4){(float)iv[0], (float)iv[1], (float)iv[2], (float)iv[3]}; } }
        if constexpr (!Epi::AFTER_DRAIN) { E(acc, cur, wr, wc, fr, fq); S.done(cur); }
        if (!has_next) break;
#pragma unroll
        for (int a = 0; a < 2; ++a)
#pragma unroll
            for (int b = 0; b < 2; ++b)
#pragma unroll
                for (int m = 0; m < 4; ++m)
#pragma unroll
                    for (int n = 0; n < 2; ++n) acc[a][b][m][n] = (f32x4){0.f, 0.f, 0.f, 0.f};
        if constexpr (F8) asm volatile("s_nop 7" ::: "memory");
        cur = nxt; cA = nA; cB = nB; ++ui;
        if constexpr (ALIGN_EPI) { if (wr == 1) PG8_BAR; }
    }
    PG8_WAIT_V(0);
    if constexpr (!ALIGN_EPI) { if (wr == 0) PG8_BAR; }
    PG8_BAR;
    if constexpr (Epi::AFTER_DRAIN) { E.fused(acc, cur, wr, wc, fr, fq, lds, wid, lane); S.done(cur); }
#undef PG8_SA
#undef PG8_SB
#undef PG8_STAGE
#undef PG8_LDA
#undef PG8_LDB
#undef PG8_MMA
#undef PG8_RD8
#undef PG8_WAIT_V
#undef PG8_WAIT_L
#undef PG8_BAR
#undef PG8_SCHED
}
}
namespace pg8 {
__device__ __forceinline__ u32x4 pack8bf(const f32x4 v0, const f32x4 v1) { u32x4 w; w.x = cvt_pk_bf16(v0[0], v0[1]); w.y = cvt_pk_bf16(v0[2], v0[3]); w.z = cvt_pk_bf16(v1[0], v1[1]); w.w = cvt_pk_bf16(v1[2], v1[3]); return w; }

struct EpiQRope {
    static constexpr bool PERM = true, AFTER_DRAIN = false;
    bf16_t* Qb; const float* cs;
    __device__ __forceinline__ void operator()(const f32x4 (&acc)[2][2][4][2], const Unit& u, int wr, int wc, int fr, int fq) const {
        const int row0 = u.pm * BM + wr * 64 + fr;
        if (u.pn < 4) {
#pragma unroll
            for (int ai = 0; ai < 2; ++ai)
#pragma unroll
                for (int m = 0; m < 4; ++m) { bf16_t* rowp = Qb + (size_t)(row0 + ai * HALF + m * 16) * 1536 + wc * 32 + 8 * fq;
#pragma unroll
                    for (int bj = 0; bj < 2; ++bj) *(u32x4*)(rowp + (2 * u.pn + bj) * 192) = pack8bf(acc[ai][bj][m][0], acc[ai][bj][m][1]); }
        } else {
            const int head = 4 * (u.pn - 4) + wc, i0 = 8 * fq;
#pragma unroll
            for (int ai = 0; ai < 2; ++ai)
#pragma unroll
                for (int m = 0; m < 4; ++m) { const int row = row0 + ai * HALF + m * 16; const float* c = cs + (size_t)row * 64 + i0;
                    const f32x4 c0 = *(const f32x4*)c, c1 = *(const f32x4*)(c + 4), s0 = *(const f32x4*)(c + 32), s1 = *(const f32x4*)(c + 36);
                    const f32x4 x1a = acc[ai][0][m][0], x1b = acc[ai][0][m][1], x2a = acc[ai][1][m][0], x2b = acc[ai][1][m][1];
                    const f32x4 o1a = x1a * c0 - x2a * s0, o1b = x1b * c1 - x2b * s1, o2a = x2a * c0 + x1a * s0, o2b = x2b * c1 + x1b * s1;
                    bf16_t* rowp = Qb + (size_t)row * 1536 + head * 192 + 128 + i0;
                    *(u32x4*)(rowp) = pack8bf(o1a, o1b); *(u32x4*)(rowp + 32) = pack8bf(o2a, o2b); }
        }
    }
};
struct EpiKV {
    static constexpr bool PERM = true, AFTER_DRAIN = false;
    bf16_t* KV;
    __device__ __forceinline__ void operator()(const f32x4 (&acc)[2][2][4][2], const Unit& u, int wr, int wc, int fr, int fq) const {
        const int row0 = u.pm * BM + wr * 64 + fr, d = wc * 32 + 8 * fq;
#pragma unroll
        for (int ai = 0; ai < 2; ++ai)
#pragma unroll
            for (int m = 0; m < 4; ++m) { const size_t row = (size_t)(row0 + ai * HALF + m * 16);
                *(u32x4*)(KV + row * 2560 + u.pn * 320 + d) = pack8bf(acc[ai][0][m][0], acc[ai][0][m][1]);
                *(u32x4*)(KV + row * 2560 + u.pn * 320 + 192 + d) = pack8bf(acc[ai][1][m][0], acc[ai][1][m][1]); }
    }
};
template <bool BASE_F32, bool RSC = false> struct EpiResB {
    static constexpr bool PERM = true, AFTER_DRAIN = false;
    const float* basef; bf16_t* hb; float* ps; int ldc; const float* rsc;
    __device__ __forceinline__ void operator()(const f32x4 (&acc)[2][2][4][2], const Unit& u, int wr, int wc, int fr, int fq) const {
        const int row0 = u.pm * BM + wr * 64 + fr, col0 = u.pn * BM + wc * 32 + 8 * fq;
#pragma unroll
        for (int ai = 0; ai < 2; ++ai) {
            f32x4 bf[BASE_F32 ? 4 : 1][2][2]; u32x4 bh[BASE_F32 ? 1 : 4][2];
#pragma unroll
            for (int m = 0; m < 4; ++m) { const size_t off = (size_t)(row0 + ai * HALF + m * 16) * ldc + col0;
#pragma unroll
                for (int bj = 0; bj < 2; ++bj) { if (BASE_F32) { bf[BASE_F32 ? m : 0][bj][0] = *(const f32x4*)(basef + off + bj * HALF); bf[BASE_F32 ? m : 0][bj][1] = *(const f32x4*)(basef + off + bj * HALF + 4); }
                                                 else bh[BASE_F32 ? 0 : m][bj] = *(const u32x4*)(hb + off + bj * HALF); } }
#pragma unroll
            for (int m = 0; m < 4; ++m) { const int row = row0 + ai * HALF + m * 16; const size_t off = (size_t)row * ldc + col0; float ss = 0.f; const float rf = RSC ? rsc[row] : 1.f;
#pragma unroll
                for (int bj = 0; bj < 2; ++bj) { f32x4 b0, b1;
                    if (BASE_F32) { b0 = bf[BASE_F32 ? m : 0][bj][0]; b1 = bf[BASE_F32 ? m : 0][bj][1]; }
                    else { const u32x4 w = bh[BASE_F32 ? 0 : m][bj];
                        b0 = (f32x4){__builtin_bit_cast(float, w.x << 16), __builtin_bit_cast(float, w.x & 0xffff0000u), __builtin_bit_cast(float, w.y << 16), __builtin_bit_cast(float, w.y & 0xffff0000u)};
                        b1 = (f32x4){__builtin_bit_cast(float, w.z << 16), __builtin_bit_cast(float, w.z & 0xffff0000u), __builtin_bit_cast(float, w.w << 16), __builtin_bit_cast(float, w.w & 0xffff0000u)}; }
                    const f32x4 v0 = RSC ? b0 + acc[ai][bj][m][0] * rf : b0 + acc[ai][bj][m][0], v1 = RSC ? b1 + acc[ai][bj][m][1] * rf : b1 + acc[ai][bj][m][1];
                    ss += ((v0[0] * v0[0] + v0[1] * v0[1]) + (v0[2] * v0[2] + v0[3] * v0[3])) + ((v1[0] * v1[0] + v1[1] * v1[1]) + (v1[2] * v1[2] + v1[3] * v1[3]));
                    *(u32x4*)(hb + off + bj * HALF) = pack8bf(v0, v1); }
                ss += __shfl_xor(ss, 16); ss += __shfl_xor(ss, 32);
                if (fq == 0) ps[(size_t)row * 32 + u.pn * 4 + wc] = ss; }
            asm volatile("" ::: "memory"); }
    }
};
struct EpiBf16Row {
    static constexpr bool PERM = true, AFTER_DRAIN = false;
    bf16_t* O; int ldc; const float* rstd;
    __device__ __forceinline__ void operator()(const f32x4 (&acc)[2][2][4][2], const Unit& u, int wr, int wc, int fr, int fq) const {
        const int row0 = u.pm * BM + wr * 64 + fr, col0 = u.pn * BM + wc * 32 + 8 * fq;
        float rs[2][4];
#pragma unroll
        for (int ai = 0; ai < 2; ++ai)
#pragma unroll
            for (int m = 0; m < 4; ++m) rs[ai][m] = rstd[row0 + ai * HALF + m * 16];
#pragma unroll
        for (int ai = 0; ai < 2; ++ai)
#pragma unroll
            for (int m = 0; m < 4; ++m) { const int row = row0 + ai * HALF + m * 16; const float r = rs[ai][m]; bf16_t* rowp = O + (size_t)row * ldc + col0;
#pragma unroll
                for (int bj = 0; bj < 2; ++bj) *(u32x4*)(rowp + bj * HALF) = pack8bf(acc[ai][bj][m][0] * r, acc[ai][bj][m][1] * r); }
    }
};
template <bool OUT8 = false> struct EpiSwiGLU {
    static constexpr bool PERM = true, AFTER_DRAIN = false;
    bf16_t* Hm; int ldh; int ntn; const float* rstd; float osc;
    __device__ __forceinline__ void operator()(const f32x4 (&acc)[2][2][4][2], const Unit& u, int wr, int wc, int fr, int fq) const {
        const int row0 = u.pm * BM + wr * 64 + fr, col = (u.pn % ntn) * 128 + wc * 32 + 8 * fq;
        float rs[2][4];
#pragma unroll
        for (int ai = 0; ai < 2; ++ai)
#pragma unroll
            for (int m = 0; m < 4; ++m) rs[ai][m] = rstd[row0 + ai * HALF + m * 16];
#pragma unroll
        for (int ai = 0; ai < 2; ++ai)
#pragma unroll
            for (int m = 0; m < 4; ++m) { f32x4 h[2]; const float r = rs[ai][m];
#pragma unroll
                for (int n = 0; n < 2; ++n) { const f32x4 g = acc[ai][0][m][n] * r, up = acc[ai][1][m][n] * r;
#pragma unroll
                    for (int e = 0; e < 4; ++e) { const float s = __builtin_amdgcn_rcpf(1.0f + __builtin_amdgcn_exp2f(-1.4426950408889634f * g[e])); h[n][e] = g[e] * s * up[e]; } }
                if constexpr (OUT8) { typedef unsigned u32x2 __attribute__((ext_vector_type(2)));
                    u32x2 w; w.x = pk8x4(h[0][0] * osc, h[0][1] * osc, h[0][2] * osc, h[0][3] * osc); w.y = pk8x4(h[1][0] * osc, h[1][1] * osc, h[1][2] * osc, h[1][3] * osc);
                    *(u32x2*)((unsigned char*)Hm + (size_t)(row0 + ai * HALF + m * 16) * ldh + col) = w; }
                else *(u32x4*)(Hm + (size_t)(row0 + ai * HALF + m * 16) * ldh + col) = pack8bf(h[0], h[1]); }
    }
};
struct EpiMoEDown {
    static constexpr bool PERM = true, AFTER_DRAIN = false;
    bf16_t* Y; const float* gate; int ntn;
    __device__ __forceinline__ void operator()(const f32x4 (&acc)[2][2][4][2], const Unit& u, int wr, int wc, int fr, int fq) const {
        const int row0 = u.pm * BM + wr * 64 + fr, col0 = (u.pn % ntn) * BM + wc * 32 + 8 * fq;
        float gs[2][4];
#pragma unroll
        for (int ai = 0; ai < 2; ++ai)
#pragma unroll
            for (int m = 0; m < 4; ++m) gs[ai][m] = gate[row0 + ai * HALF + m * 16];
#pragma unroll
        for (int ai = 0; ai < 2; ++ai)
#pragma unroll
            for (int m = 0; m < 4; ++m) { const int row = row0 + ai * HALF + m * 16; const float gt = gs[ai][m]; bf16_t* rowp = Y + (size_t)row * 2048 + col0;
#pragma unroll
                for (int bj = 0; bj < 2; ++bj) *(u32x4*)(rowp + bj * HALF) = pack8bf(acc[ai][bj][m][0] * gt, acc[ai][bj][m][1] * gt); }
    }
};
struct EpiPartF32 {
    static constexpr bool PERM = true, AFTER_DRAIN = false;
    float* out; int ncols, kbytes, rows; const float* rstd;
    __device__ __forceinline__ void operator()(const f32x4 (&acc)[2][2][4][2], const Unit& u, int wr, int wc, int fr, int fq) const {
        const int row0 = u.pm * BM + wr * 64 + fr, col = wc * 32 + 8 * fq, kq = u.ko / kbytes;
        if (col < ncols) {
            float rs[2][4];
#pragma unroll
            for (int ai = 0; ai < 2; ++ai)
#pragma unroll
                for (int m = 0; m < 4; ++m) rs[ai][m] = rstd ? rstd[row0 + ai * HALF + m * 16] : 1.f;
#pragma unroll
            for (int ai = 0; ai < 2; ++ai)
#pragma unroll
                for (int m = 0; m < 4; ++m) { const int row = row0 + ai * HALF + m * 16; const float r = rs[ai][m]; float* p = out + ((size_t)kq * rows + (size_t)row) * ncols + col; *(f32x4*)p = acc[ai][0][m][0] * r; *(f32x4*)(p + 4) = acc[ai][0][m][1] * r; }
        }
    }
};
struct SplitKOrder {
    int G, c, PN, kbytes;
    __device__ __forceinline__ bool next(int i, Unit& u) const { const int L = i * G + c; if (L >= 256) return false; u.pm = L >> 2; u.pn = PN; u.ko = (L & 3) * kbytes; return true; }
    __device__ __forceinline__ void a_ready(const Unit&) const {}
    __device__ __forceinline__ void done(const Unit&) const {}
};
struct GroupedOrder {
    int nN, nwg, G, c, MT, t1, t2, t3, t4, t5, t6, t7, hi;
    __device__ __forceinline__ void init(const unsigned* tot, int nN_, int G_, int c_) {
        int t = 0; nN = nN_; G = G_; c = c_;
        t += (int)((tot[0] + 255u) >> 8); t1 = t; t += (int)((tot[1] + 255u) >> 8); t2 = t; t += (int)((tot[2] + 255u) >> 8); t3 = t; t += (int)((tot[3] + 255u) >> 8); t4 = t;
        t += (int)((tot[4] + 255u) >> 8); t5 = t; t += (int)((tot[5] + 255u) >> 8); t6 = t; t += (int)((tot[6] + 255u) >> 8); t7 = t; t += (int)((tot[7] + 255u) >> 8); MT = t; nwg = MT * nN; hi = nwg;
    }
    __device__ __forceinline__ bool next(int i, Unit& u) const { const long L = (long)i * G + c; if (L >= hi) return false; map((int)L, u); return true; }
    __device__ __forceinline__ void map(int L, Unit& u) const {
        int wgid = L; { const int q = nwg / NXCD, r = nwg % NXCD, xcd = wgid % NXCD, off = wgid / NXCD; wgid = (xcd < r ? xcd * (q + 1) : r * (q + 1) + (xcd - r) * q) + off; }
        const int nig = WGM * nN, gid = wgid / nig, fm = gid * WGM, gsz = (MT - fm) < WGM ? (MT - fm) : WGM;
        const int pm = fm + ((wgid % nig) % gsz), pn = (wgid % nig) / gsz;
        const int e = (pm >= t1) + (pm >= t2) + (pm >= t3) + (pm >= t4) + (pm >= t5) + (pm >= t6) + (pm >= t7);
        u.pm = pm; u.pn = e * nN + pn;
    }
    __device__ __forceinline__ void a_ready(const Unit&) const {}
    __device__ __forceinline__ void done(const Unit&) const {}
};
template <int LOG> struct GroupedSplitOrder {
    GroupedOrder b; int first, nq, kbytes;
    __device__ __forceinline__ bool next(int i, Unit& u) const { const int Lq = i * b.G + b.c; if (Lq >= nq) return false; b.map(first + (Lq >> LOG), u); u.ko = (Lq & ((1 << LOG) - 1)) * kbytes; u.aux = Lq >> LOG; return true; }
    __device__ __forceinline__ void a_ready(const Unit&) const {}
    __device__ __forceinline__ void done(const Unit&) const {}
};
struct EpiMoEDownPart {
    static constexpr bool PERM = true, AFTER_DRAIN = false;
    float* part; unsigned* split; int ntn, kbytes;
    __device__ __forceinline__ void operator()(const f32x4 (&acc)[2][2][4][2], const Unit& u, int wr, int wc, int fr, int fq) const {
        const int kq = u.ko / kbytes, pn = u.pn % ntn; float* base = part + ((size_t)(u.aux * 4 + kq) << 16) + (size_t)(wr * 64 + fr) * 256 + wc * 32 + 8 * fq;
        if (kq == 0 && wr == 0 && wc == 0 && fr == 0 && fq == 0) split[u.pm * ntn + pn] = (unsigned)u.aux + 1u;
#pragma unroll
        for (int ai = 0; ai < 2; ++ai)
#pragma unroll
            for (int m = 0; m < 4; ++m) { float* rowp = base + (size_t)(ai * HALF + m * 16) * 256;
#pragma unroll
                for (int bj = 0; bj < 2; ++bj) { *(f32x4*)(rowp + bj * HALF) = acc[ai][bj][m][0]; *(f32x4*)(rowp + bj * HALF + 4) = acc[ai][bj][m][1]; } }
    }
};
}
#include <cmath>
#define ATT_PV_SPLIT 1
namespace att {
typedef unsigned short bf16_t;
typedef short bf16x8 __attribute__((ext_vector_type(8)));
typedef short s16x4 __attribute__((ext_vector_type(4)));
typedef float f32x16 __attribute__((ext_vector_type(16)));
typedef float f32x4 __attribute__((ext_vector_type(4)));
typedef unsigned u32x4 __attribute__((ext_vector_type(4)));
constexpr int NW = 8, QBLK = 32, KVBLK = 64, QB = NW * QBLK, DV = 128, SHM_V = KVBLK * DV * 2;
constexpr float THR = 40.f;
#define ATT_SBAR() __builtin_amdgcn_sched_barrier(0)
__device__ __forceinline__ int v_st(int k, int c) { const int kk = (k & ~0xC) | ((k & 4) << 1) | ((k & 8) >> 1); return ((kk >> 3) * 4 + (c >> 5)) * 512 + ((kk & 7) * 32 + (c & 31)) * 2; }
__device__ __forceinline__ int v_rd_base(int lane) { return ((lane & 3) << 3) | (((lane >> 2) & 3) << 6) | (((lane >> 4) & 1) << 5) | (((lane >> 5) & 1) << 8); }
constexpr int v_rd_off(int d0, int ks, int half) { return d0 * 512 + ks * 4096 + half * 2048; }
__device__ __forceinline__ int crow(int r, int hi) { return (r & 3) + 8 * (r >> 2) + 4 * hi; }
__device__ __forceinline__ unsigned cvtpk(float lo, float hi) { unsigned r; asm volatile("v_cvt_pk_bf16_f32 %0, %1, %2" : "=v"(r) : "v"(lo), "v"(hi)); return r; }
__device__ __forceinline__ bf16x8 ld8(const bf16_t* p) { return *reinterpret_cast<const bf16x8*>(p); }
__device__ __forceinline__ void mask_tile(f32x16& p0, f32x16& p1, int dq) {
    const float NEG = -__builtin_inff();
#define ATT_MSK(x, c_) asm volatile("v_cmp_gt_i32 vcc, %2, %1\n\tv_cndmask_b32 %0, %0, %3, vcc" : "+v"(x) : "v"(dq), "n"(c_), "v"(NEG) : "vcc")
#pragma unroll
    for (int r = 0; r < 16; ++r) { const int c = (r & 3) + 8 * (r >> 2); ATT_MSK(p0[r], c); ATT_MSK(p1[r], c + 32); }
#undef ATT_MSK
}
__device__ __forceinline__ void partialSM(f32x16& p0, f32x16& p1, float& m_reg, float& mn, float& alpha, const float SCALE) {
    float pmax = p0[0];
#pragma unroll
    for (int r = 1; r < 16; ++r) pmax = fmaxf(pmax, p0[r]);
#pragma unroll
    for (int r = 0; r < 16; ++r) pmax = fmaxf(pmax, p1[r]);
    { auto rr = __builtin_amdgcn_permlane32_swap(__float_as_uint(pmax), __float_as_uint(pmax), false, false);
      pmax = fmaxf(__uint_as_float(rr[0]), __uint_as_float(rr[1])); }
    const float C2 = 1.4426950408889634f * SCALE;
    if (__builtin_expect(__all((pmax - m_reg) * SCALE <= THR), 1)) { mn = m_reg; alpha = 1.f; }
    else { mn = fmaxf(m_reg, pmax); alpha = __builtin_amdgcn_exp2f((m_reg - mn) * C2); m_reg = mn; }
    const float mnL = -mn * C2;
#pragma unroll
    for (int r = 0; r < 16; ++r) p0[r] = fmaf(p0[r], C2, mnL);
#pragma unroll
    for (int r = 0; r < 16; ++r) p1[r] = fmaf(p1[r], C2, mnL);
#pragma unroll
    for (int r = 0; r < 16; ++r) p0[r] = __builtin_amdgcn_exp2f(p0[r]);
}
__device__ __forceinline__ void finishSM(f32x16& p0, f32x16& p1, float alpha, float& l_reg, bf16x8& pa0, bf16x8& pa1, bf16x8& pa2, bf16x8& pa3) {
#pragma unroll
    for (int r = 0; r < 16; ++r) p1[r] = __builtin_amdgcn_exp2f(p1[r]);
    float ps = 0;
#pragma unroll
    for (int r = 0; r < 16; ++r) ps += p0[r];
#pragma unroll
    for (int r = 0; r < 16; ++r) ps += p1[r];
    { auto rr = __builtin_amdgcn_permlane32_swap(__float_as_uint(ps), __float_as_uint(ps), false, false);
      ps = __uint_as_float(rr[0]) + __uint_as_float(rr[1]); }
    l_reg = l_reg * alpha + ps;
#define ATT_PK4(P, B_, OUT) do { unsigned a0 = cvtpk(P[B_+0], P[B_+1]), a1 = cvtpk(P[B_+2], P[B_+3]);                          \
        unsigned b0 = cvtpk(P[B_+4], P[B_+5]), b1 = cvtpk(P[B_+6], P[B_+7]);                                             \
        auto r0 = __builtin_amdgcn_permlane32_swap(a0, b0, false, false); auto r1 = __builtin_amdgcn_permlane32_swap(a1, b1, false, false); \
        u32x4 w = {r0[0], r1[0], r0[1], r1[1]}; OUT = *reinterpret_cast<bf16x8*>(&w); } while (0)
    ATT_PK4(p0, 0, pa0); ATT_PK4(p0, 8, pa1); ATT_PK4(p1, 0, pa2); ATT_PK4(p1, 8, pa3);
#undef ATT_PK4
}
template <int VB>
__device__ __forceinline__ void pv_tile(f32x16* o, int vb0, bf16x8 pa0, bf16x8 pa1, bf16x8 pa2, bf16x8 pa3) {
#define ATT_TRRD(dst, off) asm volatile("ds_read_b64_tr_b16 %0, %1 offset:%2" : "=&v"(dst) : "v"(vb0), "i"(off) : "memory")
#ifndef ATT_PV_SPLIT
#define ATT_PV_SPLIT 0
#endif
#if ATT_PV_SPLIT
#define ATT_PV_D0(d0) do { s16x4 l0, l1, h0, h1; constexpr int b_ = VB * SHM_V + v_rd_off(d0, 0, 0); \
        ATT_TRRD(l0, b_); ATT_TRRD(h0, b_ + 2048); ATT_TRRD(l1, b_ + 4096); ATT_TRRD(h1, b_ + 6144); \
        asm volatile("s_waitcnt lgkmcnt(0)" ::: "memory"); ATT_SBAR();   \
        o[d0] = __builtin_amdgcn_mfma_f32_32x32x16_bf16(pa0, (bf16x8){l0[0], l0[1], l0[2], l0[3], h0[0], h0[1], h0[2], h0[3]}, o[d0], 0, 0, 0);   \
        o[d0] = __builtin_amdgcn_mfma_f32_32x32x16_bf16(pa1, (bf16x8){l1[0], l1[1], l1[2], l1[3], h1[0], h1[1], h1[2], h1[3]}, o[d0], 0, 0, 0);   \
        ATT_SBAR(); ATT_TRRD(l0, b_ + 8192); ATT_TRRD(h0, b_ + 10240); ATT_TRRD(l1, b_ + 12288); ATT_TRRD(h1, b_ + 14336); \
        asm volatile("s_waitcnt lgkmcnt(0)" ::: "memory"); ATT_SBAR();   \
        o[d0] = __builtin_amdgcn_mfma_f32_32x32x16_bf16(pa2, (bf16x8){l0[0], l0[1], l0[2], l0[3], h0[0], h0[1], h0[2], h0[3]}, o[d0], 0, 0, 0);   \
        o[d0] = __builtin_amdgcn_mfma_f32_32x32x16_bf16(pa3, (bf16x8){l1[0], l1[1], l1[2], l1[3], h1[0], h1[1], h1[2], h1[3]}, o[d0], 0, 0, 0); } while (0)
#else
#define ATT_PV_D0(d0) do { s16x4 l0, l1, l2, l3, h0, h1, h2, h3; constexpr int b_ = VB * SHM_V + v_rd_off(d0, 0, 0); \
        ATT_TRRD(l0, b_); ATT_TRRD(h0, b_ + 2048); ATT_TRRD(l1, b_ + 4096); ATT_TRRD(h1, b_ + 6144); ATT_TRRD(l2, b_ + 8192); ATT_TRRD(h2, b_ + 10240); ATT_TRRD(l3, b_ + 12288); ATT_TRRD(h3, b_ + 14336); \
        asm volatile("s_waitcnt lgkmcnt(0)" ::: "memory"); ATT_SBAR();   \
        o[d0] = __builtin_amdgcn_mfma_f32_32x32x16_bf16(pa0, (bf16x8){l0[0], l0[1], l0[2], l0[3], h0[0], h0[1], h0[2], h0[3]}, o[d0], 0, 0, 0);   \
        o[d0] = __builtin_amdgcn_mfma_f32_32x32x16_bf16(pa1, (bf16x8){l1[0], l1[1], l1[2], l1[3], h1[0], h1[1], h1[2], h1[3]}, o[d0], 0, 0, 0);   \
        o[d0] = __builtin_amdgcn_mfma_f32_32x32x16_bf16(pa2, (bf16x8){l2[0], l2[1], l2[2], l2[3], h2[0], h2[1], h2[2], h2[3]}, o[d0], 0, 0, 0);   \
        o[d0] = __builtin_amdgcn_mfma_f32_32x32x16_bf16(pa3, (bf16x8){l3[0], l3[1], l3[2], l3[3], h3[0], h3[1], h3[2], h3[3]}, o[d0], 0, 0, 0); } while (0)
#endif
    ATT_PV_D0(0); ATT_PV_D0(1); ATT_PV_D0(2); ATT_PV_D0(3);
#undef ATT_PV_D0
#undef ATT_TRRD
}

template <int VB>
__device__ __forceinline__ void pv_sm(f32x16* o, int vb0, bf16x8 pa0, bf16x8 pa1, bf16x8 pa2, bf16x8 pa3, f32x16& p0, f32x16& p1, float& m_reg, float& mn, float& alpha, const float SCALE) {
#define ATT_TRRD(dst, off) asm volatile("ds_read_b64_tr_b16 %0, %1 offset:%2" : "=&v"(dst) : "v"(vb0), "i"(off) : "memory")
#define ATT_RD4(base_) ATT_TRRD(l0, base_); ATT_TRRD(h0, base_ + 2048); ATT_TRRD(l1, base_ + 4096); ATT_TRRD(h1, base_ + 6144)
#define ATT_MM2(d0, pa_, pb_) do { asm volatile("s_waitcnt lgkmcnt(0)" : "+v"(l0), "+v"(h0), "+v"(l1), "+v"(h1) :: "memory"); ATT_SBAR();                        \
        o[d0] = __builtin_amdgcn_mfma_f32_32x32x16_bf16(pa_, (bf16x8){l0[0], l0[1], l0[2], l0[3], h0[0], h0[1], h0[2], h0[3]}, o[d0], 0, 0, 0);   \
        o[d0] = __builtin_amdgcn_mfma_f32_32x32x16_bf16(pb_, (bf16x8){l1[0], l1[1], l1[2], l1[3], h1[0], h1[1], h1[2], h1[3]}, o[d0], 0, 0, 0); ATT_SBAR(); } while (0)
    const float C2 = 1.4426950408889634f * SCALE;
    s16x4 l0, l1, h0, h1; constexpr int b0_ = VB * SHM_V;
    ATT_RD4(b0_ + v_rd_off(0, 0, 0));
    float ma = fmaxf(fmaxf(p0[0], p0[1]), p0[2]);
#pragma unroll
    for (int r = 3; r < 15; r += 2) ma = fmaxf(fmaxf(ma, p0[r]), p0[r + 1]);
    ma = fmaxf(ma, p0[15]);
    ATT_MM2(0, pa0, pa1);
    ATT_RD4(b0_ + v_rd_off(0, 0, 0) + 8192);
    float mb = fmaxf(fmaxf(p1[0], p1[1]), p1[2]);
#pragma unroll
    for (int r = 3; r < 15; r += 2) mb = fmaxf(fmaxf(mb, p1[r]), p1[r + 1]);
    mb = fmaxf(mb, p1[15]);
    ATT_MM2(0, pa2, pa3);
    ATT_RD4(b0_ + v_rd_off(1, 0, 0));
    float pmax = fmaxf(ma, mb);
    { auto rr = __builtin_amdgcn_permlane32_swap(__float_as_uint(pmax), __float_as_uint(pmax), false, false); pmax = fmaxf(__uint_as_float(rr[0]), __uint_as_float(rr[1])); }
    const bool keep = __all((pmax - m_reg) * SCALE <= THR);
    mn = keep ? m_reg : fmaxf(m_reg, pmax); alpha = __builtin_amdgcn_exp2f((m_reg - mn) * C2); m_reg = mn;
    const float mnL = -mn * C2;
#define ATT_VFMA(x) asm volatile("v_fma_f32 %0, %0, %1, %2" : "+v"(x) : "s"(C2), "v"(mnL))
#define ATT_VEXP(x) asm volatile("v_exp_f32 %0, %0" : "+v"(x))
    ATT_MM2(1, pa0, pa1);
    ATT_RD4(b0_ + v_rd_off(1, 0, 0) + 8192);
#pragma unroll
    for (int r = 0; r < 16; ++r) ATT_VFMA(p0[r]);
    ATT_MM2(1, pa2, pa3);
    ATT_RD4(b0_ + v_rd_off(2, 0, 0));
#pragma unroll
    for (int r = 0; r < 16; ++r) ATT_VFMA(p1[r]);
#pragma unroll
    for (int r = 0; r < 4; ++r) ATT_VEXP(p0[r]);
    ATT_MM2(2, pa0, pa1);
    ATT_RD4(b0_ + v_rd_off(2, 0, 0) + 8192);
#pragma unroll
    for (int r = 4; r < 8; ++r) ATT_VEXP(p0[r]);
    ATT_MM2(2, pa2, pa3);
    ATT_RD4(b0_ + v_rd_off(3, 0, 0));
#pragma unroll
    for (int r = 8; r < 12; ++r) ATT_VEXP(p0[r]);
    ATT_MM2(3, pa0, pa1);
    ATT_RD4(b0_ + v_rd_off(3, 0, 0) + 8192);
#pragma unroll
    for (int r = 12; r < 16; ++r) ATT_VEXP(p0[r]);
    ATT_MM2(3, pa2, pa3);
#undef ATT_VFMA
#undef ATT_VEXP
#undef ATT_MM2
#undef ATT_RD4
#undef ATT_TRRD
}

template <int DQK, int LDQ, int LDKV, int LDO, int BIAS, int QL, class TOut>
struct Body {
    static constexpr int RB = DQK * 2, SHM_K = KVBLK * RB, NKL = (DQK == 192) ? 4 : 2, ND0 = DQK / 16, ND0R = ND0 - QL;
    static constexpr bool TAB = (BIAS == 1 || BIAS == 2);
    static constexpr int OFF_K = 2 * SHM_V, OFF_WS = OFF_K + 2 * SHM_K, OFF_B = OFF_WS + NW * 64 * 4, OFF_Q = OFF_B + 512, LDS_BYTES = OFF_Q + NW * QL * 1024;
    struct Ref { const bf16_t* Q; const bf16_t* K; const bf16_t* V; TOut* O; const float* kb; float bs; int P0, jlo; };
    struct Seam { bf16x8 qr[ND0R > 0 ? ND0R : 1]; bf16x8 st_v0, st_v1; bf16x8 st_k[NKL]; float st_b; };
    template <int KB>
    static __device__ __forceinline__ void qkt(f32x16& p0, f32x16& p1, const char* K_lds, const char* B_lds, const char* Q_lds, int r32, int hi, const bf16x8* qr, float bs, float lb) {
        if (BIAS == 1) { p0 = *reinterpret_cast<const f32x16*>(B_lds + KB * 256 + hi * 128); p1 = *reinterpret_cast<const f32x16*>(B_lds + KB * 256 + hi * 128 + 64); }
        else if (BIAS == 3) {
            const float bs8 = 8.f * bs, bs32 = 32.f * bs;
            p0[0] = lb; p0[1] = p0[0] + bs; p0[2] = p0[1] + bs; p0[3] = p0[2] + bs;
#pragma unroll
            for (int r = 4; r < 16; ++r) p0[r] = p0[r - 4] + bs8;
#pragma unroll
            for (int r = 0; r < 16; ++r) p1[r] = p0[r] + bs32;
        }
        else { p0 = f32x16{}; p1 = f32x16{}; }
        const char* kb[4];
#pragma unroll
        for (int dd = 0; dd < 4; ++dd) kb[dd] = K_lds + KB * SHM_K + r32 * RB + ((dd * 32 + hi * 16) ^ ((r32 & 7) << 4));
#pragma unroll
        for (int d0 = 0; d0 < ND0; ++d0) { const char* a = kb[d0 & 3] + (d0 >> 2) * 128;
            bf16x8 b0 = *reinterpret_cast<const bf16x8*>(a);
            bf16x8 b1 = *reinterpret_cast<const bf16x8*>(a + 32 * RB);
            bf16x8 q; if (d0 < ND0R) q = qr[d0 < ND0R ? d0 : 0]; else q = *reinterpret_cast<const bf16x8*>(Q_lds + (d0 - ND0R) * 1024);
            p0 = __builtin_amdgcn_mfma_f32_32x32x16_bf16(b0, q, p0, 0, 0, 0);
            p1 = __builtin_amdgcn_mfma_f32_32x32x16_bf16(b1, q, p1, 0, 0, 0); }
    }
    static __device__ __forceinline__ void add_bias(f32x16& p0, f32x16& p1, const char* B_lds, int kbuf, int hi) {
#pragma unroll
        for (int g = 0; g < 4; ++g) { const f32x4 b0 = *reinterpret_cast<const f32x4*>(B_lds + kbuf * 256 + hi * 128 + g * 16), b1 = *reinterpret_cast<const f32x4*>(B_lds + kbuf * 256 + hi * 128 + 64 + g * 16);
            p0[4 * g + 0] += b0[0]; p0[4 * g + 1] += b0[1]; p0[4 * g + 2] += b0[2]; p0[4 * g + 3] += b0[3]; p1[4 * g + 0] += b1[0]; p1[4 * g + 1] += b1[1]; p1[4 * g + 2] += b1[2]; p1[4 * g + 3] += b1[3]; }
    }
#define ATT_VMW() asm volatile("s_waitcnt vmcnt(0)" ::: "memory")
#define ATT_VMWN(n) asm volatile("s_waitcnt vmcnt(%0)" :: "i"(n) : "memory")
#define ATT_SLOAD(Kp, Vp, Bp, k0) do { const size_t o_ = (size_t)((k0) + sr) * LDKV + sc; S.st_v0 = ld8((Vp) + o_); S.st_v1 = ld8((Vp) + o_ + 32 * LDKV);              \
        if (DQK >= 128 || sc < 64) { S.st_k[0] = ld8((Kp) + o_); S.st_k[1] = ld8((Kp) + o_ + 32 * LDKV); }                                                             \
        if (DQK == 192) { if (sc < 64) { S.st_k[NKL - 2] = ld8((Kp) + o_ + 128); S.st_k[NKL - 1] = ld8((Kp) + o_ + 32 * LDKV + 128); } }                                \
        if (TAB) { S.st_b = (Bp)[(k0) + lane]; } } while (0)
#define ATT_SWRITE_K(bf) do { if (DQK >= 128 || sc < 64) { *(bf16x8*)(K_lds + (bf) * SHM_K + kws) = S.st_k[0]; *(bf16x8*)(K_lds + (bf) * SHM_K + kws + 32 * RB) = S.st_k[1]; }   \
        if (DQK == 192) { if (sc < 64) { *(bf16x8*)(K_lds + (bf) * SHM_K + kws + 256) = S.st_k[NKL - 2]; *(bf16x8*)(K_lds + (bf) * SHM_K + kws + 32 * RB + 256) = S.st_k[NKL - 1]; } }  \
        if (TAB) { *(float*)(B_lds + (bf) * 256 + bws) = S.st_b; } } while (0)
#define ATT_SWRITE_V(bf) do { *(bf16x8*)(V_lds + (bf) * SHM_V + vst0) = S.st_v0; *(bf16x8*)(V_lds + (bf) * SHM_V + vst1) = S.st_v1; } while (0)
#define ATT_QLOAD(Qp) do { _Pragma("unroll") for (int d0 = 0; d0 < ND0R; ++d0) S.qr[d0] = ld8((Qp) + (size_t)(wid * QBLK + r32) * LDQ + d0 * 16 + hi * 8); } while (0)
#define ATT_QSPILL(Qp) do { if (QL > 0) { bf16x8 t_[QL > 0 ? QL : 1]; _Pragma("unroll") for (int j_ = 0; j_ < QL; ++j_) t_[j_] = ld8((Qp) + (size_t)(wid * QBLK + r32) * LDQ + (ND0R + j_) * 16 + hi * 8);   \
        _Pragma("unroll") for (int j_ = 0; j_ < QL; ++j_) *(bf16x8*)(Q_lds + j_ * 1024) = t_[j_]; } } while (0)
    static __device__ __forceinline__ void prime(const Ref& cur, char* lds, Seam& S) {
        const int tid = threadIdx.x, wid = __builtin_amdgcn_readfirstlane(tid >> 6), lane = tid & 63, r32 = lane & 31, hi = lane >> 5;
        const int sr = tid >> 4, sc = (tid & 15) * 8, kws = sr * RB + (sc >> 6) * 128 + (((sc & 63) * 2) ^ ((sr & 7) << 4));
        const int bws = ((((lane & 31) >> 2) & 1) * 32 + (lane >> 5) * 16 + (lane & 3) + 4 * ((lane & 31) >> 3)) * 4; (void)bws;
        char* K_lds = lds + OFF_K; char* B_lds = lds + OFF_B; (void)B_lds; char* Q_lds = lds + OFF_Q + wid * (QL * 1024) + lane * 16; (void)Q_lds;
        const int kb0 = cur.jlo * KVBLK;
        ATT_QLOAD(cur.Q);
        ATT_SLOAD(cur.K, cur.V, cur.kb, kb0); ATT_VMW(); ATT_SWRITE_K(0); ATT_QSPILL(cur.Q);
        __syncthreads();
    }
    template <class NF>
    static __device__ __forceinline__ void block(const Ref& cur, NF& nf, char* lds, Seam& S, const float SCALE) {
        const int tid = threadIdx.x, wid = __builtin_amdgcn_readfirstlane(tid >> 6), lane = tid & 63, r32 = lane & 31, hi = lane >> 5;
        const int j_lo = cur.jlo, j_hi = (cur.P0 + QB - 1) / KVBLK + 1;
        const int NT = j_hi - j_lo;
        const int qlo = cur.P0 + wid * QBLK, qm = qlo + r32 - 4 * hi;
        char* V_lds = lds; char* K_lds = lds + OFF_K; char* B_lds = lds + OFF_B; (void)B_lds; char* Q_lds = lds + OFF_Q + wid * (QL * 1024) + lane * 16; (void)Q_lds;
        float* ws = (float*)(lds + OFF_WS) + wid * 64; float* li_l = ws, * al_l = ws + 32;
        float m_reg = -1e30f, l_reg = 0; f32x16 o[4] = {};
        const int sr = tid >> 4, sc = (tid & 15) * 8, vst0 = v_st(sr, sc), vst1 = v_st(32 + sr, sc);
        const int kws = sr * RB + (sc >> 6) * 128 + (((sc & 63) * 2) ^ ((sr & 7) << 4));
        const int bws = ((((lane & 31) >> 2) & 1) * 32 + (lane >> 5) * 16 + (lane & 3) + 4 * ((lane & 31) >> 3)) * 4; (void)bws;
        const int vb0 = (int)(uintptr_t)V_lds + v_rd_base(lane);
        const bf16_t* Kh = cur.K; const bf16_t* Vh = cur.V; const float* Bh = cur.kb; const float bs = cur.bs; (void)bs;
#define ATT_RESC(a) do { if (__any((a) < 1.f)) { if (hi == 0) al_l[r32] = (a); asm volatile("s_waitcnt lgkmcnt(0)" ::: "memory");              \
                     _Pragma("unroll") for (int d_ = 0; d_ < 4; ++d_) _Pragma("unroll") for (int r = 0; r < 16; ++r) o[d_][r] *= al_l[crow(r, hi)]; } } while (0)
#define ATT_KBASE(t) ((j_lo + (t)) * KVBLK)
#define ATT_LB(t) ((BIAS == 3) ? bs * (float)(ATT_KBASE(t) - cur.P0 + 4 * hi) : 0.f)
#define ATT_MASKT(P0_, P1_, t, KB_) do { const int kb_ = ATT_KBASE(t); if (BIAS == 2) add_bias(P0_, P1_, B_lds, KB_, hi);                              \
        if (kb_ + KVBLK - 1 > qlo) mask_tile(P0_, P1_, qm - kb_); } while (0)
#define ATT_SEAM_K0() do { ATT_VMWN(ND0R); ATT_SWRITE_K(0); ATT_SBAR(); } while (0)
        f32x16 pA0, pA1, pB0, pB1; float mnA, mnB, alA, alB; bf16x8 pa0, pa1, pa2, pa3;
        ATT_SWRITE_V(0); ATT_SBAR();
        if (NT > 1) { ATT_SLOAD(Kh, Vh, Bh, ATT_KBASE(1)); }
        ATT_SBAR(); qkt<0>(pA0, pA1, K_lds, B_lds, Q_lds, r32, hi, S.qr, bs, ATT_LB(0));
        ATT_MASKT(pA0, pA1, 0, 0); partialSM(pA0, pA1, m_reg, mnA, alA, SCALE);
        if (NT > 1) { ATT_VMW(); ATT_SWRITE_V(1); ATT_SWRITE_K(1); }
        __syncthreads();
#define ATT_HALF_STEP(PX0, PX1, mnX, alX, PY0, PY1, alY, t, KB, VB, SB) do {                                                      \
        ATT_SBAR(); qkt<KB>(PX0, PX1, K_lds, B_lds, Q_lds, r32, hi, S.qr, bs, ATT_LB(t));                                                    \
        finishSM(PY0, PY1, alY, l_reg, pa0, pa1, pa2, pa3); ATT_SBAR();                                                           \
        if ((t) + 1 < NT) { ATT_SLOAD(Kh, Vh, Bh, ATT_KBASE((t) + 1)); ATT_SBAR(); }                                              \
        ATT_MASKT(PX0, PX1, (t), KB); ATT_SBAR(); pv_sm<VB>(o, vb0, pa0, pa1, pa2, pa3, PX0, PX1, m_reg, mnX, alX, SCALE);                        \
        __syncthreads();                                                                                                      \
        if ((t) + 1 < NT) { ATT_VMW(); ATT_SWRITE_V(SB); ATT_SWRITE_K(SB); }                                                      \
        ATT_RESC(alX); __syncthreads(); } while (0)
        bool issued = false;
        for (int t = 1; t + 1 < NT; t += 2) {
            if (!issued && t + 8 >= NT) { nf.issue(); issued = true; }
            ATT_HALF_STEP(pB0, pB1, mnB, alB, pA0, pA1, alA, t, 1, 0, 0);
            ATT_HALF_STEP(pA0, pA1, mnA, alA, pB0, pB1, alB, t + 1, 0, 1, 1);
        }
        const bool even = (NT & 1) == 0;
        if (even) { ATT_SBAR(); qkt<1>(pB0, pB1, K_lds, B_lds, Q_lds, r32, hi, S.qr, bs, ATT_LB(NT - 1)); ATT_SBAR(); }
        if (!issued) nf.issue();
        const Ref nxt = nf.get(cur); const int kbn = nxt.jlo * KVBLK;
        ATT_SLOAD(nxt.K, nxt.V, nxt.kb, kbn); ATT_SBAR();
        ATT_QLOAD(nxt.Q);
        ATT_SBAR();
        finishSM(pA0, pA1, alA, l_reg, pa0, pa1, pa2, pa3); ATT_SBAR();
        pv_tile<0>(o, vb0, pa0, pa1, pa2, pa3);
        if (even) { ATT_MASKT(pB0, pB1, NT - 1, 1); partialSM(pB0, pB1, m_reg, mnB, alB, SCALE); __syncthreads(); ATT_RESC(alB);
            finishSM(pB0, pB1, alB, l_reg, pa0, pa1, pa2, pa3); ATT_SBAR(); pv_tile<1>(o, vb0, pa0, pa1, pa2, pa3); }
        ATT_SBAR(); ATT_SEAM_K0();
        if (hi == 0) li_l[r32] = l_reg; asm volatile("s_waitcnt lgkmcnt(0)" ::: "memory");
        float rli[16];
#pragma unroll
        for (int r = 0; r < 16; ++r) rli[r] = __builtin_amdgcn_rcpf(li_l[crow(r, hi)]);
        TOut* Ow = cur.O + (size_t)(wid * QBLK) * LDO;
        if constexpr (sizeof(TOut) == 4) {
#pragma unroll
            for (int r = 0; r < 16; ++r) { const int orow = crow(r, hi);
#pragma unroll
                for (int d0 = 0; d0 < 4; ++d0) Ow[(size_t)orow * LDO + d0 * 32 + r32] = o[d0][r] * rli[r]; }
        } else {
            const bool odd = (r32 & 1) != 0; bf16_t* Ob = (bf16_t*)Ow + (odd ? 32 + r32 - 1 : r32);
#pragma unroll
            for (int r = 0; r < 16; ++r) { const int orow = crow(r, hi); const float v0 = o[0][r] * rli[r], v1 = o[1][r] * rli[r], v2 = o[2][r] * rli[r], v3 = o[3][r] * rli[r];
                const float s01 = odd ? v0 : v1, s23 = odd ? v2 : v3;
                const float g01 = __builtin_bit_cast(float, __builtin_amdgcn_update_dpp(0, __builtin_bit_cast(int, s01), 0xB1, 0xF, 0xF, false));
                const float g23 = __builtin_bit_cast(float, __builtin_amdgcn_update_dpp(0, __builtin_bit_cast(int, s23), 0xB1, 0xF, 0xF, false));
                const unsigned w01 = odd ? cvtpk(g01, v1) : cvtpk(v0, g01), w23 = odd ? cvtpk(g23, v3) : cvtpk(v2, g23);
                *(unsigned*)(Ob + (size_t)orow * LDO) = w01; *(unsigned*)(Ob + (size_t)orow * LDO + 64) = w23; }
        }
        ATT_QSPILL(nxt.Q);
        __syncthreads();
#undef ATT_RESC
#undef ATT_KBASE
#undef ATT_LB
#undef ATT_MASKT
#undef ATT_SEAM_K0
#undef ATT_HALF_STEP
    }
#undef ATT_VMW
#undef ATT_VMWN
#undef ATT_SLOAD
#undef ATT_SWRITE_K
#undef ATT_SWRITE_V
#undef ATT_QLOAD
#undef ATT_QSPILL
};
template <class B> struct StaticNext { typename B::Ref nxt; __device__ __forceinline__ void issue() {} __device__ __forceinline__ typename B::Ref get(const typename B::Ref&) { return nxt; } };
template <class B, class Dec>
__device__ __forceinline__ void stream(char* lds, int nblk, const Dec& dec, const float scale) {
    if (nblk <= 0) return;
    typename B::Ref cur = dec(0); typename B::Seam S;
    B::prime(cur, lds, S);
    for (int n = 0; n < nblk; ++n) {
        StaticNext<B> nf; nf.nxt = (n + 1 < nblk) ? dec(n + 1) : cur;
        B::block(cur, nf, lds, S, scale);
        cur = nf.nxt;
    }
}
template <class B, class Dec> struct QueueNext {
    unsigned* ctr; volatile __attribute__((address_space(3))) unsigned* slot; const Dec* dec; int total; unsigned claim; bool more; int pnext;
    __device__ __forceinline__ void issue() { if (threadIdx.x == 0) claim = __hip_atomic_fetch_add(ctr, 1u, __ATOMIC_RELAXED, __HIP_MEMORY_SCOPE_AGENT); }
    __device__ __forceinline__ typename B::Ref get(const typename B::Ref& cur) {
        if (threadIdx.x == 0) slot[2] = claim;
        __syncthreads();
        const int p = (int)slot[2]; more = p < total; pnext = p;
        return more ? (*dec)(p) : cur; }
    __device__ __forceinline__ typename B::Ref get_last() const { return (*dec)(pnext); }
};
template <class B, class Dec>
__device__ __forceinline__ void stream_dyn(char* lds, int total, unsigned* ctr, volatile __attribute__((address_space(3))) unsigned* slot, const Dec& dec, const float scale) {
    if (threadIdx.x == 0) slot[0] = __hip_atomic_fetch_add(ctr, 1u, __ATOMIC_RELAXED, __HIP_MEMORY_SCOPE_AGENT);
    __syncthreads();
    const int pc = (int)slot[0];
    if (pc >= total) return;
    typename B::Ref cur = dec(pc); typename B::Seam S;
    B::prime(cur, lds, S);
    QueueNext<B, Dec> nf; nf.ctr = ctr; nf.slot = slot; nf.dec = &dec; nf.total = total; nf.claim = 0u; nf.more = false;
    for (;;) {
        B::block(cur, nf, lds, S, scale);
        if (!nf.more) break;
        cur = nf.get_last(); }
}
#undef ATT_SBAR
}
#define GAS __attribute__((address_space(1)))
#define LAS __attribute__((address_space(3)))
typedef unsigned short bf16;
typedef unsigned v4u __attribute__((ext_vector_type(4)));
typedef float f32x4 __attribute__((ext_vector_type(4)));
typedef short bf16x8 __attribute__((ext_vector_type(8)));
typedef GAS unsigned gu32;
typedef GAS unsigned long long gu64;
#define RLX_AGENT __ATOMIC_RELAXED, __HIP_MEMORY_SCOPE_AGENT
#define LDS_WAIT() asm volatile("s_waitcnt lgkmcnt(0)" ::: "memory")
#define VM_WAIT() asm volatile("s_waitcnt vmcnt(0)" ::: "memory")
__device__ __forceinline__ unsigned long long rt() { return __builtin_amdgcn_s_memrealtime(); }
__device__ __forceinline__ unsigned f2bf(float f) { unsigned u = __builtin_bit_cast(unsigned, f); return (u + 0x7fffu + ((u >> 16) & 1u)) >> 16; }
__device__ __forceinline__ unsigned pk2(float lo, float hi) { return f2bf(lo) | (f2bf(hi) << 16); }

#define XB_TMO      128
#define XB_XCNT(j)  (256  + 64 * (j))
#define XB_XSUB(j)  (1280 + 64 * (j))
#define XB_XGEN(j)  (2304 + 64 * (j))
#define XB_TOP      3328
#define XB_TOPGEN   3392
#define XCD_BAR_WORDS 3456
#define XB_SPIN_CAP (1u << 18)

__device__ __forceinline__ unsigned xb_ld(unsigned* p)              { return __hip_atomic_load(p, __ATOMIC_RELAXED, __HIP_MEMORY_SCOPE_AGENT); }
__device__ __forceinline__ unsigned xb_add(unsigned* p, unsigned v) { return __hip_atomic_fetch_add(p, v, __ATOMIC_RELAXED, __HIP_MEMORY_SCOPE_AGENT); }
__device__ __forceinline__ unsigned xb_xcc_id() { return (unsigned)__builtin_amdgcn_s_getreg((3 << 11) | 20) & 0xFu; }
#define XB_SPIN(cond, bar) do { unsigned _sp = 0; while (cond) { __builtin_amdgcn_s_sleep(1); \
    if ((++_sp & 255u) == 0u) { if (xb_ld(&(bar)[XB_TMO])) break; if (_sp > XB_SPIN_CAP) { atomicAdd(&(bar)[XB_TMO], 1u); break; } } } } while (0)

struct XcdBarrier {
    unsigned* bar; unsigned x;
    volatile LAS unsigned* st;
};

__device__ __forceinline__ XcdBarrier xcd_barrier_post(unsigned* bar, volatile LAS unsigned* st) {
    XcdBarrier b; b.bar = bar; b.x = xb_xcc_id(); b.st = st;
    if (threadIdx.x == 0) (void)xb_add(&bar[XB_XCNT(b.x)], 1u);
    return b;
}
__device__ __forceinline__ void xcd_barrier_complete(unsigned* bar, unsigned x, unsigned& nloc, unsigned& nx) {
    const unsigned G = gridDim.x * gridDim.y * gridDim.z;
    unsigned sum, cnt, mine, sp = 0u;
    for (;;) {
        sum = 0u; cnt = 0u; mine = 0u;
#pragma unroll
        for (unsigned j = 0; j < 16; ++j) { const unsigned c = xb_ld(&bar[XB_XCNT(j)]); sum += c; cnt += (c > 0u) ? 1u : 0u; mine = (j == x) ? c : mine; }
        if (sum == G) break;
        __builtin_amdgcn_s_sleep(1);
        if ((++sp & 255u) == 0u) { if (xb_ld(&bar[XB_TMO])) break; if (sp > XB_SPIN_CAP) { atomicAdd(&bar[XB_TMO], 1u); break; } }
    }
    nloc = mine > 0u ? mine : 1u; nx = cnt > 0u ? cnt : 1u;
}

__device__ __forceinline__ void xcd_barrier(const XcdBarrier& b) {
    asm volatile("s_waitcnt vmcnt(0)" ::: "memory");
    __syncthreads();
    if (threadIdx.x == 0) {
        unsigned* bar = b.bar;
        __builtin_amdgcn_s_waitcnt(0);
        unsigned nloc = b.st[0], nx = b.st[1];
        if (nloc == 0u) { xcd_barrier_complete(bar, b.x, nloc, nx); b.st[0] = nloc; b.st[1] = nx; }
        const unsigned old = xb_add(&bar[XB_XSUB(b.x)], 1u);
        const unsigned gen = old / nloc;
        if (old + 1u == (gen + 1u) * nloc) {
            __builtin_amdgcn_fence(__ATOMIC_RELEASE, "agent");
            asm volatile("s_waitcnt vmcnt(0)" ::: "memory");
            const unsigned og = xb_add(&bar[XB_TOP], 1u);
            const unsigned tg = og / nx;
            if (og + 1u == (tg + 1u) * nx) xb_add(&bar[XB_TOPGEN], 1u);
            else XB_SPIN(xb_ld(&bar[XB_TOPGEN]) == tg, bar);
            __builtin_amdgcn_fence(__ATOMIC_ACQUIRE, "agent");
            xb_add(&bar[XB_XGEN(b.x)], 1u);
            asm volatile("s_waitcnt vmcnt(0)" ::: "memory");
        } else {
            XB_SPIN(xb_ld(&bar[XB_XGEN(b.x)]) == gen, bar);
            __builtin_amdgcn_fence(__ATOMIC_ACQUIRE, "agent");
            asm volatile("s_waitcnt vmcnt(0)" ::: "memory");
        }
    }
    __syncthreads();
}
constexpr int NWAVES = 8;
#ifndef MK_PER_PHASE
#define MK_PER_PHASE 0
#endif
constexpr int NPH = 21;

constexpr int S = 16384, DM = 2048, FF = 5632, NE = 8;
constexpr int N_IN0 = 4160, N_IN0P = 4352, N_IN1 = 6160, N_IN1P = 6400, NP0 = 4096;
constexpr float SCALE_A = 0.125f, SCALE_B = 0.07216878364870322f, SCALE_C = 0.08838834764831845f;

constexpr size_t MiB = 1u << 20;
constexpr size_t WS_CTL = 0, CTL_ZERO_BYTES = 1 * MiB;
constexpr size_t WS_ROPE = 1 * MiB, WS_KBC = 6 * MiB, WS_LOGF = 7 * MiB, WS_CSUM = 8 * MiB, WS_ROUTE = 8 * MiB + 512 * 1024, WS_CNTG = 9 * MiB, WS_TOT = 9 * MiB + 64 * 1024, WS_SCL = 9 * MiB + 64 * 1024 + 1024  ,
                 WS_TOKPOS = 9 * MiB + 512 * 1024, WS_GATES = 10 * MiB, WS_STATA = 5 * MiB, WS_STATC = 5 * MiB + 64 * 1024, WS_FPART = 11 * MiB, WS_KPART = 1096 * MiB, WS_PART = 880 * MiB,
                 WS_PS = 1 * MiB  , WS_RSTD = 5 * MiB + 256 * 1024, WS_RSTDS = 5 * MiB + 512 * 1024;
constexpr size_t WS_WIN0 = 16 * MiB, WS_WUQ = 33 * MiB, WS_WUKV = 35 * MiB, WS_WOUT0 = 37 * MiB, WS_WGU0 = 45 * MiB, WS_WD0 = 89 * MiB, WS_WIN1 = 111 * MiB, WS_WOUT1 = 136 * MiB,
                 WS_WGU1 = 144 * MiB, WS_WD1 = 496 * MiB;
constexpr size_t WS_XN = 672 * MiB;
constexpr size_t WS_PROJ0 = 736 * MiB, WS_CQN = 872 * MiB, WS_CKVN = 888 * MiB, WS_KF = 904 * MiB  , WS_QB = 984 * MiB, WS_OA = 1032 * MiB, WS_MIX = 1160 * MiB, WS_HMID0 = 736 * MiB;
constexpr size_t WS_A8 = 984 * MiB  , WS_QKV1 = 736 * MiB, WS_O1 = 928 * MiB, WS_AS = 736 * MiB, WS_HMS = 1024 * MiB, WS_YS = 736 * MiB;
constexpr size_t WS_END = 1398 * MiB;
constexpr int MPAD = 34816;
static_assert(WS_WD1 + (size_t)NE * DM * FF * 2 <= WS_XN && WS_HMS + (size_t)MPAD * FF * 2 <= WS_END && WS_YS + (size_t)MPAD * DM * 4 <= WS_HMS && WS_MIX + (size_t)S * DM * 2 <= WS_END, "d_ws map");
constexpr int CW_TMO = 0, CW_CODE = 1, CW_BAR = 4096, CW_QA = 8192, CW_QC = 8256, CW_SPLIT = 12288;

constexpr int RING_BYTES = 150528;
constexpr int LDSCTL_OFF = RING_BYTES, MISC_OFF = LDSCTL_OFF + 320;
constexpr int LDS_BYTES = RING_BYTES + 512;
static_assert(MISC_OFF + 128 <= LDS_BYTES, "LDS map");

typedef unsigned v2u __attribute__((ext_vector_type(2)));
__device__ __forceinline__ float bflo(unsigned w) { return __builtin_bit_cast(float, w << 16); }
__device__ __forceinline__ float bfhi(unsigned w) { return __builtin_bit_cast(float, w & 0xffff0000u); }
__device__ __forceinline__ float wave_sum(float v) {
#pragma unroll
    for (int o = 1; o < 64; o <<= 1) v += __shfl_xor(v, o);
    return v;
}
__device__ const float ROPE_INV[32] = {1.000000000e+00f, 7.498942614e-01f, 5.623413324e-01f, 4.216965139e-01f, 3.162277639e-01f, 2.371373773e-01f, 1.778279394e-01f, 1.333521307e-01f,
    1.000000015e-01f, 7.498941571e-02f, 5.623413250e-02f, 4.216965288e-02f, 3.162277490e-02f, 2.371373773e-02f, 1.778279431e-02f, 1.333521493e-02f, 9.999999776e-03f, 7.498941850e-03f,
    5.623413250e-03f, 4.216964822e-03f, 3.162277630e-03f, 2.371373586e-03f, 1.778279431e-03f, 1.333521446e-03f, 1.000000047e-03f, 7.498942432e-04f, 5.623413017e-04f, 4.216965172e-04f,
    3.162277571e-04f, 2.371373703e-04f, 1.778279402e-04f, 1.333521504e-04f};

struct Args { const float* in[27]; float* out; unsigned char* ws; int ph_lo, ph_hi; };
enum { I_X = 0, I_EV_ATTN_NORM, I_EV_W_IN, I_EV_Q_NORM, I_EV_W_UQ, I_EV_KV_NORM, I_EV_W_UKV, I_EV_LQ1, I_EV_LK1, I_EV_LQ2, I_EV_LK2, I_EV_SUBLN, I_EV_W_OUT, I_EV_FFN_NORM, I_EV_W_GATE, I_EV_W_UP,
       I_EV_W_DOWN, I_OD_ATTN_NORM, I_OD_W_IN, I_OD_FBIAS, I_OD_W_OUT, I_OD_FFN_NORM, I_OD_ROUTER, I_OD_W_GATE, I_OD_W_UP, I_OD_W_DOWN, I_FINAL_NORM };

__device__ __forceinline__ int rowmap(int type, int n) {
    if (type == 1) return (n >> 7) * 256 + (n & 127);
    if (type == 2) return (n >> 7) * 256 + 128 + (n & 127);
    if (type == 3) { const int h = n / 192, w = n - h * 192; if (w < 128) return h * 128 + w; const int i = w & 31, half = (w - 128) >> 5; return (4 + (h >> 2)) * 256 + half * 128 + (h & 3) * 32 + i; }
    return n;
}
using pg8::pk8x4;
constexpr float H8_SCALE = 8.f;
__device__ __forceinline__ unsigned pki8x4(float a, float b, float c, float d) {
    const int ia = (int)__builtin_rintf(__builtin_amdgcn_fmed3f(a, -127.f, 127.f)), ib = (int)__builtin_rintf(__builtin_amdgcn_fmed3f(b, -127.f, 127.f)), ic = (int)__builtin_rintf(__builtin_amdgcn_fmed3f(c, -127.f, 127.f)), id = (int)__builtin_rintf(__builtin_amdgcn_fmed3f(d, -127.f, 127.f));
    return ((unsigned)ia & 255u) | (((unsigned)ib & 255u) << 8) | (((unsigned)ic & 255u) << 16) | ((unsigned)id << 24); }
__device__ __forceinline__ float w_clip(const float* Wa, const float* Wb, int N, const float* gain, int lane) {
    float ss = 0.f;
#pragma unroll
    for (int k = 0; k < 16; ++k) { const float g = gain ? gain[k] : 1.f; const f32x4 a = *(const GAS f32x4*)(Wa + (size_t)k * N + 4 * lane) * g; ss += (a.x * a.x + a.y * a.y) + (a.z * a.z + a.w * a.w);
        if (Wb) { const f32x4 b = *(const GAS f32x4*)(Wb + (size_t)k * N + 4 * lane) * g; ss += (b.x * b.x + b.y * b.y) + (b.z * b.z + b.w * b.w); } }
    return fmaxf(4.f * sqrtf(wave_sum(ss) * (Wb ? 1.f / 8192.f : 1.f / 4096.f)), 1e-30f);
}
__device__ __forceinline__ float w_clip_experts(const float* Wa, const float* Wb, int K, int N, const float* gain, int lane) {
    float c = 0.f;
    for (int e = 0; e < NE; ++e) { float ss = 0.f;
#pragma unroll
        for (int k = 0; k < 2; ++k) { const float g = gain ? gain[k] : 1.f; const f32x4 a = *(const GAS f32x4*)(Wa + ((size_t)e * K + k) * N + 4 * lane) * g, b = *(const GAS f32x4*)(Wb + ((size_t)e * K + k) * N + 4 * lane) * g;
            ss += ((a.x * a.x + a.y * a.y) + (a.z * a.z + a.w * a.w)) + ((b.x * b.x + b.y * b.y) + (b.z * b.z + b.w * b.w)); }
        c = fmaxf(c, wave_sum(ss)); }
    return fmaxf(4.f * sqrtf(c * (1.f / 1024.f)), 1e-30f);
}
__device__ __forceinline__ float w8_scale_experts(const float* W, int K, int N, int lane) {
    float c = 0.f;
    for (int e = 0; e < NE; ++e) { float ss = 0.f;
#pragma unroll
        for (int k = 0; k < 2; ++k) { const f32x4 a = *(const GAS f32x4*)(W + ((size_t)e * K + k) * N + 4 * lane); ss += (a.x * a.x + a.y * a.y) + (a.z * a.z + a.w * a.w); }
        c = fmaxf(c, wave_sum(ss)); }
    return exp2f(floorf(log2f(2.f / fmaxf(sqrtf(c * (1.f / 512.f)), 1e-30f))));
}
struct TrJob { const float* W; int K, N; bf16* WT; int type, nbn, per, rows_per; const float* gain; int f8; float qs; int nb_lo; };
__device__ __forceinline__ void tr_load(const TrJob& J, int it, int lane, f32x4 (&v)[16]) {
    const int s = it / J.per, r = it - s * J.per, kb = r / J.nbn, nb = J.nb_lo + (r - kb * J.nbn);
    const int k0 = 64 * kb, n0 = 64 * nb, n4 = (lane & 15) * 4, kq = lane >> 4; const float* W = J.W + (size_t)s * J.K * J.N;
#pragma unroll
    for (int j = 0; j < 16; ++j) { const int k = 4 * j + kq; v[j] = (n0 + n4 < J.N) ? *(const GAS f32x4*)(W + (size_t)(k0 + k) * J.N + n0 + n4) : (f32x4){0.f, 0.f, 0.f, 0.f}; }
}
__device__ __forceinline__ void tr_store(const TrJob& J, int it, int lane, const f32x4 (&v)[16], LAS float* scr) {
    const int s = it / J.per, r = it - s * J.per, kb = r / J.nbn, nb = J.nb_lo + (r - kb * J.nbn);
    const int k0 = 64 * kb, n0 = 64 * nb, n4 = (lane & 15) * 4, kq = lane >> 4; bf16* WT = J.WT + (size_t)s * J.rows_per * J.K;
#pragma unroll
    for (int j = 0; j < 16; ++j) { const int k = 4 * j + kq; LAS float* d = scr + k * 65 + n4; d[0] = v[j].x; d[1] = v[j].y; d[2] = v[j].z; d[3] = v[j].w; }
    LDS_WAIT(); asm volatile("" ::: "memory");
    const int c = lane & 7;
    f32x4 g0 = (f32x4){1.f, 1.f, 1.f, 1.f}, g1 = g0; if (J.gain) { g0 = *(const GAS f32x4*)(J.gain + k0 + 8 * c); g1 = *(const GAS f32x4*)(J.gain + k0 + 8 * c + 4); }
#pragma unroll
    for (int i = 0; i < 8; ++i) { const int n = 8 * i + (lane >> 3); const LAS float* q = scr + (8 * c) * 65 + n;
        const float f0 = q[0 * 65] * g0.x, f1 = q[1 * 65] * g0.y, f2 = q[2 * 65] * g0.z, f3 = q[3 * 65] * g0.w, f4 = q[4 * 65] * g1.x, f5 = q[5 * 65] * g1.y, f6 = q[6 * 65] * g1.z, f7 = q[7 * 65] * g1.w;
        if (J.f8) { v2u o8; if (J.f8 == 2) { o8.x = pki8x4(f0 * J.qs, f1 * J.qs, f2 * J.qs, f3 * J.qs); o8.y = pki8x4(f4 * J.qs, f5 * J.qs, f6 * J.qs, f7 * J.qs); }
            else { o8.x = pk8x4(f0 * J.qs, f1 * J.qs, f2 * J.qs, f3 * J.qs); o8.y = pk8x4(f4 * J.qs, f5 * J.qs, f6 * J.qs, f7 * J.qs); }
            if (n0 + n < ((J.N + 31) & ~31)) *(GAS v2u*)((unsigned char*)J.WT + ((size_t)s * J.rows_per + rowmap(J.type, n0 + n)) * J.K + k0 + 8 * c) = o8; }
        else { v4u o; o.x = pg8::cvt_pk_bf16(f0, f1); o.y = pg8::cvt_pk_bf16(f2, f3); o.z = pg8::cvt_pk_bf16(f4, f5); o.w = pg8::cvt_pk_bf16(f6, f7);
            if (n0 + n < ((J.N + 31) & ~31)) *(GAS v4u*)(WT + (size_t)rowmap(J.type, n0 + n) * J.K + k0 + 8 * c) = o; } }
    LDS_WAIT(); asm volatile("" ::: "memory");
}
__device__ __forceinline__ void tr_matrix(const float* W, int K, int N, int NS, int rows_per, bf16* WT, int type, LAS float* scr, int gw, int NGW, int lane, const float* gain = nullptr, int f8 = 0, float qs = 0.f, int nb_lo = 0) {
    TrJob J; J.gain = gain; J.f8 = f8; J.qs = qs; J.nb_lo = nb_lo; J.W = W; J.K = K; J.N = N; J.WT = WT; J.type = type; J.nbn = (N + 63) / 64 - nb_lo; J.per = J.nbn * (K / 64); J.rows_per = rows_per;
    const int total = J.per * NS; int it = gw; if (it >= total) return;
    f32x4 va[16], vb[16];
    tr_load(J, it, lane, va);
    for (;;) {
        const int it2 = it + NGW; const bool h2 = it2 < total; if (h2) tr_load(J, it2, lane, vb);
        tr_store(J, it, lane, va, scr);
        if (!h2) break;
        const int it3 = it2 + NGW; const bool h3 = it3 < total; if (h3) tr_load(J, it3, lane, va);
        tr_store(J, it2, lane, vb, scr);
        if (!h3) break;
        it = it3;
    }
}
__device__ __forceinline__ void rms_row_bf16(const float* xrow, const float* g, bf16* orow, float eps, int lane, unsigned char* o8row = nullptr, float* cst = nullptr, float wsc = 0.f) {
    const GAS f32x4* xr = (const GAS f32x4*)xrow + lane; const GAS f32x4* gr = (const GAS f32x4*)g + lane;
    f32x4 v[8]; float s = 0.f;
#pragma unroll
    for (int j = 0; j < 8; ++j) { v[j] = xr[64 * j]; s += (v[j].x * v[j].x + v[j].y * v[j].y) + (v[j].z * v[j].z + v[j].w * v[j].w); }
    const float rstd = 1.0f / sqrtf(wave_sum(s) * (1.f / DM) + eps);
    GAS unsigned long long* o8 = (GAS unsigned long long*)orow + lane; float am = 0.f;
#pragma unroll
    for (int j = 0; j < 8; ++j) { const f32x4 gg = gr[64 * j]; const f32x4 y = (v[j] * rstd) * gg; o8[64 * j] = (unsigned long long)pk2(y.x, y.y) | ((unsigned long long)pk2(y.z, y.w) << 32);
        v[j] = y; am = fmaxf(am, fmaxf(fmaxf(fabsf(y.x), fabsf(y.y)), fmaxf(fabsf(y.z), fabsf(y.w)))); }
    if (o8row) {
#pragma unroll
        for (int o = 32; o > 0; o >>= 1) am = fmaxf(am, __shfl_xor(am, o));
        am = fmaxf(am, 1e-30f); const float qs = 127.f / am; GAS unsigned* q = (GAS unsigned*)o8row + lane;
#pragma unroll
        for (int j = 0; j < 8; ++j) q[64 * j] = pki8x4(v[j].x * qs, v[j].y * qs, v[j].z * qs, v[j].w * qs);
        if (lane == 0) *cst = (am * (1.f / 127.f)) * wsc; }
}
__device__ __forceinline__ void rstd_rows(const float* ps, float* rstd, int b, int G, int tid) {
    for (int row = b * (NWAVES * 64) + tid; row < S; row += G * NWAVES * 64) { const GAS f32x4* p = (const GAS f32x4*)(ps + (size_t)row * 32); float s = 0.f;
#pragma unroll
        for (int j = 0; j < 8; ++j) { const f32x4 v = p[j]; s += (v.x + v.y) + (v.z + v.w); }
        rstd[row] = 1.0f / sqrtf(s * (1.f / DM) + 1e-6f); }
}
__device__ __forceinline__ void rows_i8(const bf16* H, const float* ps, float* rstd, unsigned char* A8, float* cst, const float wsc, int gw, int NGW, int lane) {
    for (int row = gw; row < S; row += NGW) {
        const float rs = 1.0f / sqrtf(wave_sum(lane < 32 ? ps[(size_t)row * 32 + lane] : 0.f) * (1.f / DM) + 1e-6f);
        const GAS v4u* src = (const GAS v4u*)(H + (size_t)row * DM) + lane; const v4u x[4] = {src[0], src[64], src[128], src[192]}; float am = 0.f;
#pragma unroll
        for (int j = 0; j < 4; ++j) { am = fmaxf(am, fmaxf(fmaxf(fabsf(bflo(x[j].x)), fabsf(bfhi(x[j].x))), fmaxf(fabsf(bflo(x[j].y)), fabsf(bfhi(x[j].y))))); am = fmaxf(am, fmaxf(fmaxf(fabsf(bflo(x[j].z)), fabsf(bfhi(x[j].z))), fmaxf(fabsf(bflo(x[j].w)), fabsf(bfhi(x[j].w))))); }
#pragma unroll
        for (int o = 32; o > 0; o >>= 1) am = fmaxf(am, __shfl_xor(am, o));
        am = fmaxf(am, 1e-30f); const float qs = 127.f / am;
        GAS v2u* dst = (GAS v2u*)(A8 + (size_t)row * DM) + lane;
#pragma unroll
        for (int j = 0; j < 4; ++j) { v2u o; o.x = pki8x4(bflo(x[j].x) * qs, bfhi(x[j].x) * qs, bflo(x[j].y) * qs, bfhi(x[j].y) * qs); o.y = pki8x4(bflo(x[j].z) * qs, bfhi(x[j].z) * qs, bflo(x[j].w) * qs, bfhi(x[j].w) * qs); dst[64 * j] = o; }
        if (lane == 0) { rstd[row] = rs; cst[row] = (am * (1.f / 127.f)) * rs * wsc; } }
}
__device__ __forceinline__ void rms512_bf16(const bf16* src, const float* g, bf16* dst, int lane) {
    const v4u raw = *(const GAS v4u*)(src + 8 * lane);
    float x[8] = {bflo(raw.x), bfhi(raw.x), bflo(raw.y), bfhi(raw.y), bflo(raw.z), bfhi(raw.z), bflo(raw.w), bfhi(raw.w)};
    float s = 0.f;
#pragma unroll
    for (int e = 0; e < 8; ++e) s += x[e] * x[e];
    const float rstd = 1.0f / sqrtf(wave_sum(s) * (1.f / 512.f) + 1e-6f);
    const f32x4 g0 = *(const GAS f32x4*)(g + 8 * lane), g1 = *(const GAS f32x4*)(g + 8 * lane + 4);
    v4u o; o.x = pk2(x[0] * rstd * g0.x, x[1] * rstd * g0.y); o.y = pk2(x[2] * rstd * g0.z, x[3] * rstd * g0.w); o.z = pk2(x[4] * rstd * g1.x, x[5] * rstd * g1.y); o.w = pk2(x[6] * rstd * g1.z, x[7] * rstd * g1.w);
    *(GAS v4u*)(dst + 8 * lane) = o;
}
__device__ __forceinline__ void sincos_d(float ang, float& sn, float& cs) {
    const double t0 = (double)ang * 0.15915494309189535; const double t = t0 - __builtin_rint(t0); const double x = t * 6.283185307179586, x2 = x * x;
    double sp = -1.0 / 51090942171709440000.0;
    sp = sp * x2 + 1.0 / 121645100408832000.0; sp = sp * x2 - 1.0 / 355687428096000.0; sp = sp * x2 + 1.0 / 1307674368000.0; sp = sp * x2 - 1.0 / 6227020800.0; sp = sp * x2 + 1.0 / 39916800.0;
    sp = sp * x2 - 1.0 / 362880.0; sp = sp * x2 + 1.0 / 5040.0; sp = sp * x2 - 1.0 / 120.0; sp = sp * x2 + 1.0 / 6.0; sp = sp * x2 - 1.0; sn = (float)(-sp * x);
    double cp = 1.0 / 1124000727777607680000.0;
    cp = cp * x2 - 1.0 / 2432902008176640000.0; cp = cp * x2 + 1.0 / 6402373705728000.0; cp = cp * x2 - 1.0 / 20922789888000.0; cp = cp * x2 + 1.0 / 87178291200.0; cp = cp * x2 - 1.0 / 479001600.0;
    cp = cp * x2 + 1.0 / 3628800.0; cp = cp * x2 - 1.0 / 40320.0; cp = cp * x2 + 1.0 / 720.0; cp = cp * x2 - 1.0 / 24.0; cp = cp * x2 + 0.5; cp = cp * x2 - 1.0; cs = (float)(-cp);
}

typedef att::Body<64, NP0, NP0, 2048, 3, 0, bf16> BodyA;
typedef att::Body<192, 1536, 2560, 2048, 0, 8, bf16> BodyB;
typedef att::Body<128, 6144, 6144, 2048, 1, 2, bf16> BodyC;
struct DecB { const bf16* Qb; const bf16* KV; bf16* MIX; int vcu, G;
    __device__ __forceinline__ BodyB::Ref operator()(int n) const { const int it = vcu + (n >> 1) * G, h = it >> 5, x = it & 31, qb = (n & 1) ? 63 - x : x;
        BodyB::Ref r; r.Q = Qb + (size_t)(qb * 256) * 1536 + h * 192; r.K = KV + h * 320; r.V = KV + h * 320 + 192; r.O = MIX + (size_t)(qb * 256) * 2048 + 1024 + h * 128; r.kb = nullptr; r.bs = 0.f; r.P0 = qb * 256; r.jlo = 0; return r; } };
static_assert(BodyA::LDS_BYTES <= RING_BYTES && BodyB::LDS_BYTES <= RING_BYTES && BodyC::LDS_BYTES <= RING_BYTES, "attention LDS");
static_assert(BodyA::LDS_BYTES <= 143360 && BodyC::LDS_BYTES <= 143360 && 143360 + 4096 <= RING_BYTES, "sorted keys above the list-driven bodies");

constexpr float SKIP_THRESH = 106.0f;
constexpr int KEYS_OFF = 143360;
template <int MODE>
__device__ __forceinline__ int build_list(LAS unsigned char* scr, volatile LAS unsigned* list, const float* stats, const float* kbtab, float scale, int vcu, int G, int tid) {
    LAS float* KmH = (LAS float*)scr; LAS float* red = (LAS float*)(scr + 256); LAS unsigned* keys = (LAS unsigned*)(scr + KEYS_OFF); LAS float* te = (LAS float*)(scr + 16384);
    { const int vh = tid & 15, part = tid >> 4; float m = 0.f; for (int c = part; c < 256; c += 32) m = fmaxf(m, stats[c * 32 + 16 + vh]); red[part * 16 + vh] = m; }
    if (MODE == 1) {
#pragma unroll
        for (int i = 0; i < 8; ++i) { const int idx = tid + 512 * i; te[idx] = kbtab[(size_t)(idx >> 8) * S + 64 * (idx & 255) + 63]; } }
    __syncthreads();
    if (tid < 16) { float m = 0.f; for (int q = 0; q < 32; ++q) m = fmaxf(m, red[q * 16 + tid]); KmH[tid] = m; }
    __syncthreads();
#pragma unroll 1
    for (int it = tid; it < 1024; it += NWAVES * 64) { const int vh = it >> 6, qb = it & 63, P0 = qb * 256;
        float q2 = 0.f;
#pragma unroll
        for (int i = 0; i < 4; ++i) q2 = fmaxf(q2, stats[(4 * qb + i) * 32 + vh]);
        const float Bq = scale * sqrtf(q2 * KmH[vh]) * 1.01f + 0.05f, thr = SKIP_THRESH + 2.f * Bq;
        int jlo;
        if (MODE == 0) { const float slope = 1.0f / (float)(2 << (vh >> 1)); const float X = (float)P0 - thr / slope - 63.f; jlo = X > 0.f ? (int)floorf(X * (1.f / 64.f)) : 0; }
        else { int lo = 0, hi = 4 * qb;
            const float base = qb > 0 ? te[vh * 256 + 4 * qb - 1] : 0.f;
            while (lo < hi) { const int mid = (lo + hi) >> 1; if (scale * (te[vh * 256 + mid] - base) >= -thr) hi = mid; else lo = mid + 1; }
            jlo = lo; }
        jlo = jlo < 0 ? 0 : (jlo > 4 * qb ? 4 * qb : jlo);
        keys[it] = ((unsigned)(4 * (qb + 1) - jlo) << 10) | (unsigned)(1023 - it); }
    __syncthreads();
#pragma unroll 1
    for (int k = 2; k <= 1024; k <<= 1)
#pragma unroll 1
        for (int j = k >> 1; j > 0; j >>= 1) { const int i = ((tid & ~(j - 1)) << 1) | (tid & (j - 1)), l = i | j; const unsigned a = keys[i], b = keys[l]; const bool up = (i & k) == 0;
            if ((a < b) == up) { keys[i] = b; keys[l] = a; }
            __syncthreads(); }
    return 1024;
}
struct DecAL { const bf16* proj; bf16* OA; volatile LAS unsigned* keys;
    __device__ __forceinline__ BodyA::Ref operator()(int n) const { const unsigned key = (unsigned)__builtin_amdgcn_readfirstlane((int)keys[n]); const int it = 1023 - (int)(key & 1023u), vh = it >> 6, qb = it & 63, h = vh >> 1; const unsigned e = (unsigned)(4 * (qb + 1) - (int)(key >> 10)) << 16;
        BodyA::Ref r; r.Q = proj + (size_t)(qb * 256) * NP0 + vh * 64; r.K = proj + 1024 + vh * 64; r.V = proj + 2048 + h * 128; r.O = OA + (size_t)(qb * 256) * 2048 + vh * 128; r.kb = nullptr; r.bs = 4.0f / (float)(1 << h); r.P0 = qb * 256; r.jlo = (int)(e >> 16); return r; } };
struct DecCL { const bf16* QKV; bf16* O1; const float* kb; volatile LAS unsigned* keys;
    __device__ __forceinline__ BodyC::Ref operator()(int n) const { const unsigned key = (unsigned)__builtin_amdgcn_readfirstlane((int)keys[n]); const int it = 1023 - (int)(key & 1023u), h = it >> 6, qb = it & 63; const unsigned e = (unsigned)(4 * (qb + 1) - (int)(key >> 10)) << 16;
        BodyC::Ref r; r.Q = QKV + (size_t)(qb * 256) * 6144 + h * 128; r.K = QKV + 2048 + h * 128; r.V = QKV + 4096 + h * 128; r.O = O1 + (size_t)(qb * 256) * 2048 + h * 128; r.kb = kb + h * S; r.bs = 0.f; r.P0 = qb * 256; r.jlo = (int)(e >> 16); return r; } };

__global__ void __launch_bounds__(NWAVES * 64, 2) mk_fwd(Args args) {
    extern __shared__ __attribute__((aligned(16))) unsigned char lds[];
    LAS unsigned char* const ldsl = (LAS unsigned char*)lds;
    volatile LAS unsigned* const MISC = (volatile LAS unsigned*)(ldsl + MISC_OFF);
    const int tid = threadIdx.x, lane = tid & 63, wave = __builtin_amdgcn_readfirstlane(tid >> 6);
    const int G = gridDim.x; const int vcu = (G % 8 == 0) ? ((int)blockIdx.x % 8) * (G / 8) + (int)blockIdx.x / 8 : (int)blockIdx.x;
    unsigned char* const ws = args.ws;
    gu32* const ctl = (gu32*)(ws + WS_CTL);
    for (int u = tid; u < (LDS_BYTES - LDSCTL_OFF) / 4; u += NWAVES * 64) ((LAS unsigned*)(ldsl + LDSCTL_OFF))[u] = 0u;
    __syncthreads();
#if MK_PER_PHASE
    XcdBarrier bar; bar.bar = (unsigned*)(ctl + CW_BAR); bar.x = 0; bar.st = nullptr; (void)bar;
#define GRID_BAR() do { } while (0)
#else
    XcdBarrier bar = xcd_barrier_post((unsigned*)(ctl + CW_BAR), MISC + 8);
#define GRID_BAR() xcd_barrier(bar)
#endif
    const int lo = args.ph_lo, hi = args.ph_hi;
#define IN(k) (lo <= (k) && (k) < hi)
#define PHASE_LOCAL_IDS int tid_ph_ = (int)threadIdx.x; asm volatile("" : "+v"(tid_ph_)); const int tid = tid_ph_, lane = tid & 63; (void)tid; (void)lane
#define SEAM(k) do { if (IN((k) + 1)) GRID_BAR(); } while (0)
    const int gw = vcu * NWAVES + wave, NGW = G * NWAVES;
    bf16* const HB = (bf16*)(ws + WS_XN);

    if (IN(0)) { PHASE_LOCAL_IDS;
        LAS float* scr = (LAS float*)(ldsl + wave * 16640);
        LAS float* scl = (LAS float*)(ldsl + 139264);
        if (wave == 0) { const float c0 = w_clip(args.in[I_EV_W_IN], nullptr, N_IN0, nullptr, lane), c1 = w_clip(args.in[I_EV_W_GATE], args.in[I_EV_W_UP], FF, args.in[I_EV_FFN_NORM], lane),
                                     c2 = w_clip(args.in[I_OD_W_IN], nullptr, N_IN1, args.in[I_OD_ATTN_NORM], lane), c3 = w_clip_experts(args.in[I_OD_W_GATE], args.in[I_OD_W_UP], DM, FF, args.in[I_OD_FFN_NORM], lane),
                                     c4 = w8_scale_experts(args.in[I_OD_W_DOWN], FF, DM, lane);
            if (lane == 0) { scl[0] = c0; scl[1] = c1; scl[2] = c2; scl[3] = c3; scl[4] = c4;
                if (blockIdx.x == 0) { float* t = (float*)(ws + WS_SCL); t[0] = c0; t[1] = c1; t[2] = c2; t[3] = c3; t[4] = c4; } } }
        __syncthreads();
        const float clip_in0 = scl[0], clip_gu0 = scl[1], clip_in1 = scl[2], clip_gu1 = scl[3], scale_d1 = scl[4];
        { const float qsi = 127.f / clip_in0;
          tr_matrix(args.in[I_EV_W_IN], DM, N_IN0, 1, 0, (bf16*)(ws + WS_WIN0), 0, scr, gw, NGW, lane, nullptr, 2, qsi);
          tr_matrix(args.in[I_EV_W_IN], DM, N_IN0, 1, 0, (bf16*)(ws + WS_WIN0), 0, scr, gw, NGW, lane, nullptr, 0, 0.f, 64); }
        tr_matrix(args.in[I_EV_W_UQ], 512, 1536, 1, 0, (bf16*)(ws + WS_WUQ), 3, scr, gw, NGW, lane);
        tr_matrix(args.in[I_EV_W_UKV], 512, 2048, 1, 0, (bf16*)(ws + WS_WUKV), 0, scr, gw, NGW, lane);
        tr_matrix(args.in[I_EV_W_OUT], DM, DM, 1, 0, (bf16*)(ws + WS_WOUT0), 0, scr, gw, NGW, lane);
        const float qs0 = 127.f / clip_gu0;
        tr_matrix(args.in[I_EV_W_GATE], DM, FF, 1, 0, (bf16*)(ws + WS_WGU0), 1, scr, gw, NGW, lane, args.in[I_EV_FFN_NORM], 2, qs0);
        tr_matrix(args.in[I_EV_W_UP], DM, FF, 1, 0, (bf16*)(ws + WS_WGU0), 2, scr, gw, NGW, lane, args.in[I_EV_FFN_NORM], 2, qs0);
        tr_matrix(args.in[I_EV_W_DOWN], FF, DM, 1, 0, (bf16*)(ws + WS_WD0), 0, scr, gw, NGW, lane);
        { const float qsi = 127.f / clip_in1;
          tr_matrix(args.in[I_OD_W_IN], DM, N_IN1, 1, 0, (bf16*)(ws + WS_WIN1), 0, scr, gw, NGW, lane, args.in[I_OD_ATTN_NORM], 2, qsi);
          tr_matrix(args.in[I_OD_W_IN], DM, N_IN1, 1, 0, (bf16*)(ws + WS_WIN1), 0, scr, gw, NGW, lane, args.in[I_OD_ATTN_NORM], 0, 0.f, 96); }
        tr_matrix(args.in[I_OD_W_OUT], DM, DM, 1, 0, (bf16*)(ws + WS_WOUT1), 0, scr, gw, NGW, lane);
        const float qs1 = 127.f / clip_gu1;
        tr_matrix(args.in[I_OD_W_GATE], DM, FF, NE, 2 * FF, (bf16*)(ws + WS_WGU1), 1, scr, gw, NGW, lane, args.in[I_OD_FFN_NORM], 2, qs1);
        tr_matrix(args.in[I_OD_W_UP], DM, FF, NE, 2 * FF, (bf16*)(ws + WS_WGU1), 2, scr, gw, NGW, lane, args.in[I_OD_FFN_NORM], 2, qs1);
        tr_matrix(args.in[I_OD_W_DOWN], FF, DM, NE, DM, (bf16*)(ws + WS_WD1), 0, scr, gw, NGW, lane, nullptr, 1, scale_d1);
        { const int gt = gw * 64 + lane, NGT = NGW * 64;
          GAS v4u* z0 = (GAS v4u*)((bf16*)(ws + WS_WIN0) + (size_t)N_IN0 * DM); const int n0 = (N_IN0P - N_IN0) * DM / 8;
          for (int i = gt; i < n0; i += NGT) z0[i] = (v4u){0u, 0u, 0u, 0u};
          GAS v4u* z1 = (GAS v4u*)((bf16*)(ws + WS_WIN1) + (size_t)(N_IN1 + 16) * DM); const int n1 = (N_IN1P - N_IN1 - 16) * DM / 8;
          for (int i = gt; i < n1; i += NGT) z1[i] = (v4u){0u, 0u, 0u, 0u};
          float* cs = (float*)(ws + WS_ROPE);
          for (int i = gt; i < S * 32; i += NGT) { const int pos = i >> 5, k = i & 31; const float ang = (float)pos * ROPE_INV[k]; float sn, c; sincos_d(ang, sn, c); cs[pos * 64 + k] = c; cs[pos * 64 + 32 + k] = sn; }
        }
        { const float wsc0 = clip_in0 * (1.f / 127.f);
          for (int m = gw; m < S; m += NGW) rms_row_bf16(args.in[I_X] + (size_t)m * DM, args.in[I_EV_ATTN_NORM], (bf16*)(ws + WS_XN) + (size_t)m * DM, 1e-6f, lane, ws + WS_A8 + (size_t)m * DM, (float*)(ws + WS_RSTDS) + m, wsc0); }
        SEAM(0);
    }
    if (IN(1)) { PHASE_LOCAL_IDS;
        { pg8::Gemm g{(const bf16*)(ws + WS_A8), (const bf16*)(ws + WS_WIN0), S, NP0, DM / 2, DM / 2}; pg8::StaticOrder so; so.init(S, NP0, G, (int)blockIdx.x);
          pg8::EpiBf16Row E{(bf16*)(ws + WS_PROJ0), NP0, (const float*)(ws + WS_RSTDS)};
          pg8::gemm_phase<pg8::EpiBf16Row, pg8::StaticOrder, true, true, 2>(ldsl, g, so, E); }
        __syncthreads();
        { pg8::Gemm g{(const bf16*)(ws + WS_XN), (const bf16*)(ws + WS_WIN0), S, 256, 512, DM}; pg8::SplitKOrder so{G, (int)blockIdx.x, 16, 1024};
          pg8::EpiPartF32 E{(float*)(ws + WS_KPART), 64, 1024, S, nullptr};
          pg8::gemm_phase<pg8::EpiPartF32, pg8::SplitKOrder, true, true>(ldsl, g, so, E); }
        SEAM(1);
    }
    if (IN(2)) { PHASE_LOCAL_IDS;
        const bf16* proj = (const bf16*)(ws + WS_PROJ0); const float* cs = (const float*)(ws + WS_ROPE); bf16* Kf = (bf16*)(ws + WS_KF);
        LAS float* sm = (LAS float*)ldsl; float* statA = (float*)(ws + WS_STATA);
        for (int c = (int)blockIdx.x; c < 256; c += G) { float qmax = 0.f, kmax = 0.f;
            for (int i = 0; i < 8; ++i) { const int m = 64 * c + 8 * wave + i; const bf16* prow = proj + (size_t)m * NP0;
                rms512_bf16(prow + 3072, args.in[I_EV_Q_NORM], (bf16*)(ws + WS_CQN) + (size_t)m * 512, lane);
                rms512_bf16(prow + 3584, args.in[I_EV_KV_NORM], (bf16*)(ws + WS_CKVN) + (size_t)m * 512, lane);
                if (lane < 32) { const float* kp = (const float*)(ws + WS_KPART) + (size_t)m * 64 + lane; const size_t kq = (size_t)S * 64;
                    const float x1 = (kp[0] + kp[kq]) + (kp[2 * kq] + kp[3 * kq]), x2 = (kp[32] + kp[kq + 32]) + (kp[2 * kq + 32] + kp[3 * kq + 32]); const float cc = cs[m * 64 + lane], sn = cs[m * 64 + 32 + lane];
                    const bf16 o1 = (bf16)f2bf(x1 * cc - x2 * sn), o2 = (bf16)f2bf(x2 * cc + x1 * sn); bf16* kr = Kf + (size_t)m * 2560 + 128 + lane;
#pragma unroll
                    for (int h = 0; h < 8; ++h) { kr[h * 320] = o1; kr[h * 320 + 32] = o2; } }
                { const v4u a0 = *(const GAS v4u*)(prow + 16 * lane), a1 = *(const GAS v4u*)(prow + 16 * lane + 8), b0 = *(const GAS v4u*)(prow + 1024 + 16 * lane), b1 = *(const GAS v4u*)(prow + 1024 + 16 * lane + 8);
                  float sq = 0.f, sk = 0.f;
#pragma unroll
                  for (int e = 0; e < 4; ++e) { sq += bflo(a0[e]) * bflo(a0[e]) + bfhi(a0[e]) * bfhi(a0[e]) + bflo(a1[e]) * bflo(a1[e]) + bfhi(a1[e]) * bfhi(a1[e]);
                                                sk += bflo(b0[e]) * bflo(b0[e]) + bfhi(b0[e]) * bfhi(b0[e]) + bflo(b1[e]) * bflo(b1[e]) + bfhi(b1[e]) * bfhi(b1[e]); }
                  sq += __shfl_xor(sq, 1); sq += __shfl_xor(sq, 2); sk += __shfl_xor(sk, 1); sk += __shfl_xor(sk, 2); qmax = fmaxf(qmax, sq); kmax = fmaxf(kmax, sk); } }
            if ((lane & 3) == 0) { sm[wave * 32 + (lane >> 2)] = qmax; sm[wave * 32 + 16 + (lane >> 2)] = kmax; }
            __syncthreads();
            if (tid < 32) { float v = 0.f; for (int q = 0; q < 8; ++q) v = fmaxf(v, sm[q * 32 + tid]); statA[c * 32 + tid] = v; }
            __syncthreads(); }
        SEAM(2);
    }
    if (IN(3)) { PHASE_LOCAL_IDS;
        { pg8::Gemm g{(const bf16*)(ws + WS_CQN), (const bf16*)(ws + WS_WUQ), S, 1536, 512}; pg8::StaticOrder so; so.init(S, 1536, G, (int)blockIdx.x);
          pg8::EpiQRope E{(bf16*)(ws + WS_QB), (const float*)(ws + WS_ROPE)};
          pg8::gemm_phase<pg8::EpiQRope, pg8::StaticOrder, true, true>(ldsl, g, so, E); }
        __syncthreads();
        { pg8::Gemm g{(const bf16*)(ws + WS_CKVN), (const bf16*)(ws + WS_WUKV), S, 2048, 512}; pg8::StaticOrder so; so.init(S, 2048, G, (int)blockIdx.x);
          pg8::EpiKV E{(bf16*)(ws + WS_KF)};
          pg8::gemm_phase<pg8::EpiKV, pg8::StaticOrder, true, true>(ldsl, g, so, E); }
        SEAM(3);
    }
    if (IN(4)) { PHASE_LOCAL_IDS;
        const int nit = (vcu < 256) ? (256 - vcu + G - 1) / G : 0;
        { volatile LAS unsigned* slot = (volatile LAS unsigned*)(ldsl + LDSCTL_OFF);
          const int nb = build_list<0>(ldsl, slot, (const float*)(ws + WS_STATA), nullptr, SCALE_A, vcu, G, tid);
          DecAL d{(const bf16*)(ws + WS_PROJ0), (bf16*)(ws + WS_OA), (volatile LAS unsigned*)(ldsl + KEYS_OFF)}; att::stream_dyn<BodyA, DecAL>((char*)lds, nb, (unsigned*)(ctl + CW_QA), slot, d, SCALE_A); }
        __syncthreads();
        { DecB d{(const bf16*)(ws + WS_QB), (const bf16*)(ws + WS_KF), (bf16*)(ws + WS_MIX), vcu, G}; att::stream<BodyB, DecB>((char*)lds, 2 * nit, d, SCALE_B); }
        SEAM(4);
    }
    if (IN(5)) { PHASE_LOCAL_IDS;
        const float a1 = wave_sum(args.in[I_EV_LQ1][lane] * args.in[I_EV_LK1][lane]), a2 = wave_sum(args.in[I_EV_LQ2][lane] * args.in[I_EV_LK2][lane]);
        const float lam = expf(a1) - expf(a2) + 0.2f;
        const bf16* OA = (const bf16*)(ws + WS_OA); bf16* MIX = (bf16*)(ws + WS_MIX); const int h = lane >> 3, d0 = (lane & 7) * 16;
        f32x4 sg[4];
#pragma unroll
        for (int q = 0; q < 4; ++q) sg[q] = *(const GAS f32x4*)(args.in[I_EV_SUBLN] + d0 + 4 * q) * 0.8f;
        for (int m = gw; m < S; m += NGW) { const bf16* p0 = OA + (size_t)m * 2048 + (2 * h) * 128 + d0; f32x4 d[4]; float ss = 0.f;
            const v4u a0 = *(const GAS v4u*)p0, a1 = *(const GAS v4u*)(p0 + 8), b0 = *(const GAS v4u*)(p0 + 128), b1 = *(const GAS v4u*)(p0 + 136);
            d[0] = (f32x4){bflo(a0.x) - lam * bflo(b0.x), bfhi(a0.x) - lam * bfhi(b0.x), bflo(a0.y) - lam * bflo(b0.y), bfhi(a0.y) - lam * bfhi(b0.y)};
            d[1] = (f32x4){bflo(a0.z) - lam * bflo(b0.z), bfhi(a0.z) - lam * bfhi(b0.z), bflo(a0.w) - lam * bflo(b0.w), bfhi(a0.w) - lam * bfhi(b0.w)};
            d[2] = (f32x4){bflo(a1.x) - lam * bflo(b1.x), bfhi(a1.x) - lam * bfhi(b1.x), bflo(a1.y) - lam * bflo(b1.y), bfhi(a1.y) - lam * bfhi(b1.y)};
            d[3] = (f32x4){bflo(a1.z) - lam * bflo(b1.z), bfhi(a1.z) - lam * bfhi(b1.z), bflo(a1.w) - lam * bflo(b1.w), bfhi(a1.w) - lam * bfhi(b1.w)};
#pragma unroll
            for (int q = 0; q < 4; ++q) ss += (d[q].x * d[q].x + d[q].y * d[q].y) + (d[q].z * d[q].z + d[q].w * d[q].w);
            ss += __shfl_xor(ss, 1); ss += __shfl_xor(ss, 2); ss += __shfl_xor(ss, 4);
            const float rstd = 1.0f / sqrtf(ss * (1.f / 128.f) + 1e-5f);
            v4u o0, o1; { const f32x4 y0 = d[0] * rstd * sg[0], y1 = d[1] * rstd * sg[1], y2 = d[2] * rstd * sg[2], y3 = d[3] * rstd * sg[3];
              o0.x = pk2(y0.x, y0.y); o0.y = pk2(y0.z, y0.w); o0.z = pk2(y1.x, y1.y); o0.w = pk2(y1.z, y1.w); o1.x = pk2(y2.x, y2.y); o1.y = pk2(y2.z, y2.w); o1.z = pk2(y3.x, y3.y); o1.w = pk2(y3.z, y3.w); }
            GAS v4u* dst = (GAS v4u*)(MIX + (size_t)m * 2048 + h * 128 + d0); dst[0] = o0; dst[1] = o1; }
        SEAM(5);
    }
    if (IN(6)) { PHASE_LOCAL_IDS;
        pg8::Gemm g{(const bf16*)(ws + WS_MIX), (const bf16*)(ws + WS_WOUT0), S, DM, DM}; pg8::StaticOrder so; so.init(S, DM, G, (int)blockIdx.x);
        pg8::EpiResB<true> E{args.in[I_X], HB, (float*)(ws + WS_PS), DM};
        pg8::gemm_phase<pg8::EpiResB<true>, pg8::StaticOrder, true, true>(ldsl, g, so, E);
        SEAM(6);
    }
    if (IN(7)) { PHASE_LOCAL_IDS;
        rows_i8(HB, (const float*)(ws + WS_PS), (float*)(ws + WS_RSTD), ws + WS_A8, (float*)(ws + WS_RSTDS), ((const float*)(ws + WS_SCL))[1] * (1.f / 127.f), gw, NGW, lane);
        SEAM(7);
    }
    if (IN(8)) { PHASE_LOCAL_IDS;
        pg8::Gemm g{(const bf16*)(ws + WS_A8), (const bf16*)(ws + WS_WGU0), S, 2 * FF, DM / 2, DM / 2}; pg8::StaticOrder so; so.init(S, 2 * FF, G, (int)blockIdx.x);
        pg8::EpiSwiGLU<false> E{(bf16*)(ws + WS_HMID0), FF, 2 * FF / 256, (const float*)(ws + WS_RSTDS), 1.f};
        pg8::gemm_phase<pg8::EpiSwiGLU<false>, pg8::StaticOrder, true, true, 2>(ldsl, g, so, E);
        SEAM(8);
    }
    if (IN(9)) { PHASE_LOCAL_IDS;
        pg8::Gemm g{(const bf16*)(ws + WS_HMID0), (const bf16*)(ws + WS_WD0), S, DM, FF}; pg8::StaticOrder so; so.init(S, DM, G, (int)blockIdx.x);
        pg8::EpiResB<false> E{nullptr, HB, (float*)(ws + WS_PS), DM};
        pg8::gemm_phase<pg8::EpiResB<false>, pg8::StaticOrder, true, true>(ldsl, g, so, E);
        SEAM(9);
    }
    if (IN(10)) { PHASE_LOCAL_IDS;
        rows_i8(HB, (const float*)(ws + WS_PS), (float*)(ws + WS_RSTD), ws + WS_A8, (float*)(ws + WS_RSTDS), ((const float*)(ws + WS_SCL))[2] * (1.f / 127.f), gw, NGW, lane);
        SEAM(10);
    }
    if (IN(11)) { PHASE_LOCAL_IDS;
        { pg8::Gemm g{(const bf16*)(ws + WS_A8), (const bf16*)(ws + WS_WIN1), S, 6144, DM / 2, DM / 2}; pg8::StaticOrder so; so.init(S, 6144, G, (int)blockIdx.x);
          pg8::EpiBf16Row E{(bf16*)(ws + WS_QKV1), 6144, (const float*)(ws + WS_RSTDS)};
          pg8::gemm_phase<pg8::EpiBf16Row, pg8::StaticOrder, true, true, 2>(ldsl, g, so, E); }
        __syncthreads();
        { pg8::Gemm g{(const bf16*)(ws + WS_XN), (const bf16*)(ws + WS_WIN1), S, 256, 512, DM}; pg8::SplitKOrder so{G, (int)blockIdx.x, 24, 1024};
          pg8::EpiPartF32 E{(float*)(ws + WS_FPART), 16, 1024, S, (const float*)(ws + WS_RSTD)};
          pg8::gemm_phase<pg8::EpiPartF32, pg8::SplitKOrder, true, true>(ldsl, g, so, E); }
        SEAM(11);
    }
    if (IN(12)) { PHASE_LOCAL_IDS;
        float* logf = (float*)(ws + WS_LOGF); float* csum = (float*)(ws + WS_CSUM); LAS float* red = (LAS float*)ldsl;
        const bf16* qkv = (const bf16*)(ws + WS_QKV1); float* statC = (float*)(ws + WS_STATC); LAS float* sm = red + 1024;
        for (int c = (int)blockIdx.x; c < 256; c += G) { const int r = tid >> 4, h = tid & 15;
            { const float* fp = (const float*)(ws + WS_FPART); const size_t kq = (size_t)S * 16; const float fb = args.in[I_OD_FBIAS][h]; float lsum = 0.f;
#pragma unroll
              for (int rr = 0; rr < 2; ++rr) { const size_t o = (size_t)(64 * c + 32 * rr + r) * 16 + h; const float x = ((fp[o] + fp[o + kq]) + (fp[o + 2 * kq] + fp[o + 3 * kq])) + fb;
                  const float ls = fminf(x, 0.f) - log1pf(__expf(-fabsf(x))); logf[o] = ls; lsum += ls; }
              red[r * 16 + h] = lsum; }
            float qmax = 0.f, kmax = 0.f;
            for (int i = 0; i < 8; ++i) { const bf16* prow = qkv + (size_t)(64 * c + 8 * wave + i) * 6144 + 32 * lane; float sq = 0.f, sk = 0.f;
#pragma unroll
                for (int j = 0; j < 4; ++j) { const v4u a = *(const GAS v4u*)(prow + 8 * j), b = *(const GAS v4u*)(prow + 2048 + 8 * j);
#pragma unroll
                    for (int e = 0; e < 4; ++e) { sq += bflo(a[e]) * bflo(a[e]) + bfhi(a[e]) * bfhi(a[e]); sk += bflo(b[e]) * bflo(b[e]) + bfhi(b[e]) * bfhi(b[e]); } }
                sq += __shfl_xor(sq, 1); sq += __shfl_xor(sq, 2); sk += __shfl_xor(sk, 1); sk += __shfl_xor(sk, 2); qmax = fmaxf(qmax, sq); kmax = fmaxf(kmax, sk); }
            if ((lane & 3) == 0) { sm[wave * 32 + (lane >> 2)] = qmax; sm[wave * 32 + 16 + (lane >> 2)] = kmax; }
            __syncthreads();
            if (tid < 16) { float s = 0.f; for (int q = 0; q < 32; ++q) s += red[q * 16 + tid]; csum[c * 16 + tid] = s; }
            if (tid < 32) { float v = 0.f; for (int q = 0; q < 8; ++q) v = fmaxf(v, sm[q * 32 + tid]); statC[c * 32 + tid] = v; }
            __syncthreads(); }
        SEAM(12);
    }
    if (IN(13)) { PHASE_LOCAL_IDS;
        const float* logf = (const float*)(ws + WS_LOGF); const float* csum = (const float*)(ws + WS_CSUM); float* kbC = (float*)(ws + WS_KBC);
        LAS float* red = (LAS float*)ldsl; LAS float* pre = red + 512; LAS float* val = red + 1024;
        for (int c = (int)blockIdx.x; c < 256; c += G) { const int part = tid >> 4, h = tid & 15;
            { float s = 0.f; for (int cc = part; cc < c; cc += 32) s += csum[cc * 16 + h]; red[part * 16 + h] = s; }
            val[tid] = logf[(size_t)(64 * c) * 16 + tid]; val[512 + tid] = logf[(size_t)(64 * c) * 16 + 512 + tid];
            __syncthreads();
            if (tid < 16) { float s = 0.f; for (int q = 0; q < 32; ++q) s += red[q * 16 + tid]; pre[tid] = s; }
            __syncthreads();
            if (tid < 16) { float run = pre[tid]; for (int r = 0; r < 64; ++r) { run += val[r * 16 + tid]; val[r * 16 + tid] = run; } }
            __syncthreads();
            { const int r = tid & 63, hh = tid >> 6; kbC[(size_t)hh * S + 64 * c + r] = val[r * 16 + hh] * (-1.0f / SCALE_C); kbC[(size_t)(hh + 8) * S + 64 * c + r] = val[r * 16 + hh + 8] * (-1.0f / SCALE_C); }
            __syncthreads(); }
        SEAM(13);
    }
    if (IN(14)) { PHASE_LOCAL_IDS;
        volatile LAS unsigned* slot = (volatile LAS unsigned*)(ldsl + LDSCTL_OFF);
        const int nb = build_list<1>(ldsl, slot, (const float*)(ws + WS_STATC), (const float*)(ws + WS_KBC), SCALE_C, vcu, G, tid);
        DecCL d{(const bf16*)(ws + WS_QKV1), (bf16*)(ws + WS_O1), (const float*)(ws + WS_KBC), (volatile LAS unsigned*)(ldsl + KEYS_OFF)}; att::stream_dyn<BodyC, DecCL>((char*)lds, nb, (unsigned*)(ctl + CW_QC), slot, d, SCALE_C);
        SEAM(14);
    }
    if (IN(15)) { PHASE_LOCAL_IDS;
        pg8::Gemm g{(const bf16*)(ws + WS_O1), (const bf16*)(ws + WS_WOUT1), S, DM, DM}; pg8::StaticOrder so; so.init(S, DM, G, (int)blockIdx.x);
        pg8::EpiResB<false> E{nullptr, HB, (float*)(ws + WS_PS), DM};
        pg8::gemm_phase<pg8::EpiResB<false>, pg8::StaticOrder, true, true>(ldsl, g, so, E);
        SEAM(15);
    }
    if (IN(16)) { PHASE_LOCAL_IDS;
        LAS float* rt = (LAS float*)ldsl; LAS unsigned* cnt = (LAS unsigned*)(ldsl + 65536);
        for (int idx = tid; idx < DM * NE; idx += NWAVES * 64) { const int k = idx >> 3, e = idx & 7; rt[e * DM + k] = args.in[I_OD_ROUTER][idx]; }
        __syncthreads();
        const GAS f32x4* gr = (const GAS f32x4*)args.in[I_OD_FFN_NORM] + lane;
        for (int c = (int)blockIdx.x; c < 256; c += G) {
            if (tid < 8) cnt[tid] = 0u;
            __syncthreads();
            for (int i = 0; i < 8; ++i) { const int row = 64 * c + 8 * wave + i;
                const GAS v2u* xr = (const GAS v2u*)(HB + (size_t)row * DM) + lane; f32x4 v[8]; float s = 0.f;
#pragma unroll
                for (int j = 0; j < 8; ++j) { const v2u a = xr[64 * j]; v[j] = (f32x4){bflo(a.x), bfhi(a.x), bflo(a.y), bfhi(a.y)}; s += (v[j].x * v[j].x + v[j].y * v[j].y) + (v[j].z * v[j].z + v[j].w * v[j].w); }
                const float rstd = 1.0f / sqrtf(wave_sum(s) * (1.f / DM) + 1e-6f);
#pragma unroll
                for (int j = 0; j < 8; ++j) { const f32x4 gg = gr[64 * j]; v[j] = (v[j] * rstd) * gg; }
                if (lane == 0) ((float*)(ws + WS_RSTD))[row] = rstd;
                float lg[8];
#pragma unroll
                for (int e = 0; e < 8; ++e) { float a = 0.f;
#pragma unroll
                    for (int j = 0; j < 8; ++j) { const f32x4 w = *(const LAS f32x4*)(rt + e * DM + 4 * lane + 256 * j); a += (v[j].x * w.x + v[j].y * w.y) + (v[j].z * w.z + v[j].w * w.w); }
                    lg[e] = wave_sum(a); }
                int e1 = 0; float l1 = lg[0];
#pragma unroll
                for (int e = 1; e < 8; ++e) if (lg[e] > l1) { l1 = lg[e]; e1 = e; }
                int e2 = -1; float l2 = -__builtin_inff();
#pragma unroll
                for (int e = 0; e < 8; ++e) if (e != e1 && lg[e] > l2) { l2 = lg[e]; e2 = e; }
                const float g1 = 1.0f / (1.0f + expf(l2 - l1)), g2 = 1.0f - g1;
                if (lane == 0) { *(GAS v4u*)(ws + WS_ROUTE + (size_t)row * 16) = (v4u){(unsigned)e1, (unsigned)e2, __builtin_bit_cast(unsigned, g1), __builtin_bit_cast(unsigned, g2)};
                    __hip_atomic_fetch_add(cnt + e1, 1u, __ATOMIC_RELAXED, __HIP_MEMORY_SCOPE_WORKGROUP); __hip_atomic_fetch_add(cnt + e2, 1u, __ATOMIC_RELAXED, __HIP_MEMORY_SCOPE_WORKGROUP); } }
            __syncthreads();
            if (tid < 8) ((unsigned*)(ws + WS_CNTG))[c * 8 + tid] = cnt[tid];
            __syncthreads(); }
        SEAM(16);
    }
    if (IN(17)) { PHASE_LOCAL_IDS;
        const unsigned* cntg = (const unsigned*)(ws + WS_CNTG); LAS unsigned* red = (LAS unsigned*)ldsl; LAS unsigned* red2 = red + 512; LAS unsigned* T = red + 1024; LAS unsigned* P = red + 1032;
        LAS unsigned* st = red + 1040; LAS unsigned* rl = red + 1056; LAS unsigned* posl = red + 1056 + 256;
        bf16* As = (bf16*)(ws + WS_AS); float* gates = (float*)(ws + WS_GATES); unsigned* tokpos = (unsigned*)(ws + WS_TOKPOS);
        const float gsc = 1.0f / (((const float*)(ws + WS_SCL))[4] * H8_SCALE);
        const float wsc1 = ((const float*)(ws + WS_SCL))[3] * (1.f / 127.f);
        for (int c = (int)blockIdx.x; c < 256; c += G) {
            { const int e = tid & 7, part = tid >> 3; unsigned tot = 0u, pre = 0u; for (int cc = part; cc < 256; cc += 64) { const unsigned x = cntg[cc * 8 + e]; tot += x; if (cc < c) pre += x; } red[part * 8 + e] = tot; red2[part * 8 + e] = pre; }
            if (tid < 64) { const v4u r = *(const GAS v4u*)(ws + WS_ROUTE + (size_t)(64 * c + tid) * 16); rl[tid * 4 + 0] = r.x; rl[tid * 4 + 1] = r.y; rl[tid * 4 + 2] = r.z; rl[tid * 4 + 3] = r.w; }
            __syncthreads();
            if (tid < 8) { unsigned a = 0u, b = 0u; for (int q = 0; q < 64; ++q) { a += red[q * 8 + tid]; b += red2[q * 8 + tid]; } T[tid] = a; P[tid] = b; }
            __syncthreads();
            if (tid < 8) { unsigned s0 = 0u; for (int e = 0; e < tid; ++e) s0 += (T[e] + 255u) & ~255u; st[tid] = s0;
                unsigned run = s0 + P[tid]; for (int r = 0; r < 64; ++r) { if (rl[r * 4 + 0] == (unsigned)tid) posl[r * 2 + 0] = run++; if (rl[r * 4 + 1] == (unsigned)tid) posl[r * 2 + 1] = run++; }
                if (c == 0) ((unsigned*)(ws + WS_TOT))[tid] = T[tid]; }
            __syncthreads();
            for (int i = 0; i < 8; ++i) { const int r = 8 * wave + i, row = 64 * c + r; const GAS v4u* src = (const GAS v4u*)((const bf16*)(ws + WS_XN) + (size_t)row * DM) + lane;
                const v4u x[4] = {src[0], src[64], src[128], src[192]}; const float rs = ((const float*)(ws + WS_RSTD))[row];
                float am = 0.f;
#pragma unroll
                for (int j = 0; j < 4; ++j) { am = fmaxf(am, fmaxf(fmaxf(fabsf(bflo(x[j].x)), fabsf(bfhi(x[j].x))), fmaxf(fabsf(bflo(x[j].y)), fabsf(bfhi(x[j].y))))); am = fmaxf(am, fmaxf(fmaxf(fabsf(bflo(x[j].z)), fabsf(bfhi(x[j].z))), fmaxf(fabsf(bflo(x[j].w)), fabsf(bfhi(x[j].w))))); }
#pragma unroll
                for (int o = 32; o > 0; o >>= 1) am = fmaxf(am, __shfl_xor(am, o));
                am = fmaxf(am, 1e-30f); const float qs = 127.f / am, rowf = (am * (1.f / 127.f)) * rs * wsc1;
                v2u q[4];
#pragma unroll
                for (int j = 0; j < 4; ++j) { q[j].x = pki8x4(bflo(x[j].x) * qs, bfhi(x[j].x) * qs, bflo(x[j].y) * qs, bfhi(x[j].y) * qs); q[j].y = pki8x4(bflo(x[j].z) * qs, bfhi(x[j].z) * qs, bflo(x[j].w) * qs, bfhi(x[j].w) * qs); }
                const v2u q0 = q[0], q1 = q[1], q2 = q[2], q3 = q[3];
#pragma unroll
                for (int sl = 0; sl < 2; ++sl) { const unsigned p = posl[r * 2 + sl]; GAS v2u* dst = (GAS v2u*)((unsigned char*)As + (size_t)p * DM) + lane; dst[0] = q0; dst[64] = q1; dst[128] = q2; dst[192] = q3;
                    if (lane == 0) { gates[p] = __builtin_bit_cast(float, rl[r * 4 + 2 + sl]) * gsc; tokpos[row * 2 + sl] = p; ((float*)(ws + WS_RSTDS))[p] = rowf;   } } }
            { const unsigned e = (unsigned)wave, te = T[e], pad = ((te + 255u) & ~255u) - te;
              if ((unsigned)c < pad) { const unsigned p = st[e] + te + (unsigned)c; GAS v2u* dst = (GAS v2u*)((unsigned char*)As + (size_t)p * DM) + lane; const v2u z = (v2u){0u, 0u}; dst[0] = z; dst[64] = z; dst[128] = z; dst[192] = z; if (lane == 0) { gates[p] = 0.f; ((float*)(ws + WS_RSTDS))[p] = 0.f; } } }
            __syncthreads(); }
        SEAM(17);
    }
    if (IN(18)) { PHASE_LOCAL_IDS;
        pg8::Gemm g{(const bf16*)(ws + WS_AS), (const bf16*)(ws + WS_WGU1), MPAD, NE * 2 * FF, DM / 2, DM / 2}; pg8::GroupedOrder so; so.init((const unsigned*)(ws + WS_TOT), 2 * FF / 256, G, (int)blockIdx.x);
        pg8::EpiSwiGLU<true> E{(bf16*)(ws + WS_HMS), FF, 2 * FF / 256, (const float*)(ws + WS_RSTDS), H8_SCALE};
        pg8::gemm_phase<pg8::EpiSwiGLU<true>, pg8::GroupedOrder, true, true, 2>(ldsl, g, so, E);
        SEAM(18);
    }
    if (IN(19)) { PHASE_LOCAL_IDS;
        pg8::GroupedOrder so; so.init((const unsigned*)(ws + WS_TOT), DM / 256, G, (int)blockIdx.x);
        const int full = (so.nwg / G) * G, left = so.nwg - full; const bool halves = left > 0 && 2 * left <= G;
        if (halves) so.hi = full;
        { pg8::Gemm g{(const bf16*)(ws + WS_HMS), (const bf16*)(ws + WS_WD1), MPAD, NE * DM, FF / 2, FF / 2};
          pg8::EpiMoEDown E{(bf16*)(ws + WS_YS), (const float*)(ws + WS_GATES), DM / 256};
          pg8::gemm_phase<pg8::EpiMoEDown, pg8::GroupedOrder, true, true, 1>(ldsl, g, so, E); }
        if (halves) { __syncthreads();
          pg8::Gemm g{(const bf16*)(ws + WS_HMS), (const bf16*)(ws + WS_WD1), MPAD, NE * DM, FF / 4, FF / 2};
          pg8::GroupedSplitOrder<1> ss{so, full, 2 * left, FF / 2};
          pg8::EpiMoEDownPart E{(float*)(ws + WS_PART), (unsigned*)(ctl + CW_SPLIT), DM / 256, FF / 2};
          pg8::gemm_phase<pg8::EpiMoEDownPart, pg8::GroupedSplitOrder<1>, true, true, 1>(ldsl, g, ss, E); }
        SEAM(19);
    }
    if (IN(20)) { PHASE_LOCAL_IDS;
        const bf16* Y = (const bf16*)(ws + WS_YS); const unsigned* split = (const unsigned*)(ctl + CW_SPLIT); const float* PART = (const float*)(ws + WS_PART); const float* gates = (const float*)(ws + WS_GATES); const unsigned* tokpos = (const unsigned*)(ws + WS_TOKPOS); const GAS f32x4* gr = (const GAS f32x4*)args.in[I_FINAL_NORM] + lane;
        unsigned bad = __hip_atomic_load(ctl + CW_TMO, RLX_AGENT) | __hip_atomic_load(ctl + CW_BAR + XB_TMO, RLX_AGENT);
        for (int m = gw; m < S; m += NGW) { const unsigned p0 = tokpos[m * 2], p1 = tokpos[m * 2 + 1];
            GAS f32x4* xo = (GAS f32x4*)(args.out + (size_t)m * DM) + lane; const GAS v2u* hr = (const GAS v2u*)(HB + (size_t)m * DM) + lane; const GAS v2u* y0 = (const GAS v2u*)(Y + (size_t)p0 * DM) + lane; const GAS v2u* y1 = (const GAS v2u*)(Y + (size_t)p1 * DM) + lane;
            f32x4 v[8]; float s = 0.f;
            const v4u fa = *(const GAS v4u*)(split + (p0 >> 8) * 8), fb = *(const GAS v4u*)(split + (p0 >> 8) * 8 + 4), fc = *(const GAS v4u*)(split + (p1 >> 8) * 8), fd = *(const GAS v4u*)(split + (p1 >> 8) * 8 + 4);
            const unsigned anysplit = (fa.x | fa.y | fa.z | fa.w) | (fb.x | fb.y | fb.z | fb.w) | (fc.x | fc.y | fc.z | fc.w) | (fd.x | fd.y | fd.z | fd.w);
            if (__builtin_expect(anysplit == 0u, 1)) {
#pragma unroll
                for (int j = 0; j < 8; ++j) { const v2u a = y0[64 * j], b = y1[64 * j], hh = hr[64 * j]; v[j] = (f32x4){(bflo(hh.x) + bflo(a.x)) + bflo(b.x), (bfhi(hh.x) + bfhi(a.x)) + bfhi(b.x), (bflo(hh.y) + bflo(a.y)) + bflo(b.y), (bfhi(hh.y) + bfhi(a.y)) + bfhi(b.y)}; }
            } else {
#pragma unroll
                for (int j = 0; j < 8; ++j) { f32x4 add = (f32x4){0.f, 0.f, 0.f, 0.f};
#pragma unroll
                    for (int sl = 0; sl < 2; ++sl) { const unsigned p = sl ? p1 : p0; const unsigned xs = split[(p >> 8) * 8 + j];
                        if (xs) { const GAS f32x4* q = (const GAS f32x4*)(PART + ((size_t)(xs - 1u) << 18) + (size_t)(p & 255u) * 256) + lane; add = add + (q[0] + q[16384]) * gates[p]; }
                        else { const v2u a = (sl ? y1 : y0)[64 * j]; add = add + (f32x4){bflo(a.x), bfhi(a.x), bflo(a.y), bfhi(a.y)}; } }
                    { const v2u hh = hr[64 * j]; v[j] = (f32x4){bflo(hh.x), bfhi(hh.x), bflo(hh.y), bfhi(hh.y)} + add; } }
            }
#pragma unroll
            for (int j = 0; j < 8; ++j) s += (v[j].x * v[j].x + v[j].y * v[j].y) + (v[j].z * v[j].z + v[j].w * v[j].w);
            float rstd = 1.0f / sqrtf(wave_sum(s) * (1.f / DM) + 1e-6f); if (bad) rstd = __builtin_nanf("");
#pragma unroll
            for (int j = 0; j < 8; ++j) xo[64 * j] = (v[j] * rstd) * gr[64 * j]; }
    }
#undef IN
#undef SEAM
#undef GRID_BAR
}

extern "C" void kernel_launch(void* const* d_in, const int* in_sizes, int n_in, void* d_out, int out_size, void* d_ws, size_t ws_size, hipStream_t stream) {
    static int grid = 0;
    if (grid == 0) {
        if (n_in != 27 || in_sizes[0] != S * DM || out_size != S * DM || ws_size < WS_END) { fprintf(stderr, "kernel_launch: shape/workspace mismatch (n_in %d, in0 %d, out %d, ws %zu, need %zu); nothing launched\n", n_in, n_in > 0 ? in_sizes[0] : -1, out_size, ws_size, (size_t)WS_END); grid = -1; return; }
        int dev = 0, cus = 0, per_cu = 0;
        if (hipGetDevice(&dev) != hipSuccess || hipDeviceGetAttribute(&cus, hipDeviceAttributeMultiprocessorCount, dev) != hipSuccess) { fprintf(stderr, "kernel_launch: device query failed\n"); grid = -1; return; }
        if (hipFuncSetAttribute((const void*)mk_fwd, hipFuncAttributeMaxDynamicSharedMemorySize, LDS_BYTES) != hipSuccess) { fprintf(stderr, "kernel_launch: hipFuncSetAttribute failed\n"); grid = -1; return; }
        if (hipOccupancyMaxActiveBlocksPerMultiprocessor(&per_cu, (const void*)mk_fwd, NWAVES * 64, LDS_BYTES) != hipSuccess || per_cu < 1) fprintf(stderr, "kernel_launch: note: occupancy query reports %d workgroups per CU\n", per_cu);
        (void)hipGetLastError();
        grid = cus;
    }
    if (grid < 0) return;
    if (hipMemsetAsync((char*)d_ws + WS_CTL, 0, CTL_ZERO_BYTES, stream) != hipSuccess) { fprintf(stderr, "kernel_launch: hipMemsetAsync failed\n"); return; }
    Args a{};
    for (int i = 0; i < 27; ++i) a.in[i] = (const float*)d_in[i];
    a.out = (float*)d_out; a.ws = (unsigned char*)d_ws;
#if MK_PER_PHASE
#ifndef MK_PROBE_MASK
#define MK_PROBE_MASK 0
#endif
    for (int p = 0; p < NPH; ++p) { a.ph_lo = p; a.ph_hi = p + 1; const int reps = ((MK_PROBE_MASK >> p) & 1) ? 2 : 1;
        for (int r = 0; r < reps; ++r) hipLaunchKernelGGL(mk_fwd, dim3(grid), dim3(NWAVES * 64), LDS_BYTES, stream, a); }
#else
    a.ph_lo = 0; a.ph_hi = NPH; hipLaunchKernelGGL(mk_fwd, dim3(grid), dim3(NWAVES * 64), LDS_BYTES, stream, a);
#endif
    const hipError_t le = hipPeekAtLastError();
    if (le != hipSuccess) fprintf(stderr, "kernel_launch: launch failed: %s\n", hipGetErrorName(le));
}
```

```cpp
#include <hip/hip_runtime.h>
#include <cstdio>
#include <cstdint>
namespace pg8 {
#define PG8_LAS __attribute__((address_space(3)))
typedef unsigned short bf16_t;
typedef short bf16x8 __attribute__((ext_vector_type(8)));
typedef float f32x4 __attribute__((ext_vector_type(4)));
typedef unsigned u32x4 __attribute__((ext_vector_type(4)));
typedef int i32x4 __attribute__((ext_vector_type(4)));
typedef int i32x8 __attribute__((ext_vector_type(8)));
constexpr int BM = 256, BK = 64, HALF = 128, HTB = HALF * BK * 2  , STAGE_BYTES = 8 * HTB, NXCD = 8, WGM = 8;

__host__ __device__ __forceinline__ int lds_byte(int r, int c) { const int st = (r >> 4) * 2 + (c >> 5), rr = r & 15, cc = c & 31, ob = rr * 64 + cc * 2; return st * 1024 + (ob ^ (((ob >> 9) & 1) << 5)); }
__host__ __device__ __forceinline__ void stage_rc(int b, int& R, int& C) { const int st = b / 1024, sb = b % 1024, swz = sb ^ (((sb >> 9) & 1) << 5); R = (st >> 1) * 16 + swz / 64; C = (st & 1) * 32 + (swz % 64) / 2; }
__host__ __device__ __forceinline__ int perm32(int rho) { const int n = rho >> 4, i = rho & 15; return 8 * (i >> 2) + 4 * n + (i & 3); }

struct Unit { int pm, pn, ko, aux; };
struct Gemm { const bf16_t* A; const bf16_t* Bt; int M, N, K, ld; };

struct StaticOrder {
    int nM, nN, nwg, G, c;
    __host__ __device__ void init(int M, int N, int G_, int c_) { nM = M / BM; nN = N / BM; nwg = nM * nN; G = G_; c = c_; }
    __host__ __device__ bool next(int i, Unit& u) const {
        const long L = (long)i * G + c; if (L >= nwg) return false;
        int wgid = (int)L; { const int q = nwg / NXCD, r = nwg % NXCD, xcd = wgid % NXCD, off = wgid / NXCD; wgid = (xcd < r ? xcd * (q + 1) : r * (q + 1) + (xcd - r) * q) + off; }
        const int nig = WGM * nN, gid = wgid / nig, fm = gid * WGM, gsz = (nM - fm) < WGM ? (nM - fm) : WGM;
        u.pm = fm + ((wgid % nig) % gsz); u.pn = (wgid % nig) / gsz; return true;
    }
    __device__ __forceinline__ void a_ready(const Unit&) const {}
    __device__ __forceinline__ void done(const Unit&) const {}
};

__device__ __forceinline__ float sat8(float x) { return __builtin_amdgcn_fmed3f(x, -448.f, 448.f); }
__device__ __forceinline__ unsigned pk8x4(float a, float b, float c, float d) { int w = __builtin_amdgcn_cvt_pk_fp8_f32(sat8(a), sat8(b), 0, false); w = __builtin_amdgcn_cvt_pk_fp8_f32(sat8(c), sat8(d), w, true); return (unsigned)w; }
__device__ __forceinline__ unsigned cvt_pk_bf16(float lo, float hi) { unsigned r; asm volatile("v_cvt_pk_bf16_f32 %0, %1, %2" : "=v"(r) : "v"(lo), "v"(hi)); return r; }
typedef float f32x2 __attribute__((ext_vector_type(2)));
__device__ __forceinline__ f32x2 gelu_pk(f32x2 v) {
    const f32x2 av = __builtin_elementwise_abs(v), d = av * 0.2316418882f + 1.0f;
    f32x2 t; t.x = __builtin_amdgcn_rcpf(d.x); t.y = __builtin_amdgcn_rcpf(d.y);
    f32x2 q = t * 0.5307027145f + (-0.7265760135f); q = q * t + 0.7107068705f; q = q * t + (-0.142248368f); q = q * t + 0.127414796f; q = q * t;
    const f32x2 s = (v * v) * (-0.72134752044f);
    f32x2 e; e.x = __builtin_amdgcn_exp2f(s.x); e.y = __builtin_amdgcn_exp2f(s.y);
    const f32x2 m = v * (q * e), r = v - m;
    f32x2 o; o.x = v.x < 0.f ? m.x : r.x; o.y = v.y < 0.f ? m.y : r.y; return o;
}

template <int ACT  > struct EpiBf16 {
    static constexpr bool PERM = true, AFTER_DRAIN = false; static_assert(ACT == 0 || ACT == 1, "EpiBf16: ACT is 0 (none) or 1 (gelu_pk)");
    bf16_t* O; int ldc; const float* bias; int split_cols; size_t split_stride; float scale0;
    __device__ __forceinline__ void operator()(const f32x4 (&acc)[2][2][4][2], const Unit& u, int wr, int wc, int fr, int fq) const {
        const int row0 = u.pm * BM + wr * 64 + fr; int colt = u.pn * BM; bf16_t* base = O;
        float sc = 1.f; if (split_cols) { const int t = colt / split_cols; base += (size_t)t * split_stride; colt -= t * split_cols; if (t == 0) sc = scale0; }
        const int col0 = colt + wc * 32 + 8 * fq, bcol0 = u.pn * BM + wc * 32 + 8 * fq;
        f32x4 bv[2][2];
#pragma unroll
        for (int bj = 0; bj < 2; ++bj)
#pragma unroll
            for (int n = 0; n < 2; ++n) bv[bj][n] = bias ? *(const f32x4*)(bias + bcol0 + bj * HALF + 4 * n) : (f32x4){0.f, 0.f, 0.f, 0.f};
#pragma unroll
        for (int ai = 0; ai < 2; ++ai)
#pragma unroll
            for (int m = 0; m < 4; ++m) { bf16_t* rowp = base + (size_t)(row0 + ai * HALF + m * 16) * ldc + col0;
#pragma unroll
                for (int bj = 0; bj < 2; ++bj) { f32x4 v0 = acc[ai][bj][m][0] + bv[bj][0], v1 = acc[ai][bj][m][1] + bv[bj][1];
                    if (ACT == 1) { f32x2 a = gelu_pk((f32x2){v0[0], v0[1]}), b = gelu_pk((f32x2){v0[2], v0[3]}), c = gelu_pk((f32x2){v1[0], v1[1]}), d = gelu_pk((f32x2){v1[2], v1[3]});
                        v0 = (f32x4){a.x, a.y, b.x, b.y}; v1 = (f32x4){c.x, c.y, d.x, d.y}; }
                    v0 = v0 * sc; v1 = v1 * sc; u32x4 w; w.x = cvt_pk_bf16(v0[0], v0[1]); w.y = cvt_pk_bf16(v0[2], v0[3]); w.z = cvt_pk_bf16(v1[0], v1[1]); w.w = cvt_pk_bf16(v1[2], v1[3]);
                    *(u32x4*)(rowp + bj * HALF) = w; } }
    }
};

template <class Epi, class Sched, bool ALIGN_EPI = false, bool SP2 = false, int QM = 0>
__device__ __forceinline__ void gemm_phase(PG8_LAS unsigned char* lds, const Gemm g, const Sched& S, const Epi& E) {
    constexpr bool F8 = (QM == 1), I8 = (QM == 2);
    const int tid = threadIdx.x, wid = __builtin_amdgcn_readfirstlane(tid >> 6), lane = tid & 63, wr = wid >> 2, wc = wid & 3, fr = lane & 15, fq = lane >> 4;
    const int K = g.K, nt = K / BK, ld = g.ld ? g.ld : g.K;
    unsigned voffA[2], voffB[2];
#pragma unroll
    for (int i = 0; i < 2; ++i) { int R, C; stage_rc(tid * 16 + i * 8192, R, C); const int Rb = Epi::PERM ? ((R & ~31) + perm32(R & 31)) : R;
        voffA[i] = (unsigned)(R * ld + C) * 2u; voffB[i] = (unsigned)(Rb * ld + C) * 2u; }
    const size_t kstep = (size_t)(BK * 2);
    const size_t hstep = (size_t)HALF * ld * 2;
    const size_t tstep = 2 * hstep;
    const unsigned ldsw = (unsigned)wid * 1024u;
    const int aoff = lds_byte(wr * 64 + fr, fq * 8), boff = lds_byte(wc * 32 + fr, fq * 8);
#define PG8_SA(b, h) (((b) * 2 + (h)) * HTB)
#define PG8_SB(b, h) ((4 + (b) * 2 + (h)) * HTB)
#define PG8_STAGE(bufoff, gbase, voff) do { _Pragma("unroll") for (int _i = 0; _i < 2; ++_i) \
        __builtin_amdgcn_global_load_lds((const unsigned*)((const char*)(gbase) + (voff)[_i]), (PG8_LAS unsigned*)(lds + (bufoff) + ldsw + _i * 8192), 16, 0, 0); } while (0)
#define PG8_RD8(p_) __builtin_shufflevector(*(const PG8_LAS i32x4*)(p_), *(const PG8_LAS i32x4*)((p_) + 1024), 0, 1, 2, 3, 4, 5, 6, 7)
#define PG8_LDA(dst, b, h) do { if constexpr (F8) { _Pragma("unroll") for (int m = 0; m < 4; ++m) dst##8[m] = PG8_RD8(lds + PG8_SA(b, h) + aoff + m * 2048); }                                       \
        else { _Pragma("unroll") for (int m = 0; m < 4; ++m) _Pragma("unroll") for (int k = 0; k < 2; ++k) dst[m][k] = *(const PG8_LAS bf16x8*)(lds + PG8_SA(b, h) + aoff + m * 2048 + k * 1024); } } while (0)
#define PG8_LDB(dst, b, h) do { if constexpr (F8) { _Pragma("unroll") for (int n = 0; n < 2; ++n) dst##8[n] = PG8_RD8(lds + PG8_SB(b, h) + boff + n * 2048); }                                       \
        else { _Pragma("unroll") for (int n = 0; n < 2; ++n) _Pragma("unroll") for (int k = 0; k < 2; ++k) dst[n][k] = *(const PG8_LAS bf16x8*)(lds + PG8_SB(b, h) + boff + n * 2048 + k * 1024); } } while (0)
#define PG8_MMA(ai, bj, At, Bt) do { __builtin_amdgcn_s_setprio(1); _Pragma("unroll") for (int m = 0; m < 4; ++m) _Pragma("unroll") for (int n = 0; n < 2; ++n) {                               \
        if constexpr (F8) asm volatile("v_mfma_f32_16x16x128_f8f6f4 %0, %1, %2, %0" : "+v"(acc[ai][bj][m][n]) : "v"(Bt##8[n]), "v"(At##8[m]));     \
        else if constexpr (I8) { _Pragma("unroll") for (int k = 0; k < 2; ++k) acc[ai][bj][m][n] = __builtin_bit_cast(f32x4, __builtin_amdgcn_mfma_i32_16x16x64_i8(__builtin_bit_cast(i32x4, Bt[n][k]), __builtin_bit_cast(i32x4, At[m][k]), __builtin_bit_cast(i32x4, acc[ai][bj][m][n]), 0, 0, 0)); } \
        else { _Pragma("unroll") for (int k = 0; k < 2; ++k) acc[ai][bj][m][n] = __builtin_amdgcn_mfma_f32_16x16x32_bf16(Bt[n][k], At[m][k], acc[ai][bj][m][n], 0, 0, 0); } }                \
        __builtin_amdgcn_s_setprio(0); } while (0)
#define PG8_WAIT_V(n) asm volatile("s_waitcnt vmcnt(" #n ")" ::: "memory")
#define PG8_WAIT_L(n) asm volatile("s_waitcnt lgkmcnt(" #n ")" ::: "memory")
#define PG8_BAR __builtin_amdgcn_s_barrier()
#define PG8_SCHED __builtin_amdgcn_sched_barrier(0)
    Unit cur, nxt; int ui = 0; cur.ko = 0; nxt.ko = 0; cur.aux = 0; nxt.aux = 0;
    if (!S.next(0, cur)) return;
    f32x4 acc[2][2][4][2];
#pragma unroll
    for (int a = 0; a < 2; ++a)
#pragma unroll
        for (int b = 0; b < 2; ++b)
#pragma unroll
            for (int m = 0; m < 4; ++m)
#pragma unroll
                for (int n = 0; n < 2; ++n) acc[a][b][m][n] = (f32x4){0.f, 0.f, 0.f, 0.f};
    bf16x8 At[4][2], B0[2][2], B1[2][2]; i32x8 At8[4], B08[2], B18[2]; (void)At; (void)B0; (void)B1; (void)At8; (void)B08; (void)B18;
    const char* cA = (const char*)g.A + (size_t)cur.pm * tstep + cur.ko; const char* cB = (const char*)g.Bt + (size_t)cur.pn * tstep + cur.ko;
    S.a_ready(cur);
    if constexpr (SP2) {
        PG8_STAGE(PG8_SB(0, 0), cB, voffB); PG8_STAGE(PG8_SB(0, 1), cB + hstep, voffB); PG8_STAGE(PG8_SA(0, 0), cA, voffA); PG8_STAGE(PG8_SA(0, 1), cA + hstep, voffA);
        if (wr == 1) PG8_BAR;
        PG8_WAIT_V(2); PG8_BAR;
        PG8_STAGE(PG8_SB(1, 0), cB + kstep, voffB); PG8_STAGE(PG8_SA(1, 0), cA + kstep, voffA); PG8_STAGE(PG8_SB(1, 1), cB + hstep + kstep, voffB);
        PG8_WAIT_V(6); PG8_BAR;
    } else {
        PG8_STAGE(PG8_SB(0, 0), cB, voffB); PG8_STAGE(PG8_SA(0, 0), cA, voffA); PG8_STAGE(PG8_SB(0, 1), cB + hstep, voffB); PG8_STAGE(PG8_SA(0, 1), cA + hstep, voffA);
        if (wr == 1) PG8_BAR;
        PG8_WAIT_V(4); PG8_BAR;
        PG8_STAGE(PG8_SB(1, 0), cB + kstep, voffB); PG8_STAGE(PG8_SA(1, 0), cA + kstep, voffA); PG8_STAGE(PG8_SB(1, 1), cB + hstep + kstep, voffB);
        PG8_WAIT_V(6); PG8_BAR;
    }
    for (;;) {
        const bool has_next = S.next(ui + 1, nxt);
        const char* nA = has_next ? (const char*)g.A + (size_t)nxt.pm * tstep + nxt.ko : cA; const char* nB = has_next ? (const char*)g.Bt + (size_t)nxt.pn * tstep + nxt.ko : cB;
        for (int t = 0; t < nt; t += 2) {
            const bool last = (t == nt - 2);
            const char* a1 = cA + (size_t)(t + 1) * kstep;
            const char* a2 = last ? nA : cA + (size_t)(t + 2) * kstep; const char* b2 = last ? nB : cB + (size_t)(t + 2) * kstep;
            const char* a3 = a2 + kstep; const char* b3 = b2 + kstep;
            if (last && has_next) S.a_ready(nxt);
            if constexpr (SP2) {
            PG8_LDB(B0, 0, 0); PG8_LDB(B1, 0, 1); PG8_SCHED; PG8_LDA(At, 0, 0); PG8_STAGE(PG8_SA(1, 1), a1 + hstep, voffA);
            PG8_WAIT_V(8); PG8_WAIT_L(0); PG8_BAR; PG8_MMA(0, 0, At, B0); PG8_MMA(0, 1, At, B1); PG8_BAR; PG8_SCHED;
            PG8_LDA(At, 0, 1); PG8_STAGE(PG8_SB(0, 0), b2, voffB); PG8_STAGE(PG8_SB(0, 1), b2 + hstep, voffB); PG8_STAGE(PG8_SA(0, 0), a2, voffA);
            PG8_WAIT_V(8); PG8_WAIT_L(0); PG8_BAR; PG8_MMA(1, 0, At, B0); PG8_MMA(1, 1, At, B1); PG8_BAR; PG8_SCHED;
            PG8_LDB(B0, 1, 0); PG8_LDB(B1, 1, 1); PG8_SCHED; PG8_LDA(At, 1, 0); PG8_STAGE(PG8_SA(0, 1), a2 + hstep, voffA);
            PG8_WAIT_V(8); PG8_WAIT_L(0); PG8_BAR; PG8_MMA(0, 0, At, B0); PG8_MMA(0, 1, At, B1); PG8_BAR; PG8_SCHED;
            PG8_LDA(At, 1, 1); PG8_STAGE(PG8_SB(1, 0), b3, voffB); PG8_STAGE(PG8_SB(1, 1), b3 + hstep, voffB); PG8_STAGE(PG8_SA(1, 0), a3, voffA);
            PG8_WAIT_V(8); PG8_WAIT_L(0); PG8_BAR; PG8_MMA(1, 0, At, B0); PG8_MMA(1, 1, At, B1); PG8_BAR; PG8_SCHED;
            } else {
            PG8_LDB(B0, 0, 0); PG8_SCHED; PG8_LDA(At, 0, 0); PG8_STAGE(PG8_SA(1, 1), a1 + hstep, voffA);
            PG8_WAIT_L(8); PG8_BAR; PG8_WAIT_L(0); PG8_MMA(0, 0, At, B0); PG8_BAR; PG8_SCHED;
            PG8_LDB(B1, 0, 1); PG8_STAGE(PG8_SB(0, 0), b2, voffB);
            PG8_BAR; PG8_WAIT_L(0); PG8_MMA(0, 1, At, B1); PG8_BAR;
            PG8_LDA(At, 0, 1); PG8_STAGE(PG8_SA(0, 0), a2, voffA);
            PG8_BAR; PG8_WAIT_L(0); PG8_MMA(1, 0, At, B0); PG8_BAR; PG8_SCHED;
            PG8_STAGE(PG8_SB(0, 1), b2 + hstep, voffB);
            PG8_WAIT_V(6); PG8_BAR; PG8_MMA(1, 1, At, B1); PG8_BAR;
            PG8_LDB(B0, 1, 0); PG8_SCHED; PG8_LDA(At, 1, 0); PG8_STAGE(PG8_SA(0, 1), a2 + hstep, voffA);
            PG8_WAIT_L(8); PG8_BAR; PG8_WAIT_L(0); PG8_MMA(0, 0, At, B0); PG8_BAR; PG8_SCHED;
            PG8_LDB(B1, 1, 1); PG8_STAGE(PG8_SB(1, 0), b3, voffB);
            PG8_BAR; PG8_WAIT_L(0); PG8_MMA(0, 1, At, B1); PG8_BAR;
            PG8_LDA(At, 1, 1); PG8_STAGE(PG8_SA(1, 0), a3, voffA);
            PG8_BAR; PG8_WAIT_L(0); PG8_MMA(1, 0, At, B0); PG8_BAR; PG8_SCHED;
            PG8_STAGE(PG8_SB(1, 1), b3 + hstep, voffB);
            PG8_WAIT_V(6); PG8_BAR; PG8_MMA(1, 1, At, B1); PG8_BAR;
            }
        }
        if constexpr (ALIGN_EPI) { if (wr == 0) PG8_BAR; }
        if constexpr (F8) asm volatile("s_nop 15\n\ts_nop 15" ::: "memory");
        if constexpr (I8) {
#pragma unroll
            for (int a = 0; a < 2; ++a)
#pragma unroll
                for (int b = 0; b < 2; ++b)
#pragma unroll
                    for (int m = 0; m < 4; ++m)
#pragma unroll
                        for (int n = 0; n < 2; ++n) { const i32x4 iv = __builtin_bit_cast(i32x4, acc[a][b][m][n]); acc[a][b][m][n] = (f32x4){(float)iv[0], (float)iv[1], (float)iv[2], (float)iv[3]}; } }
        if constexpr (!Epi::AFTER_DRAIN) { E(acc, cur, wr, wc, fr, fq); S.done(cur); }
        if (!has_next) break;
#pragma unroll
        for (int a = 0; a < 2; ++a)
#pragma unroll
            for (int b = 0; b < 2; ++b)
#pragma unroll
                for (int m = 0; m < 4; ++m)
#pragma unroll
                    for (int n = 0; n < 2; ++n) acc[a][b][m][n] = (f32x4){0.f, 0.f, 0.f, 0.f};
        if constexpr (F8) asm volatile("s_nop 7" ::: "memory");
        cur = nxt; cA = nA; cB = nB; ++ui;
        if constexpr (ALIGN_EPI) { if (wr == 1) PG8_BAR; }
    }
    PG8_WAIT_V(0);
    if constexpr (!ALIGN_EPI) { if (wr == 0) PG8_BAR; }
    PG8_BAR;
    if constexpr (Epi::AFTER_DRAIN) { E.fused(acc, cur, wr, wc, fr, fq, lds, wid, lane); S.done(cur); }
#undef PG8_SA
#undef PG8_SB
#undef PG8_STAGE
#undef PG8_LDA
#undef PG8_LDB
#undef PG8_MMA
#undef PG8_RD8
#undef PG8_WAIT_V
#undef PG8_WAIT_L
#undef PG8_BAR
#undef PG8_SCHED
}
}
namespace pg8 {
__device__ __forceinline__ u32x4 pack8bf(const f32x4 v0, const f32x4 v1) { u32x4 w; w.x = cvt_pk_bf16(v0[0], v0[1]); w.y = cvt_pk_bf16(v0[2], v0[3]); w.z = cvt_pk_bf16(v1[0], v1[1]); w.w = cvt_pk_bf16(v1[2], v1[3]); return w; }

struct EpiQRope {
    static constexpr bool PERM = true, AFTER_DRAIN = false;
    bf16_t* Qb; const float* cs;
    __device__ __forceinline__ void operator()(const f32x4 (&acc)[2][2][4][2], const Unit& u, int wr, int wc, int fr, int fq) const {
        const int row0 = u.pm * BM + wr * 64 + fr;
        if (u.pn < 4) {
#pragma unroll
            for (int ai = 0; ai < 2; ++ai)
#pragma unroll
                for (int m = 0; m < 4; ++m) { bf16_t* rowp = Qb + (size_t)(row0 + ai * HALF + m * 16) * 1536 + wc * 32 + 8 * fq;
#pragma unroll
                    for (int bj = 0; bj < 2; ++bj) *(u32x4*)(rowp + (2 * u.pn + bj) * 192) = pack8bf(acc[ai][bj][m][0], acc[ai][bj][m][1]); }
        } else {
            const int head = 4 * (u.pn - 4) + wc, i0 = 8 * fq;
#pragma unroll
            for (int ai = 0; ai < 2; ++ai)
#pragma unroll
                for (int m = 0; m < 4; ++m) { const int row = row0 + ai * HALF + m * 16; const float* c = cs + (size_t)row * 64 + i0;
                    const f32x4 c0 = *(const f32x4*)c, c1 = *(const f32x4*)(c + 4), s0 = *(const f32x4*)(c + 32), s1 = *(const f32x4*)(c + 36);
                    const f32x4 x1a = acc[ai][0][m][0], x1b = acc[ai][0][m][1], x2a = acc[ai][1][m][0], x2b = acc[ai][1][m][1];
                    const f32x4 o1a = x1a * c0 - x2a * s0, o1b = x1b * c1 - x2b * s1, o2a = x2a * c0 + x1a * s0, o2b = x2b * c1 + x1b * s1;
                    bf16_t* rowp = Qb + (size_t)row * 1536 + head * 192 + 128 + i0;
                    *(u32x4*)(rowp) = pack8bf(o1a, o1b); *(u32x4*)(rowp + 32) = pack8bf(o2a, o2b); }
        }
    }
};
struct EpiKV {
    static constexpr bool PERM = true, AFTER_DRAIN = false;
    bf16_t* KV;
    __device__ __forceinline__ void operator()(const f32x4 (&acc)[2][2][4][2], const Unit& u, int wr, int wc, int fr, int fq) const {
        const int row0 = u.pm * BM + wr * 64 + fr, d = wc * 32 + 8 * fq;
#pragma unroll
        for (int ai = 0; ai < 2; ++ai)
#pragma unroll
            for (int m = 0; m < 4; ++m) { const size_t row = (size_t)(row0 + ai * HALF + m * 16);
                *(u32x4*)(KV + row * 2560 + u.pn * 320 + d) = pack8bf(acc[ai][0][m][0], acc[ai][0][m][1]);
                *(u32x4*)(KV + row * 2560 + u.pn * 320 + 192 + d) = pack8bf(acc[ai][1][m][0], acc[ai][1][m][1]); }
    }
};
template <bool BASE_F32, bool RSC = false> struct EpiResB {
    static constexpr bool PERM = true, AFTER_DRAIN = false;
    const float* basef; bf16_t* hb; float* ps; int ldc; const float* rsc;
    __device__ __forceinline__ void operator()(const f32x4 (&acc)[2][2][4][2], const Unit& u, int wr, int wc, int fr, int fq) const {
        const int row0 = u.pm * BM + wr * 64 + fr, col0 = u.pn * BM + wc * 32 + 8 * fq;
#pragma unroll
        for (int ai = 0; ai < 2; ++ai) {
            f32x4 bf[BASE_F32 ? 4 : 1][2][2]; u32x4 bh[BASE_F32 ? 1 : 4][2];
#pragma unroll
            for (int m = 0; m < 4; ++m) { const size_t off = (size_t)(row0 + ai * HALF + m * 16) * ldc + col0;
#pragma unroll
                for (int bj = 0; bj < 2; ++bj) { if (BASE_F32) { bf[BASE_F32 ? m : 0][bj][0] = *(const f32x4*)(basef + off + bj * HALF); bf[BASE_F32 ? m : 0][bj][1] = *(const f32x4*)(basef + off + bj * HALF + 4); }
                                                 else bh[BASE_F32 ? 0 : m][bj] = *(const u32x4*)(hb + off + bj * HALF); } }
#pragma unroll
            for (int m = 0; m < 4; ++m) { const int row = row0 + ai * HALF + m * 16; const size_t off = (size_t)row * ldc + col0; float ss = 0.f; const float rf = RSC ? rsc[row] : 1.f;
#pragma unroll
                for (int bj = 0; bj < 2; ++bj) { f32x4 b0, b1;
                    if (BASE_F32) { b0 = bf[BASE_F32 ? m : 0][bj][0]; b1 = bf[BASE_F32 ? m : 0][bj][1]; }
                    else { const u32x4 w = bh[BASE_F32 ? 0 : m][bj];
                        b0 = (f32x4){__builtin_bit_cast(float, w.x << 16), __builtin_bit_cast(float, w.x & 0xffff0000u), __builtin_bit_cast(float, w.y << 16), __builtin_bit_cast(float, w.y & 0xffff0000u)};
                        b1 = (f32x4){__builtin_bit_cast(float, w.z << 16), __builtin_bit_cast(float, w.z & 0xffff0000u), __builtin_bit_cast(float, w.w << 16), __builtin_bit_cast(float, w.w & 0xffff0000u)}; }
                    const f32x4 v0 = RSC ? b0 + acc[ai][bj][m][0] * rf : b0 + acc[ai][bj][m][0], v1 = RSC ? b1 + acc[ai][bj][m][1] * rf : b1 + acc[ai][bj][m][1];
                    ss += ((v0[0] * v0[0] + v0[1] * v0[1]) + (v0[2] * v0[2] + v0[3] * v0[3])) + ((v1[0] * v1[0] + v1[1] * v1[1]) + (v1[2] * v1[2] + v1[3] * v1[3]));
                    *(u32x4*)(hb + off + bj * HALF) = pack8bf(v0, v1); }
                ss += __shfl_xor(ss, 16); ss += __shfl_xor(ss, 32);
                if (fq == 0) ps[(size_t)row * 32 + u.pn * 4 + wc] = ss; }
            asm volatile("" ::: "memory"); }
    }
};
struct EpiBf16Row {
    static constexpr bool PERM = true, AFTER_DRAIN = false;
    bf16_t* O; int ldc; const float* rstd;
    __device__ __forceinline__ void operator()(const f32x4 (&acc)[2][2][4][2], const Unit& u, int wr, int wc, int fr, int fq) const {
        const int row0 = u.pm * BM + wr * 64 + fr, col0 = u.pn * BM + wc * 32 + 8 * fq;
        float rs[2][4];
#pragma unroll
        for (int ai = 0; ai < 2; ++ai)
#pragma unroll
            for (int m = 0; m < 4; ++m) rs[ai][m] = rstd[row0 + ai * HALF + m * 16];
#pragma unroll
        for (int ai = 0; ai < 2; ++ai)
#pragma unroll
            for (int m = 0; m < 4; ++m) { const int row = row0 + ai * HALF + m * 16; const float r = rs[ai][m]; bf16_t* rowp = O + (size_t)row * ldc + col0;
#pragma unroll
                for (int bj = 0; bj < 2; ++bj) *(u32x4*)(rowp + bj * HALF) = pack8bf(acc[ai][bj][m][0] * r, acc[ai][bj][m][1] * r); }
    }
};
template <bool OUT8 = false> struct EpiSwiGLU {
    static constexpr bool PERM = true, AFTER_DRAIN = false;
    bf16_t* Hm; int ldh; int ntn; const float* rstd; float osc;
    __device__ __forceinline__ void operator()(const f32x4 (&acc)[2][2][4][2], const Unit& u, int wr, int wc, int fr, int fq) const {
        const int row0 = u.pm * BM + wr * 64 + fr, col = (u.pn % ntn) * 128 + wc * 32 + 8 * fq;
        float rs[2][4];
#pragma unroll
        for (int ai = 0; ai < 2; ++ai)
#pragma unroll
            for (int m = 0; m < 4; ++m) rs[ai][m] = rstd[row0 + ai * HALF + m * 16];
#pragma unroll
        for (int ai = 0; ai < 2; ++ai)
#pragma unroll
            for (int m = 0; m < 4; ++m) { f32x4 h[2]; const float r = rs[ai][m];
#pragma unroll
                for (int n = 0; n < 2; ++n) { const f32x4 g = acc[ai][0][m][n] * r, up = acc[ai][1][m][n] * r;
#pragma unroll
                    for (int e = 0; e < 4; ++e) { const float s = __builtin_amdgcn_rcpf(1.0f + __builtin_amdgcn_exp2f(-1.4426950408889634f * g[e])); h[n][e] = g[e] * s * up[e]; } }
                if constexpr (OUT8) { typedef unsigned u32x2 __attribute__((ext_vector_type(2)));
                    u32x2 w; w.x = pk8x4(h[0][0] * osc, h[0][1] * osc, h[0][2] * osc, h[0][3] * osc); w.y = pk8x4(h[1][0] * osc, h[1][1] * osc, h[1][2] * osc, h[1][3] * osc);
                    *(u32x2*)((unsigned char*)Hm + (size_t)(row0 + ai * HALF + m * 16) * ldh + col) = w; }
                else *(u32x4*)(Hm + (size_t)(row0 + ai * HALF + m * 16) * ldh + col) = pack8bf(h[0], h[1]); }
    }
};
struct EpiMoEDown {
    static constexpr bool PERM = true, AFTER_DRAIN = false;
    bf16_t* Y; const float* gate; int ntn;
    __device__ __forceinline__ void operator()(const f32x4 (&acc)[2][2][4][2], const Unit& u, int wr, int wc, int fr, int fq) const {
        const int row0 = u.pm * BM + wr * 64 + fr, col0 = (u.pn % ntn) * BM + wc * 32 + 8 * fq;
        float gs[2][4];
#pragma unroll
        for (int ai = 0; ai < 2; ++ai)
#pragma unroll
            for (int m = 0; m < 4; ++m) gs[ai][m] = gate[row0 + ai * HALF + m * 16];
#pragma unroll
        for (int ai = 0; ai < 2; ++ai)
#pragma unroll
            for (int m = 0; m < 4; ++m) { const int row = row0 + ai * HALF + m * 16; const float gt = gs[ai][m]; bf16_t* rowp = Y + (size_t)row * 2048 + col0;
#pragma unroll
                for (int bj = 0; bj < 2; ++bj) *(u32x4*)(rowp + bj * HALF) = pack8bf(acc[ai][bj][m][0] * gt, acc[ai][bj][m][1] * gt); }
    }
};
struct EpiPartF32 {
    static constexpr bool PERM = true, AFTER_DRAIN = false;
    float* out; int ncols, kbytes, rows; const float* rstd;
    __device__ __forceinline__ void operator()(const f32x4 (&acc)[2][2][4][2], const Unit& u, int wr, int wc, int fr, int fq) const {
        const int row0 = u.pm * BM + wr * 64 + fr, col = wc * 32 + 8 * fq, kq = u.ko / kbytes;
        if (col < ncols) {
            float rs[2][4];
#pragma unroll
            for (int ai = 0; ai < 2; ++ai)
#pragma unroll
                for (int m = 0; m < 4; ++m) rs[ai][m] = rstd ? rstd[row0 + ai * HALF + m * 16] : 1.f;
#pragma unroll
            for (int ai = 0; ai < 2; ++ai)
#pragma unroll
                for (int m = 0; m < 4; ++m) { const int row = row0 + ai * HALF + m * 16; const float r = rs[ai][m]; float* p = out + ((size_t)kq * rows + (size_t)row) * ncols + col; *(f32x4*)p = acc[ai][0][m][0] * r; *(f32x4*)(p + 4) = acc[ai][0][m][1] * r; }
        }
    }
};
struct SplitKOrder {
    int G, c, PN, kbytes;
    __device__ __forceinline__ bool next(int i, Unit& u) const { const int L = i * G + c; if (L >= 256) return false; u.pm = L >> 2; u.pn = PN; u.ko = (L & 3) * kbytes; return true; }
    __device__ __forceinline__ void a_ready(const Unit&) const {}
    __device__ __forceinline__ void done(const Unit&) const {}
};
struct GroupedOrder {
    int nN, nwg, G, c, MT, t1, t2, t3, t4, t5, t6, t7, hi;
    __device__ __forceinline__ void init(const unsigned* tot, int nN_, int G_, int c_) {
        int t = 0; nN = nN_; G = G_; c = c_;
        t += (int)((tot[0] + 255u) >> 8); t1 = t; t += (int)((tot[1] + 255u) >> 8); t2 = t; t += (int)((tot[2] + 255u) >> 8); t3 = t; t += (int)((tot[3] + 255u) >> 8); t4 = t;
        t += (int)((tot[4] + 255u) >> 8); t5 = t; t += (int)((tot[5] + 255u) >> 8); t6 = t; t += (int)((tot[6] + 255u) >> 8); t7 = t; t += (int)((tot[7] + 255u) >> 8); MT = t; nwg = MT * nN; hi = nwg;
    }
    __device__ __forceinline__ bool next(int i, Unit& u) const { const long L = (long)i * G + c; if (L >= hi) return false; map((int)L, u); return true; }
    __device__ __forceinline__ void map(int L, Unit& u) const {
        int wgid = L; { const int q = nwg / NXCD, r = nwg % NXCD, xcd = wgid % NXCD, off = wgid / NXCD; wgid = (xcd < r ? xcd * (q + 1) : r * (q + 1) + (xcd - r) * q) + off; }
        const int nig = WGM * nN, gid = wgid / nig, fm = gid * WGM, gsz = (MT - fm) < WGM ? (MT - fm) : WGM;
        const int pm = fm + ((wgid % nig) % gsz), pn = (wgid % nig) / gsz;
        const int e = (pm >= t1) + (pm >= t2) + (pm >= t3) + (pm >= t4) + (pm >= t5) + (pm >= t6) + (pm >= t7);
        u.pm = pm; u.pn = e * nN + pn;
    }
    __device__ __forceinline__ void a_ready(const Unit&) const {}
    __device__ __forceinline__ void done(const Unit&) const {}
};
template <int LOG> struct GroupedSplitOrder {
    GroupedOrder b; int first, nq, kbytes;
    __device__ __forceinline__ bool next(int i, Unit& u) const { const int Lq = i * b.G + b.c; if (Lq >= nq) return false; b.map(first + (Lq >> LOG), u); u.ko = (Lq & ((1 << LOG) - 1)) * kbytes; u.aux = Lq >> LOG; return true; }
    __device__ __forceinline__ void a_ready(const Unit&) const {}
    __device__ __forceinline__ void done(const Unit&) const {}
};
struct EpiMoEDownPart {
    static constexpr bool PERM = true, AFTER_DRAIN = false;
    float* part; unsigned* split; int ntn, kbytes;
    __device__ __forceinline__ void operator()(const f32x4 (&acc)[2][2][4][2], const Unit& u, int wr, int wc, int fr, int fq) const {
        const int kq = u.ko / kbytes, pn = u.pn % ntn; float* base = part + ((size_t)(u.aux * 4 + kq) << 16) + (size_t)(wr * 64 + fr) * 256 + wc * 32 + 8 * fq;
        if (kq == 0 && wr == 0 && wc == 0 && fr == 0 && fq == 0) split[u.pm * ntn + pn] = (unsigned)u.aux + 1u;
#pragma unroll
        for (int ai = 0; ai < 2; ++ai)
#pragma unroll
            for (int m = 0; m < 4; ++m) { float* rowp = base + (size_t)(ai * HALF + m * 16) * 256;
#pragma unroll
                for (int bj = 0; bj < 2; ++bj) { *(f32x4*)(rowp + bj * HALF) = acc[ai][bj][m][0]; *(f32x4*)(rowp + bj * HALF + 4) = acc[ai][bj][m][1]; } }
    }
};
}
#include <cmath>
#define ATT_PV_SPLIT 1
namespace att {
typedef unsigned short bf16_t;
typedef short bf16x8 __attribute__((ext_vector_type(8)));
typedef short s16x4 __attribute__((ext_vector_type(4)));
typedef float f32x16 __attribute__((ext_vector_type(16)));
typedef float f32x4 __attribute__((ext_vector_type(4)));
typedef unsigned u32x4 __attribute__((ext_vector_type(4)));
constexpr int NW = 8, QBLK = 32, KVBLK = 64, QB = NW * QBLK, DV = 128, SHM_V = KVBLK * DV * 2;
constexpr float THR = 40.f;
#define ATT_SBAR() __builtin_amdgcn_sched_barrier(0)
__device__ __forceinline__ int v_st(int k, int c) { const int kk = (k & ~0xC) | ((k & 4) << 1) | ((k & 8) >> 1); return ((kk >> 3) * 4 + (c >> 5)) * 512 + ((kk & 7) * 32 + (c & 31)) * 2; }
__device__ __forceinline__ int v_rd_base(int lane) { return ((lane & 3) << 3) | (((lane >> 2) & 3) << 6) | (((lane >> 4) & 1) << 5) | (((lane >> 5) & 1) << 8); }
constexpr int v_rd_off(int d0, int ks, int half) { return d0 * 512 + ks * 4096 + half * 2048; }
__device__ __forceinline__ int crow(int r, int hi) { return (r & 3) + 8 * (r >> 2) + 4 * hi; }
__device__ __forceinline__ unsigned cvtpk(float lo, float hi) { unsigned r; asm volatile("v_cvt_pk_bf16_f32 %0, %1, %2" : "=v"(r) : "v"(lo), "v"(hi)); return r; }
__device__ __forceinline__ bf16x8 ld8(const bf16_t* p) { return *reinterpret_cast<const bf16x8*>(p); }
__device__ __forceinline__ void mask_tile(f32x16& p0, f32x16& p1, int dq) {
    const float NEG = -__builtin_inff();
#define ATT_MSK(x, c_) asm volatile("v_cmp_gt_i32 vcc, %2, %1\n\tv_cndmask_b32 %0, %0, %3, vcc" : "+v"(x) : "v"(dq), "n"(c_), "v"(NEG) : "vcc")
#pragma unroll
    for (int r = 0; r < 16; ++r) { const int c = (r & 3) + 8 * (r >> 2); ATT_MSK(p0[r], c); ATT_MSK(p1[r], c + 32); }
#undef ATT_MSK
}
__device__ __forceinline__ void partialSM(f32x16& p0, f32x16& p1, float& m_reg, float& mn, float& alpha, const float SCALE) {
    float pmax = p0[0];
#pragma unroll
    for (int r = 1; r < 16; ++r) pmax = fmaxf(pmax, p0[r]);
#pragma unroll
    for (int r = 0; r < 16; ++r) pmax = fmaxf(pmax, p1[r]);
    { auto rr = __builtin_amdgcn_permlane32_swap(__float_as_uint(pmax), __float_as_uint(pmax), false, false);
      pmax = fmaxf(__uint_as_float(rr[0]), __uint_as_float(rr[1])); }
    const float C2 = 1.4426950408889634f * SCALE;
    if (__builtin_expect(__all((pmax - m_reg) * SCALE <= THR), 1)) { mn = m_reg; alpha = 1.f; }
    else { mn = fmaxf(m_reg, pmax); alpha = __builtin_amdgcn_exp2f((m_reg - mn) * C2); m_reg = mn; }
    const float mnL = -mn * C2;
#pragma unroll
    for (int r = 0; r < 16; ++r) p0[r] = fmaf(p0[r], C2, mnL);
#pragma unroll
    for (int r = 0; r < 16; ++r) p1[r] = fmaf(p1[r], C2, mnL);
#pragma unroll
    for (int r = 0; r < 16; ++r) p0[r] = __builtin_amdgcn_exp2f(p0[r]);
}
__device__ __forceinline__ void finishSM(f32x16& p0, f32x16& p1, float alpha, float& l_reg, bf16x8& pa0, bf16x8& pa1, bf16x8& pa2, bf16x8& pa3) {
#pragma unroll
    for (int r = 0; r < 16; ++r) p1[r] = __builtin_amdgcn_exp2f(p1[r]);
    float ps = 0;
#pragma unroll
    for (int r = 0; r < 16; ++r) ps += p0[r];
#pragma unroll
    for (int r = 0; r < 16; ++r) ps += p1[r];
    { auto rr = __builtin_amdgcn_permlane32_swap(__float_as_uint(ps), __float_as_uint(ps), false, false);
      ps = __uint_as_float(rr[0]) + __uint_as_float(rr[1]); }
    l_reg = l_reg * alpha + ps;
#define ATT_PK4(P, B_, OUT) do { unsigned a0 = cvtpk(P[B_+0], P[B_+1]), a1 = cvtpk(P[B_+2], P[B_+3]);                          \
        unsigned b0 = cvtpk(P[B_+4], P[B_+5]), b1 = cvtpk(P[B_+6], P[B_+7]);                                             \
        auto r0 = __builtin_amdgcn_permlane32_swap(a0, b0, false, false); auto r1 = __builtin_amdgcn_permlane32_swap(a1, b1, false, false); \
        u32x4 w = {r0[0], r1[0], r0[1], r1[1]}; OUT = *reinterpret_cast<bf16x8*>(&w); } while (0)
    ATT_PK4(p0, 0, pa0); ATT_PK4(p0, 8, pa1); ATT_PK4(p1, 0, pa2); ATT_PK4(p1, 8, pa3);
#undef ATT_PK4
}
template <int VB>
__device__ __forceinline__ void pv_tile(f32x16* o, int vb0, bf16x8 pa0, bf16x8 pa1, bf16x8 pa2, bf16x8 pa3) {
#define ATT_TRRD(dst, off) asm volatile("ds_read_b64_tr_b16 %0, %1 offset:%2" : "=&v"(dst) : "v"(vb0), "i"(off) : "memory")
#ifndef ATT_PV_SPLIT
#define ATT_PV_SPLIT 0
#endif
#if ATT_PV_SPLIT
#define ATT_PV_D0(d0) do { s16x4 l0, l1, h0, h1; constexpr int b_ = VB * SHM_V + v_rd_off(d0, 0, 0); \
        ATT_TRRD(l0, b_); ATT_TRRD(h0, b_ + 2048); ATT_TRRD(l1, b_ + 4096); ATT_TRRD(h1, b_ + 6144); \
        asm volatile("s_waitcnt lgkmcnt(0)" ::: "memory"); ATT_SBAR();   \
        o[d0] = __builtin_amdgcn_mfma_f32_32x32x16_bf16(pa0, (bf16x8){l0[0], l0[1], l0[2], l0[3], h0[0], h0[1], h0[2], h0[3]}, o[d0], 0, 0, 0);   \
        o[d0] = __builtin_amdgcn_mfma_f32_32x32x16_bf16(pa1, (bf16x8){l1[0], l1[1], l1[2], l1[3], h1[0], h1[1], h1[2], h1[3]}, o[d0], 0, 0, 0);   \
        ATT_SBAR(); ATT_TRRD(l0, b_ + 8192); ATT_TRRD(h0, b_ + 10240); ATT_TRRD(l1, b_ + 12288); ATT_TRRD(h1, b_ + 14336); \
        asm volatile("s_waitcnt lgkmcnt(0)" ::: "memory"); ATT_SBAR();   \
        o[d0] = __builtin_amdgcn_mfma_f32_32x32x16_bf16(pa2, (bf16x8){l0[0], l0[1], l0[2], l0[3], h0[0], h0[1], h0[2], h0[3]}, o[d0], 0, 0, 0);   \
        o[d0] = __builtin_amdgcn_mfma_f32_32x32x16_bf16(pa3, (bf16x8){l1[0], l1[1], l1[2], l1[3], h1[0], h1[1], h1[2], h1[3]}, o[d0], 0, 0, 0); } while (0)
#else
#define ATT_PV_D0(d0) do { s16x4 l0, l1, l2, l3, h0, h1, h2, h3; constexpr int b_ = VB * SHM_V + v_rd_off(d0, 0, 0); \
        ATT_TRRD(l0, b_); ATT_TRRD(h0, b_ + 2048); ATT_TRRD(l1, b_ + 4096); ATT_TRRD(h1, b_ + 6144); ATT_TRRD(l2, b_ + 8192); ATT_TRRD(h2, b_ + 10240); ATT_TRRD(l3, b_ + 12288); ATT_TRRD(h3, b_ + 14336); \
        asm volatile("s_waitcnt lgkmcnt(0)" ::: "memory"); ATT_SBAR();   \
        o[d0] = __builtin_amdgcn_mfma_f32_32x32x16_bf16(pa0, (bf16x8){l0[0], l0[1], l0[2], l0[3], h0[0], h0[1], h0[2], h0[3]}, o[d0], 0, 0, 0);   \
        o[d0] = __builtin_amdgcn_mfma_f32_32x32x16_bf16(pa1, (bf16x8){l1[0], l1[1], l1[2], l1[3], h1[0], h1[1], h1[2], h1[3]}, o[d0], 0, 0, 0);   \
        o[d0] = __builtin_amdgcn_mfma_f32_32x32x16_bf16(pa2, (bf16x8){l2[0], l2[1], l2[2], l2[3], h2[0], h2[1], h2[2], h2[3]}, o[d0], 0, 0, 0);   \
        o[d0] = __builtin_amdgcn_mfma_f32_32x32x16_bf16(pa3, (bf16x8){l3[0], l3[1], l3[2], l3[3], h3[0], h3[1], h3[2], h3[3]}, o[d0], 0, 0, 0); } while (0)
#endif
    ATT_PV_D0(0); ATT_PV_D0(1); ATT_PV_D0(2); ATT_PV_D0(3);
#undef ATT_PV_D0
#undef ATT_TRRD
}

template <int VB>
__device__ __forceinline__ void pv_sm(f32x16* o, int vb0, bf16x8 pa0, bf16x8 pa1, bf16x8 pa2, bf16x8 pa3, f32x16& p0, f32x16& p1, float& m_reg, float& mn, float& alpha, const float SCALE) {
#define ATT_TRRD(dst, off) asm volatile("ds_read_b64_tr_b16 %0, %1 offset:%2" : "=&v"(dst) : "v"(vb0), "i"(off) : "memory")
#define ATT_RD4(base_) ATT_TRRD(l0, base_); ATT_TRRD(h0, base_ + 2048); ATT_TRRD(l1, base_ + 4096); ATT_TRRD(h1, base_ + 6144)
#define ATT_MM2(d0, pa_, pb_) do { asm volatile("s_waitcnt lgkmcnt(0)" : "+v"(l0), "+v"(h0), "+v"(l1), "+v"(h1) :: "memory"); ATT_SBAR();                        \
        o[d0] = __builtin_amdgcn_mfma_f32_32x32x16_bf16(pa_, (bf16x8){l0[0], l0[1], l0[2], l0[3], h0[0], h0[1], h0[2], h0[3]}, o[d0], 0, 0, 0);   \
        o[d0] = __builtin_amdgcn_mfma_f32_32x32x16_bf16(pb_, (bf16x8){l1[0], l1[1], l1[2], l1[3], h1[0], h1[1], h1[2], h1[3]}, o[d0], 0, 0, 0); ATT_SBAR(); } while (0)
    const float C2 = 1.4426950408889634f * SCALE;
    s16x4 l0, l1, h0, h1; constexpr int b0_ = VB * SHM_V;
    ATT_RD4(b0_ + v_rd_off(0, 0, 0));
    float ma = fmaxf(fmaxf(p0[0], p0[1]), p0[2]);
#pragma unroll
    for (int r = 3; r < 15; r += 2) ma = fmaxf(fmaxf(ma, p0[r]), p0[r + 1]);
    ma = fmaxf(ma, p0[15]);
    ATT_MM2(0, pa0, pa1);
    ATT_RD4(b0_ + v_rd_off(0, 0, 0) + 8192);
    float mb = fmaxf(fmaxf(p1[0], p1[1]), p1[2]);
#pragma unroll
    for (int r = 3; r < 15; r += 2) mb = fmaxf(fmaxf(mb, p1[r]), p1[r + 1]);
    mb = fmaxf(mb, p1[15]);
    ATT_MM2(0, pa2, pa3);
    ATT_RD4(b0_ + v_rd_off(1, 0, 0));
    float pmax = fmaxf(ma, mb);
    { auto rr = __builtin_amdgcn_permlane32_swap(__float_as_uint(pmax), __float_as_uint(pmax), false, false); pmax = fmaxf(__uint_as_float(rr[0]), __uint_as_float(rr[1])); }
    const bool keep = __all((pmax - m_reg) * SCALE <= THR);
    mn = keep ? m_reg : fmaxf(m_reg, pmax); alpha = __builtin_amdgcn_exp2f((m_reg - mn) * C2); m_reg = mn;
    const float mnL = -mn * C2;
#define ATT_VFMA(x) asm volatile("v_fma_f32 %0, %0, %1, %2" : "+v"(x) : "s"(C2), "v"(mnL))
#define ATT_VEXP(x) asm volatile("v_exp_f32 %0, %0" : "+v"(x))
    ATT_MM2(1, pa0, pa1);
    ATT_RD4(b0_ + v_rd_off(1, 0, 0) + 8192);
#pragma unroll
    for (int r = 0; r < 16; ++r) ATT_VFMA(p0[r]);
    ATT_MM2(1, pa2, pa3);
    ATT_RD4(b0_ + v_rd_off(2, 0, 0));
#pragma unroll
    for (int r = 0; r < 16; ++r) ATT_VFMA(p1[r]);
#pragma unroll
    for (int r = 0; r < 4; ++r) ATT_VEXP(p0[r]);
    ATT_MM2(2, pa0, pa1);
    ATT_RD4(b0_ + v_rd_off(2, 0, 0) + 8192);
#pragma unroll
    for (int r = 4; r < 8; ++r) ATT_VEXP(p0[r]);
    ATT_MM2(2, pa2, pa3);
    ATT_RD4(b0_ + v_rd_off(3, 0, 0));
#pragma unroll
    for (int r = 8; r < 12; ++r) ATT_VEXP(p0[r]);
    ATT_MM2(3, pa0, pa1);
    ATT_RD4(b0_ + v_rd_off(3, 0, 0) + 8192);
#pragma unroll
    for (int r = 12; r < 16; ++r) ATT_VEXP(p0[r]);
    ATT_MM2(3, pa2, pa3);
#undef ATT_VFMA
#undef ATT_VEXP
#undef ATT_MM2
#undef ATT_RD4
#undef ATT_TRRD
}

template <int DQK, int LDQ, int LDKV, int LDO, int BIAS, int QL, class TOut>
struct Body {
    static constexpr int RB = DQK * 2, SHM_K = KVBLK * RB, NKL = (DQK == 192) ? 4 : 2, ND0 = DQK / 16, ND0R = ND0 - QL;
    static constexpr bool TAB = (BIAS == 1 || BIAS == 2);
    static constexpr int OFF_K = 2 * SHM_V, OFF_WS = OFF_K + 2 * SHM_K, OFF_B = OFF_WS + NW * 64 * 4, OFF_Q = OFF_B + 512, LDS_BYTES = OFF_Q + NW * QL * 1024;
    struct Ref { const bf16_t* Q; const bf16_t* K; const bf16_t* V; TOut* O; const float* kb; float bs; int P0, jlo; };
    struct Seam { bf16x8 qr[ND0R > 0 ? ND0R : 1]; bf16x8 st_v0, st_v1; bf16x8 st_k[NKL]; float st_b; };
    template <int KB>
    static __device__ __forceinline__ void qkt(f32x16& p0, f32x16& p1, const char* K_lds, const char* B_lds, const char* Q_lds, int r32, int hi, const bf16x8* qr, float bs, float lb) {
        if (BIAS == 1) { p0 = *reinterpret_cast<const f32x16*>(B_lds + KB * 256 + hi * 128); p1 = *reinterpret_cast<const f32x16*>(B_lds + KB * 256 + hi * 128 + 64); }
        else if (BIAS == 3) {
            const float bs8 = 8.f * bs, bs32 = 32.f * bs;
            p0[0] = lb; p0[1] = p0[0] + bs; p0[2] = p0[1] + bs; p0[3] = p0[2] + bs;
#pragma unroll
            for (int r = 4; r < 16; ++r) p0[r] = p0[r - 4] + bs8;
#pragma unroll
            for (int r = 0; r < 16; ++r) p1[r] = p0[r] + bs32;
        }
        else { p0 = f32x16{}; p1 = f32x16{}; }
        const char* kb[4];
#pragma unroll
        for (int dd = 0; dd < 4; ++dd) kb[dd] = K_lds + KB * SHM_K + r32 * RB + ((dd * 32 + hi * 16) ^ ((r32 & 7) << 4));
#pragma unroll
        for (int d0 = 0; d0 < ND0; ++d0) { const char* a = kb[d0 & 3] + (d0 >> 2) * 128;
            bf16x8 b0 = *reinterpret_cast<const bf16x8*>(a);
            bf16x8 b1 = *reinterpret_cast<const bf16x8*>(a + 32 * RB);
            bf16x8 q; if (d0 < ND0R) q = qr[d0 < ND0R ? d0 : 0]; else q = *reinterpret_cast<const bf16x8*>(Q_lds + (d0 - ND0R) * 1024);
            p0 = __builtin_amdgcn_mfma_f32_32x32x16_bf16(b0, q, p0, 0, 0, 0);
            p1 = __builtin_amdgcn_mfma_f32_32x32x16_bf16(b1, q, p1, 0, 0, 0); }
    }
    static __device__ __forceinline__ void add_bias(f32x16& p0, f32x16& p1, const char* B_lds, int kbuf, int hi) {
#pragma unroll
        for (int g = 0; g < 4; ++g) { const f32x4 b0 = *reinterpret_cast<const f32x4*>(B_lds + kbuf * 256 + hi * 128 + g * 16), b1 = *reinterpret_cast<const f32x4*>(B_lds + kbuf * 256 + hi * 128 + 64 + g * 16);
            p0[4 * g + 0] += b0[0]; p0[4 * g + 1] += b0[1]; p0[4 * g + 2] += b0[2]; p0[4 * g + 3] += b0[3]; p1[4 * g + 0] += b1[0]; p1[4 * g + 1] += b1[1]; p1[4 * g + 2] += b1[2]; p1[4 * g + 3] += b1[3]; }
    }
#define ATT_VMW() asm volatile("s_waitcnt vmcnt(0)" ::: "memory")
#define ATT_VMWN(n) asm volatile("s_waitcnt vmcnt(%0)" :: "i"(n) : "memory")
#define ATT_SLOAD(Kp, Vp, Bp, k0) do { const size_t o_ = (size_t)((k0) + sr) * LDKV + sc; S.st_v0 = ld8((Vp) + o_); S.st_v1 = ld8((Vp) + o_ + 32 * LDKV);              \
        if (DQK >= 128 || sc < 64) { S.st_k[0] = ld8((Kp) + o_); S.st_k[1] = ld8((Kp) + o_ + 32 * LDKV); }                                                             \
        if (DQK == 192) { if (sc < 64) { S.st_k[NKL - 2] = ld8((Kp) + o_ + 128); S.st_k[NKL - 1] = ld8((Kp) + o_ + 32 * LDKV + 128); } }                                \
        if (TAB) { S.st_b = (Bp)[(k0) + lane]; } } while (0)
#define ATT_SWRITE_K(bf) do { if (DQK >= 128 || sc < 64) { *(bf16x8*)(K_lds + (bf) * SHM_K + kws) = S.st_k[0]; *(bf16x8*)(K_lds + (bf) * SHM_K + kws + 32 * RB) = S.st_k[1]; }   \
        if (DQK == 192) { if (sc < 64) { *(bf16x8*)(K_lds + (bf) * SHM_K + kws + 256) = S.st_k[NKL - 2]; *(bf16x8*)(K_lds + (bf) * SHM_K + kws + 32 * RB + 256) = S.st_k[NKL - 1]; } }  \
        if (TAB) { *(float*)(B_lds + (bf) * 256 + bws) = S.st_b; } } while (0)
#define ATT_SWRITE_V(bf) do { *(bf16x8*)(V_lds + (bf) * SHM_V + vst0) = S.st_v0; *(bf16x8*)(V_lds + (bf) * SHM_V + vst1) = S.st_v1; } while (0)
#define ATT_QLOAD(Qp) do { _Pragma("unroll") for (int d0 = 0; d0 < ND0R; ++d0) S.qr[d0] = ld8((Qp) + (size_t)(wid * QBLK + r32) * LDQ + d0 * 16 + hi * 8); } while (0)
#define ATT_QSPILL(Qp) do { if (QL > 0) { bf16x8 t_[QL > 0 ? QL : 1]; _Pragma("unroll") for (int j_ = 0; j_ < QL; ++j_) t_[j_] = ld8((Qp) + (size_t)(wid * QBLK + r32) * LDQ + (ND0R + j_) * 16 + hi * 8);   \
        _Pragma("unroll") for (int j_ = 0; j_ < QL; ++j_) *(bf16x8*)(Q_lds + j_ * 1024) = t_[j_]; } } while (0)
    static __device__ __forceinline__ void prime(const Ref& cur, char* lds, Seam& S) {
        const int tid = threadIdx.x, wid = __builtin_amdgcn_readfirstlane(tid >> 6), lane = tid & 63, r32 = lane & 31, hi = lane >> 5;
        const int sr = tid >> 4, sc = (tid & 15) * 8, kws = sr * RB + (sc >> 6) * 128 + (((sc & 63) * 2) ^ ((sr & 7) << 4));
        const int bws = ((((lane & 31) >> 2) & 1) * 32 + (lane >> 5) * 16 + (lane & 3) + 4 * ((lane & 31) >> 3)) * 4; (void)bws;
        char* K_lds = lds + OFF_K; char* B_lds = lds + OFF_B; (void)B_lds; char* Q_lds = lds + OFF_Q + wid * (QL * 1024) + lane * 16; (void)Q_lds;
        const int kb0 = cur.jlo * KVBLK;
        ATT_QLOAD(cur.Q);
        ATT_SLOAD(cur.K, cur.V, cur.kb, kb0); ATT_VMW(); ATT_SWRITE_K(0); ATT_QSPILL(cur.Q);
        __syncthreads();
    }
    template <class NF>
    static __device__ __forceinline__ void block(const Ref& cur, NF& nf, char* lds, Seam& S, const float SCALE) {
        const int tid = threadIdx.x, wid = __builtin_amdgcn_readfirstlane(tid >> 6), lane = tid & 63, r32 = lane & 31, hi = lane >> 5;
        const int j_lo = cur.jlo, j_hi = (cur.P0 + QB - 1) / KVBLK + 1;
        const int NT = j_hi - j_lo;
        const int qlo = cur.P0 + wid * QBLK, qm = qlo + r32 - 4 * hi;
        char* V_lds = lds; char* K_lds = lds + OFF_K; char* B_lds = lds + OFF_B; (void)B_lds; char* Q_lds = lds + OFF_Q + wid * (QL * 1024) + lane * 16; (void)Q_lds;
        float* ws = (float*)(lds + OFF_WS) + wid * 64; float* li_l = ws, * al_l = ws + 32;
        float m_reg = -1e30f, l_reg = 0; f32x16 o[4] = {};
        const int sr = tid >> 4, sc = (tid & 15) * 8, vst0 = v_st(sr, sc), vst1 = v_st(32 + sr, sc);
        const int kws = sr * RB + (sc >> 6) * 128 + (((sc & 63) * 2) ^ ((sr & 7) << 4));
        const int bws = ((((lane & 31) >> 2) & 1) * 32 + (lane >> 5) * 16 + (lane & 3) + 4 * ((lane & 31) >> 3)) * 4; (void)bws;
        const int vb0 = (int)(uintptr_t)V_lds + v_rd_base(lane);
        const bf16_t* Kh = cur.K; const bf16_t* Vh = cur.V; const float* Bh = cur.kb; const float bs = cur.bs; (void)bs;
#define ATT_RESC(a) do { if (__any((a) < 1.f)) { if (hi == 0) al_l[r32] = (a); asm volatile("s_waitcnt lgkmcnt(0)" ::: "memory");              \
                     _Pragma("unroll") for (int d_ = 0; d_ < 4; ++d_) _Pragma("unroll") for (int r = 0; r < 16; ++r) o[d_][r] *= al_l[crow(r, hi)]; } } while (0)
#define ATT_KBASE(t) ((j_lo + (t)) * KVBLK)
#define ATT_LB(t) ((BIAS == 3) ? bs * (float)(ATT_KBASE(t) - cur.P0 + 4 * hi) : 0.f)
#define ATT_MASKT(P0_, P1_, t, KB_) do { const int kb_ = ATT_KBASE(t); if (BIAS == 2) add_bias(P0_, P1_, B_lds, KB_, hi);                              \
        if (kb_ + KVBLK - 1 > qlo) mask_tile(P0_, P1_, qm - kb_); } while (0)
#define ATT_SEAM_K0() do { ATT_VMWN(ND0R); ATT_SWRITE_K(0); ATT_SBAR(); } while (0)
        f32x16 pA0, pA1, pB0, pB1; float mnA, mnB, alA, alB; bf16x8 pa0, pa1, pa2, pa3;
        ATT_SWRITE_V(0); ATT_SBAR();
        if (NT > 1) { ATT_SLOAD(Kh, Vh, Bh, ATT_KBASE(1)); }
        ATT_SBAR(); qkt<0>(pA0, pA1, K_lds, B_lds, Q_lds, r32, hi, S.qr, bs, ATT_LB(0));
        ATT_MASKT(pA0, pA1, 0, 0); partialSM(pA0, pA1, m_reg, mnA, alA, SCALE);
        if (NT > 1) { ATT_VMW(); ATT_SWRITE_V(1); ATT_SWRITE_K(1); }
        __syncthreads();
#define ATT_HALF_STEP(PX0, PX1, mnX, alX, PY0, PY1, alY, t, KB, VB, SB) do {                                                      \
        ATT_SBAR(); qkt<KB>(PX0, PX1, K_lds, B_lds, Q_lds, r32, hi, S.qr, bs, ATT_LB(t));                                                    \
        finishSM(PY0, PY1, alY, l_reg, pa0, pa1, pa2, pa3); ATT_SBAR();                                                           \
        if ((t) + 1 < NT) { ATT_SLOAD(Kh, Vh, Bh, ATT_KBASE((t) + 1)); ATT_SBAR(); }                                              \
        ATT_MASKT(PX0, PX1, (t), KB); ATT_SBAR(); pv_sm<VB>(o, vb0, pa0, pa1, pa2, pa3, PX0, PX1, m_reg, mnX, alX, SCALE);                        \
        __syncthreads();                                                                                                      \
        if ((t) + 1 < NT) { ATT_VMW(); ATT_SWRITE_V(SB); ATT_SWRITE_K(SB); }                                                      \
        ATT_RESC(alX); __syncthreads(); } while (0)
        bool issued = false;
        for (int t = 1; t + 1 < NT; t += 2) {
            if (!issued && t + 8 >= NT) { nf.issue(); issued = true; }
            ATT_HALF_STEP(pB0, pB1, mnB, alB, pA0, pA1, alA, t, 1, 0, 0);
            ATT_HALF_STEP(pA0, pA1, mnA, alA, pB0, pB1, alB, t + 1, 0, 1, 1);
        }
        const bool even = (NT & 1) == 0;
        if (even) { ATT_SBAR(); qkt<1>(pB0, pB1, K_lds, B_lds, Q_lds, r32, hi, S.qr, bs, ATT_LB(NT - 1)); ATT_SBAR(); }
        if (!issued) nf.issue();
        const Ref nxt = nf.get(cur); const int kbn = nxt.jlo * KVBLK;
        ATT_SLOAD(nxt.K, nxt.V, nxt.kb, kbn); ATT_SBAR();
        ATT_QLOAD(nxt.Q);
        ATT_SBAR();
        finishSM(pA0, pA1, alA, l_reg, pa0, pa1, pa2, pa3); ATT_SBAR();
        pv_tile<0>(o, vb0, pa0, pa1, pa2, pa3);
        if (even) { ATT_MASKT(pB0, pB1, NT - 1, 1); partialSM(pB0, pB1, m_reg, mnB, alB, SCALE); __syncthreads(); ATT_RESC(alB);
            finishSM(pB0, pB1, alB, l_reg, pa0, pa1, pa2, pa3); ATT_SBAR(); pv_tile<1>(o, vb0, pa0, pa1, pa2, pa3); }
        ATT_SBAR(); ATT_SEAM_K0();
        if (hi == 0) li_l[r32] = l_reg; asm volatile("s_waitcnt lgkmcnt(0)" ::: "memory");
        float rli[16];
#pragma unroll
        for (int r = 0; r < 16; ++r) rli[r] = __builtin_amdgcn_rcpf(li_l[crow(r, hi)]);
        TOut* Ow = cur.O + (size_t)(wid * QBLK) * LDO;
        if constexpr (sizeof(TOut) == 4) {
#pragma unroll
            for (int r = 0; r < 16; ++r) { const int orow = crow(r, hi);
#pragma unroll
                for (int d0 = 0; d0 < 4; ++d0) Ow[(size_t)orow * LDO + d0 * 32 + r32] = o[d0][r] * rli[r]; }
        } else {
            const bool odd = (r32 & 1) != 0; bf16_t* Ob = (bf16_t*)Ow + (odd ? 32 + r32 - 1 : r32);
#pragma unroll
            for (int r = 0; r < 16; ++r) { const int orow = crow(r, hi); const float v0 = o[0][r] * rli[r], v1 = o[1][r] * rli[r], v2 = o[2][r] * rli[r], v3 = o[3][r] * rli[r];
                const float s01 = odd ? v0 : v1, s23 = odd ? v2 : v3;
                const float g01 = __builtin_bit_cast(float, __builtin_amdgcn_update_dpp(0, __builtin_bit_cast(int, s01), 0xB1, 0xF, 0xF, false));
                const float g23 = __builtin_bit_cast(float, __builtin_amdgcn_update_dpp(0, __builtin_bit_cast(int, s23), 0xB1, 0xF, 0xF, false));
                const unsigned w01 = odd ? cvtpk(g01, v1) : cvtpk(v0, g01), w23 = odd ? cvtpk(g23, v3) : cvtpk(v2, g23);
                *(unsigned*)(Ob + (size_t)orow * LDO) = w01; *(unsigned*)(Ob + (size_t)orow * LDO + 64) = w23; }
        }
        ATT_QSPILL(nxt.Q);
        __syncthreads();
#undef ATT_RESC
#undef ATT_KBASE
#undef ATT_LB
#undef ATT_MASKT
#undef ATT_SEAM_K0
#undef ATT_HALF_STEP
    }
#undef ATT_VMW
#undef ATT_VMWN
#undef ATT_SLOAD
#undef ATT_SWRITE_K
#undef ATT_SWRITE_V
#undef ATT_QLOAD
#undef ATT_QSPILL
};
template <class B> struct StaticNext { typename B::Ref nxt; __device__ __forceinline__ void issue() {} __device__ __forceinline__ typename B::Ref get(const typename B::Ref&) { return nxt; } };
template <class B, class Dec>
__device__ __forceinline__ void stream(char* lds, int nblk, const Dec& dec, const float scale) {
    if (nblk <= 0) return;
    typename B::Ref cur = dec(0); typename B::Seam S;
    B::prime(cur, lds, S);
    for (int n = 0; n < nblk; ++n) {
        StaticNext<B> nf; nf.nxt = (n + 1 < nblk) ? dec(n + 1) : cur;
        B::block(cur, nf, lds, S, scale);
        cur = nf.nxt;
    }
}
template <class B, class Dec> struct QueueNext {
    unsigned* ctr; volatile __attribute__((address_space(3))) unsigned* slot; const Dec* dec; int total; unsigned claim; bool more; int pnext;
    __device__ __forceinline__ void issue() { if (threadIdx.x == 0) claim = __hip_atomic_fetch_add(ctr, 1u, __ATOMIC_RELAXED, __HIP_MEMORY_SCOPE_AGENT); }
    __device__ __forceinline__ typename B::Ref get(const typename B::Ref& cur) {
        if (threadIdx.x == 0) slot[2] = claim;
        __syncthreads();
        const int p = (int)slot[2]; more = p < total; pnext = p;
        return more ? (*dec)(p) : cur; }
    __device__ __forceinline__ typename B::Ref get_last() const { return (*dec)(pnext); }
};
template <class B, class Dec>
__device__ __forceinline__ void stream_dyn(char* lds, int total, unsigned* ctr, volatile __attribute__((address_space(3))) unsigned* slot, const Dec& dec, const float scale) {
    if (threadIdx.x == 0) slot[0] = __hip_atomic_fetch_add(ctr, 1u, __ATOMIC_RELAXED, __HIP_MEMORY_SCOPE_AGENT);
    __syncthreads();
    const int pc = (int)slot[0];
    if (pc >= total) return;
    typename B::Ref cur = dec(pc); typename B::Seam S;
    B::prime(cur, lds, S);
    QueueNext<B, Dec> nf; nf.ctr = ctr; nf.slot = slot; nf.dec = &dec; nf.total = total; nf.claim = 0u; nf.more = false;
    for (;;) {
        B::block(cur, nf, lds, S, scale);
        if (!nf.more) break;
        cur = nf.get_last(); }
}
#undef ATT_SBAR
}
#define GAS __attribute__((address_space(1)))
#define LAS __attribute__((address_space(3)))
typedef unsigned short bf16;
typedef unsigned v4u __attribute__((ext_vector_type(4)));
typedef float f32x4 __attribute__((ext_vector_type(4)));
typedef short bf16x8 __attribute__((ext_vector_type(8)));
typedef GAS unsigned gu32;
typedef GAS unsigned long long gu64;
#define RLX_AGENT __ATOMIC_RELAXED, __HIP_MEMORY_SCOPE_AGENT
#define LDS_WAIT() asm volatile("s_waitcnt lgkmcnt(0)" ::: "memory")
#define VM_WAIT() asm volatile("s_waitcnt vmcnt(0)" ::: "memory")
__device__ __forceinline__ unsigned long long rt() { return __builtin_amdgcn_s_memrealtime(); }
__device__ __forceinline__ unsigned f2bf(float f) { unsigned u = __builtin_bit_cast(unsigned, f); return (u + 0x7fffu + ((u >> 16) & 1u)) >> 16; }
__device__ __forceinline__ unsigned pk2(float lo, float hi) { return f2bf(lo) | (f2bf(hi) << 16); }

#define XB_TMO      128
#define XB_XCNT(j)  (256  + 64 * (j))
#define XB_XSUB(j)  (1280 + 64 * (j))
#define XB_XGEN(j)  (2304 + 64 * (j))
#define XB_TOP      3328
#define XB_TOPGEN   3392
#define XCD_BAR_WORDS 3456
#define XB_SPIN_CAP (1u << 18)

__device__ __forceinline__ unsigned xb_ld(unsigned* p)              { return __hip_atomic_load(p, __ATOMIC_RELAXED, __HIP_MEMORY_SCOPE_AGENT); }
__device__ __forceinline__ unsigned xb_add(unsigned* p, unsigned v) { return __hip_atomic_fetch_add(p, v, __ATOMIC_RELAXED, __HIP_MEMORY_SCOPE_AGENT); }
__device__ __forceinline__ unsigned xb_xcc_id() { return (unsigned)__builtin_amdgcn_s_getreg((3 << 11) | 20) & 0xFu; }
#define XB_SPIN(cond, bar) do { unsigned _sp = 0; while (cond) { __builtin_amdgcn_s_sleep(1); \
    if ((++_sp & 255u) == 0u) { if (xb_ld(&(bar)[XB_TMO])) break; if (_sp > XB_SPIN_CAP) { atomicAdd(&(bar)[XB_TMO], 1u); break; } } } } while (0)

struct XcdBarrier {
    unsigned* bar; unsigned x;
    volatile LAS unsigned* st;
};

__device__ __forceinline__ XcdBarrier xcd_barrier_post(unsigned* bar, volatile LAS unsigned* st) {
    XcdBarrier b; b.bar = bar; b.x = xb_xcc_id(); b.st = st;
    if (threadIdx.x == 0) (void)xb_add(&bar[XB_XCNT(b.x)], 1u);
    return b;
}
__device__ __forceinline__ void xcd_barrier_complete(unsigned* bar, unsigned x, unsigned& nloc, unsigned& nx) {
    const unsigned G = gridDim.x * gridDim.y * gridDim.z;
    unsigned sum, cnt, mine, sp = 0u;
    for (;;) {
        sum = 0u; cnt = 0u; mine = 0u;
#pragma unroll
        for (unsigned j = 0; j < 16; ++j) { const unsigned c = xb_ld(&bar[XB_XCNT(j)]); sum += c; cnt += (c > 0u) ? 1u : 0u; mine = (j == x) ? c : mine; }
        if (sum == G) break;
        __builtin_amdgcn_s_sleep(1);
        if ((++sp & 255u) == 0u) { if (xb_ld(&bar[XB_TMO])) break; if (sp > XB_SPIN_CAP) { atomicAdd(&bar[XB_TMO], 1u); break; } }
    }
    nloc = mine > 0u ? mine : 1u; nx = cnt > 0u ? cnt : 1u;
}

__device__ __forceinline__ void xcd_barrier(const XcdBarrier& b) {
    asm volatile("s_waitcnt vmcnt(0)" ::: "memory");
    __syncthreads();
    if (threadIdx.x == 0) {
        unsigned* bar = b.bar;
        __builtin_amdgcn_s_waitcnt(0);
        unsigned nloc = b.st[0], nx = b.st[1];
        if (nloc == 0u) { xcd_barrier_complete(bar, b.x, nloc, nx); b.st[0] = nloc; b.st[1] = nx; }
        const unsigned old = xb_add(&bar[XB_XSUB(b.x)], 1u);
        const unsigned gen = old / nloc;
        if (old + 1u == (gen + 1u) * nloc) {
            __builtin_amdgcn_fence(__ATOMIC_RELEASE, "agent");
            asm volatile("s_waitcnt vmcnt(0)" ::: "memory");
            const unsigned og = xb_add(&bar[XB_TOP], 1u);
            const unsigned tg = og / nx;
            if (og + 1u == (tg + 1u) * nx) xb_add(&bar[XB_TOPGEN], 1u);
            else XB_SPIN(xb_ld(&bar[XB_TOPGEN]) == tg, bar);
            __builtin_amdgcn_fence(__ATOMIC_ACQUIRE, "agent");
            xb_add(&bar[XB_XGEN(b.x)], 1u);
            asm volatile("s_waitcnt vmcnt(0)" ::: "memory");
        } else {
            XB_SPIN(xb_ld(&bar[XB_XGEN(b.x)]) == gen, bar);
            __builtin_amdgcn_fence(__ATOMIC_ACQUIRE, "agent");
            asm volatile("s_waitcnt vmcnt(0)" ::: "memory");
        }
    }
    __syncthreads();
}
constexpr int NWAVES = 8;
#ifndef MK_PER_PHASE
#define MK_PER_PHASE 0
#endif
constexpr int NPH = 21;

constexpr int S = 16384, DM = 2048, FF = 5632, NE = 8;
constexpr int N_IN0 = 4160, N_IN0P = 4352, N_IN1 = 6160, N_IN1P = 6400, NP0 = 4096;
constexpr float SCALE_A = 0.125f, SCALE_B = 0.07216878364870322f, SCALE_C = 0.08838834764831845f;

constexpr size_t MiB = 1u << 20;
constexpr size_t WS_CTL = 0, CTL_ZERO_BYTES = 1 * MiB;
constexpr size_t WS_ROPE = 1 * MiB, WS_KBC = 6 * MiB, WS_LOGF = 7 * MiB, WS_CSUM = 8 * MiB, WS_ROUTE = 8 * MiB + 512 * 1024, WS_CNTG = 9 * MiB, WS_TOT = 9 * MiB + 64 * 1024, WS_SCL = 9 * MiB + 64 * 1024 + 1024  ,
                 WS_TOKPOS = 9 * MiB + 512 * 1024, WS_GATES = 10 * MiB, WS_STATA = 5 * MiB, WS_STATC = 5 * MiB + 64 * 1024, WS_FPART = 11 * MiB, WS_KPART = 1096 * MiB, WS_PART = 880 * MiB,
                 WS_PS = 1 * MiB  , WS_RSTD = 5 * MiB + 256 * 1024, WS_RSTDS = 5 * MiB + 512 * 1024;
constexpr size_t WS_WIN0 = 16 * MiB, WS_WUQ = 33 * MiB, WS_WUKV = 35 * MiB, WS_WOUT0 = 37 * MiB, WS_WGU0 = 45 * MiB, WS_WD0 = 89 * MiB, WS_WIN1 = 111 * MiB, WS_WOUT1 = 136 * MiB,
                 WS_WGU1 = 144 * MiB, WS_WD1 = 496 * MiB;
constexpr size_t WS_XN = 672 * MiB;
constexpr size_t WS_PROJ0 = 736 * MiB, WS_CQN = 872 * MiB, WS_CKVN = 888 * MiB, WS_KF = 904 * MiB  , WS_QB = 984 * MiB, WS_OA = 1032 * MiB, WS_MIX = 1160 * MiB, WS_HMID0 = 736 * MiB;
constexpr size_t WS_A8 = 984 * MiB  , WS_QKV1 = 736 * MiB, WS_O1 = 928 * MiB, WS_AS = 736 * MiB, WS_HMS = 1024 * MiB, WS_YS = 736 * MiB;
constexpr size_t WS_END = 1398 * MiB;
constexpr int MPAD = 34816;
static_assert(WS_WD1 + (size_t)NE * DM * FF * 2 <= WS_XN && WS_HMS + (size_t)MPAD * FF * 2 <= WS_END && WS_YS + (size_t)MPAD * DM * 4 <= WS_HMS && WS_MIX + (size_t)S * DM * 2 <= WS_END, "d_ws map");
constexpr int CW_TMO = 0, CW_CODE = 1, CW_BAR = 4096, CW_QA = 8192, CW_QC = 8256, CW_SPLIT = 12288;

constexpr int RING_BYTES = 150528;
constexpr int LDSCTL_OFF = RING_BYTES, MISC_OFF = LDSCTL_OFF + 320;
constexpr int LDS_BYTES = RING_BYTES + 512;
static_assert(MISC_OFF + 128 <= LDS_BYTES, "LDS map");

typedef unsigned v2u __attribute__((ext_vector_type(2)));
__device__ __forceinline__ float bflo(unsigned w) { return __builtin_bit_cast(float, w << 16); }
__device__ __forceinline__ float bfhi(unsigned w) { return __builtin_bit_cast(float, w & 0xffff0000u); }
__device__ __forceinline__ float wave_sum(float v) {
#pragma unroll
    for (int o = 1; o < 64; o <<= 1) v += __shfl_xor(v, o);
    return v;
}
__device__ const float ROPE_INV[32] = {1.000000000e+00f, 7.498942614e-01f, 5.623413324e-01f, 4.216965139e-01f, 3.162277639e-01f, 2.371373773e-01f, 1.778279394e-01f, 1.333521307e-01f,
    1.000000015e-01f, 7.498941571e-02f, 5.623413250e-02f, 4.216965288e-02f, 3.162277490e-02f, 2.371373773e-02f, 1.778279431e-02f, 1.333521493e-02f, 9.999999776e-03f, 7.498941850e-03f,
    5.623413250e-03f, 4.216964822e-03f, 3.162277630e-03f, 2.371373586e-03f, 1.778279431e-03f, 1.333521446e-03f, 1.000000047e-03f, 7.498942432e-04f, 5.623413017e-04f, 4.216965172e-04f,
    3.162277571e-04f, 2.371373703e-04f, 1.778279402e-04f, 1.333521504e-04f};

struct Args { const float* in[27]; float* out; unsigned char* ws; int ph_lo, ph_hi; };
enum { I_X = 0, I_EV_ATTN_NORM, I_EV_W_IN, I_EV_Q_NORM, I_EV_W_UQ, I_EV_KV_NORM, I_EV_W_UKV, I_EV_LQ1, I_EV_LK1, I_EV_LQ2, I_EV_LK2, I_EV_SUBLN, I_EV_W_OUT, I_EV_FFN_NORM, I_EV_W_GATE, I_EV_W_UP,
       I_EV_W_DOWN, I_OD_ATTN_NORM, I_OD_W_IN, I_OD_FBIAS, I_OD_W_OUT, I_OD_FFN_NORM, I_OD_ROUTER, I_OD_W_GATE, I_OD_W_UP, I_OD_W_DOWN, I_FINAL_NORM };

__device__ __forceinline__ int rowmap(int type, int n) {
    if (type == 1) return (n >> 7) * 256 + (n & 127);
    if (type == 2) return (n >> 7) * 256 + 128 + (n & 127);
    if (type == 3) { const int h = n / 192, w = n - h * 192; if (w < 128) return h * 128 + w; const int i = w & 31, half = (w - 128) >> 5; return (4 + (h >> 2)) * 256 + half * 128 + (h & 3) * 32 + i; }
    return n;
}
using pg8::pk8x4;
constexpr float H8_SCALE = 8.f;
__device__ __forceinline__ unsigned pki8x4(float a, float b, float c, float d) {
    const int ia = (int)__builtin_rintf(__builtin_amdgcn_fmed3f(a, -127.f, 127.f)), ib = (int)__builtin_rintf(__builtin_amdgcn_fmed3f(b, -127.f, 127.f)), ic = (int)__builtin_rintf(__builtin_amdgcn_fmed3f(c, -127.f, 127.f)), id = (int)__builtin_rintf(__builtin_amdgcn_fmed3f(d, -127.f, 127.f));
    return ((unsigned)ia & 255u) | (((unsigned)ib & 255u) << 8) | (((unsigned)ic & 255u) << 16) | ((unsigned)id << 24); }
template <bool PAIR, bool GAIN>
__device__ __forceinline__ float w_clip_t(const float* Wa, const float* Wb, int N, const float* gain, int lane) {
    f32x4 a[16], b[PAIR ? 16 : 1]; float g[GAIN ? 16 : 1];
#pragma unroll
    for (int k = 0; k < 16; ++k) { a[k] = *(const GAS f32x4*)(Wa + (size_t)k * N + 4 * lane); if (PAIR) b[PAIR ? k : 0] = *(const GAS f32x4*)(Wb + (size_t)k * N + 4 * lane); if (GAIN) g[GAIN ? k : 0] = gain[k]; }
    float ss = 0.f;
#pragma unroll
    for (int k = 0; k < 16; ++k) { const float gg = GAIN ? g[GAIN ? k : 0] : 1.f; const f32x4 x = a[k] * gg; ss += (x.x * x.x + x.y * x.y) + (x.z * x.z + x.w * x.w);
        if (PAIR) { const f32x4 y = b[PAIR ? k : 0] * gg; ss += (y.x * y.x + y.y * y.y) + (y.z * y.z + y.w * y.w); } }
    return fmaxf(4.f * sqrtf(wave_sum(ss) * (PAIR ? 1.f / 8192.f : 1.f / 4096.f)), 1e-30f);
}
__device__ __forceinline__ float w_clip(const float* Wa, const float* Wb, int N, const float* gain, int lane) {
    if (Wb) return gain ? w_clip_t<true, true>(Wa, Wb, N, gain, lane) : w_clip_t<true, false>(Wa, Wb, N, gain, lane);
    return gain ? w_clip_t<false, true>(Wa, Wb, N, gain, lane) : w_clip_t<false, false>(Wa, Wb, N, gain, lane);
}
__device__ __forceinline__ float w_clip_experts(const float* Wa, const float* Wb, int K, int N, const float* gain, int lane) {
    f32x4 a[NE][2], b[NE][2]; const float g0 = gain ? gain[0] : 1.f, g1 = gain ? gain[1] : 1.f;
#pragma unroll
    for (int e = 0; e < NE; ++e)
#pragma unroll
        for (int k = 0; k < 2; ++k) { a[e][k] = *(const GAS f32x4*)(Wa + ((size_t)e * K + k) * N + 4 * lane); b[e][k] = *(const GAS f32x4*)(Wb + ((size_t)e * K + k) * N + 4 * lane); }
    float c = 0.f;
#pragma unroll
    for (int e = 0; e < NE; ++e) { float ss = 0.f;
#pragma unroll
        for (int k = 0; k < 2; ++k) { const float g = k ? g1 : g0; const f32x4 x = a[e][k] * g, y = b[e][k] * g;
            ss += ((x.x * x.x + x.y * x.y) + (x.z * x.z + x.w * x.w)) + ((y.x * y.x + y.y * y.y) + (y.z * y.z + y.w * y.w)); }
        c = fmaxf(c, wave_sum(ss)); }
    return fmaxf(4.f * sqrtf(c * (1.f / 1024.f)), 1e-30f);
}
__device__ __forceinline__ float w8_scale_experts(const float* W, int K, int N, int lane) {
    f32x4 a[NE][2];
#pragma unroll
    for (int e = 0; e < NE; ++e)
#pragma unroll
        for (int k = 0; k < 2; ++k) a[e][k] = *(const GAS f32x4*)(W + ((size_t)e * K + k) * N + 4 * lane);
    float c = 0.f;
#pragma unroll
    for (int e = 0; e < NE; ++e) { float ss = 0.f;
#pragma unroll
        for (int k = 0; k < 2; ++k) { const f32x4 x = a[e][k]; ss += (x.x * x.x + x.y * x.y) + (x.z * x.z + x.w * x.w); }
        c = fmaxf(c, wave_sum(ss)); }
    return exp2f(floorf(log2f(2.f / fmaxf(sqrtf(c * (1.f / 512.f)), 1e-30f))));
}
struct TrJob { const float* W; int K, N; bf16* WT; int type, nbn, per, rows_per; const float* gain; int f8; float qs; int nb_lo; };
__device__ __forceinline__ void tr_load(const TrJob& J, int it, int lane, f32x4 (&v)[16]) {
    const int s = it / J.per, r = it - s * J.per, kb = r / J.nbn, nb = J.nb_lo + (r - kb * J.nbn);
    const int k0 = 64 * kb, n0 = 64 * nb, n4 = (lane & 15) * 4, kq = lane >> 4; const float* W = J.W + (size_t)s * J.K * J.N;
#pragma unroll
    for (int j = 0; j < 16; ++j) { const int k = 4 * j + kq; v[j] = (n0 + n4 < J.N) ? *(const GAS f32x4*)(W + (size_t)(k0 + k) * J.N + n0 + n4) : (f32x4){0.f, 0.f, 0.f, 0.f}; }
}
__device__ __forceinline__ void tr_store(const TrJob& J, int it, int lane, const f32x4 (&v)[16], LAS float* scr) {
    const int s = it / J.per, r = it - s * J.per, kb = r / J.nbn, nb = J.nb_lo + (r - kb * J.nbn);
    const int k0 = 64 * kb, n0 = 64 * nb, n4 = (lane & 15) * 4, kq = lane >> 4; bf16* WT = J.WT + (size_t)s * J.rows_per * J.K;
#pragma unroll
    for (int j = 0; j < 16; ++j) { const int k = 4 * j + kq; LAS float* d = scr + k * 65 + n4; d[0] = v[j].x; d[1] = v[j].y; d[2] = v[j].z; d[3] = v[j].w; }
    LDS_WAIT(); asm volatile("" ::: "memory");
    if (J.f8) {
        const int c4 = lane & 3; f32x4 g[4] = {(f32x4){1.f, 1.f, 1.f, 1.f}, (f32x4){1.f, 1.f, 1.f, 1.f}, (f32x4){1.f, 1.f, 1.f, 1.f}, (f32x4){1.f, 1.f, 1.f, 1.f}};
        if (J.gain) {
#pragma unroll
            for (int t = 0; t < 4; ++t) g[t] = *(const GAS f32x4*)(J.gain + k0 + 16 * c4 + 4 * t); }
#pragma unroll
        for (int t = 0; t < 4; ++t) g[t] = g[t] * J.qs;
#pragma unroll
        for (int i = 0; i < 4; ++i) { const int n = 16 * i + (lane >> 2); const LAS float* q = scr + (16 * c4) * 65 + n; v4u o;
            if (J.f8 == 2) { o.x = pki8x4(q[0 * 65] * g[0].x, q[1 * 65] * g[0].y, q[2 * 65] * g[0].z, q[3 * 65] * g[0].w); o.y = pki8x4(q[4 * 65] * g[1].x, q[5 * 65] * g[1].y, q[6 * 65] * g[1].z, q[7 * 65] * g[1].w);
                             o.z = pki8x4(q[8 * 65] * g[2].x, q[9 * 65] * g[2].y, q[10 * 65] * g[2].z, q[11 * 65] * g[2].w); o.w = pki8x4(q[12 * 65] * g[3].x, q[13 * 65] * g[3].y, q[14 * 65] * g[3].z, q[15 * 65] * g[3].w); }
            else { o.x = pk8x4(q[0 * 65] * g[0].x, q[1 * 65] * g[0].y, q[2 * 65] * g[0].z, q[3 * 65] * g[0].w); o.y = pk8x4(q[4 * 65] * g[1].x, q[5 * 65] * g[1].y, q[6 * 65] * g[1].z, q[7 * 65] * g[1].w);
                   o.z = pk8x4(q[8 * 65] * g[2].x, q[9 * 65] * g[2].y, q[10 * 65] * g[2].z, q[11 * 65] * g[2].w); o.w = pk8x4(q[12 * 65] * g[3].x, q[13 * 65] * g[3].y, q[14 * 65] * g[3].z, q[15 * 65] * g[3].w); }
            if (n0 + n < ((J.N + 31) & ~31)) *(GAS v4u*)((unsigned char*)J.WT + ((size_t)s * J.rows_per + rowmap(J.type, n0 + n)) * J.K + k0 + 16 * c4) = o; }
    } else {
        const int c = lane & 7;
        f32x4 g0 = (f32x4){1.f, 1.f, 1.f, 1.f}, g1 = g0; if (J.gain) { g0 = *(const GAS f32x4*)(J.gain + k0 + 8 * c); g1 = *(const GAS f32x4*)(J.gain + k0 + 8 * c + 4); }
#pragma unroll
        for (int i = 0; i < 8; ++i) { const int n = 8 * i + (lane >> 3); const LAS float* q = scr + (8 * c) * 65 + n;
            const float f0 = q[0 * 65] * g0.x, f1 = q[1 * 65] * g0.y, f2 = q[2 * 65] * g0.z, f3 = q[3 * 65] * g0.w, f4 = q[4 * 65] * g1.x, f5 = q[5 * 65] * g1.y, f6 = q[6 * 65] * g1.z, f7 = q[7 * 65] * g1.w;
            v4u o; o.x = pg8::cvt_pk_bf16(f0, f1); o.y = pg8::cvt_pk_bf16(f2, f3); o.z = pg8::cvt_pk_bf16(f4, f5); o.w = pg8::cvt_pk_bf16(f6, f7);
            if (n0 + n < ((J.N + 31) & ~31)) *(GAS v4u*)(WT + (size_t)rowmap(J.type, n0 + n) * J.K + k0 + 8 * c) = o; }
    }
    LDS_WAIT(); asm volatile("" ::: "memory");
}
__device__ __forceinline__ void tr_matrix(const float* W, int K, int N, int NS, int rows_per, bf16* WT, int type, LAS float* scr, int gw, int NGW, int lane, const float* gain = nullptr, int f8 = 0, float qs = 0.f, int nb_lo = 0) {
    TrJob J; J.gain = gain; J.f8 = f8; J.qs = qs; J.nb_lo = nb_lo; J.W = W; J.K = K; J.N = N; J.WT = WT; J.type = type; J.nbn = (N + 63) / 64 - nb_lo; J.per = J.nbn * (K / 64); J.rows_per = rows_per;
    const int total = J.per * NS; int it = gw; if (it >= total) return;
    f32x4 va[16], vb[16];
    tr_load(J, it, lane, va);
    for (;;) {
        const int it2 = it + NGW; const bool h2 = it2 < total; if (h2) tr_load(J, it2, lane, vb);
        tr_store(J, it, lane, va, scr);
        if (!h2) break;
        const int it3 = it2 + NGW; const bool h3 = it3 < total; if (h3) tr_load(J, it3, lane, va);
        tr_store(J, it2, lane, vb, scr);
        if (!h3) break;
        it = it3;
    }
}
__device__ __forceinline__ void rms_row_bf16(const float* xrow, const float* g, bf16* orow, float eps, int lane, unsigned char* o8row = nullptr, float* cst = nullptr, float wsc = 0.f) {
    const GAS f32x4* xr = (const GAS f32x4*)xrow + lane; const GAS f32x4* gr = (const GAS f32x4*)g + lane;
    f32x4 v[8]; float s = 0.f;
#pragma unroll
    for (int j = 0; j < 8; ++j) { v[j] = xr[64 * j]; s += (v[j].x * v[j].x + v[j].y * v[j].y) + (v[j].z * v[j].z + v[j].w * v[j].w); }
    const float rstd = 1.0f / sqrtf(wave_sum(s) * (1.f / DM) + eps);
    GAS unsigned long long* o8 = (GAS unsigned long long*)orow + lane; float am = 0.f;
#pragma unroll
    for (int j = 0; j < 8; ++j) { const f32x4 gg = gr[64 * j]; const f32x4 y = (v[j] * rstd) * gg; o8[64 * j] = (unsigned long long)pk2(y.x, y.y) | ((unsigned long long)pk2(y.z, y.w) << 32);
        v[j] = y; am = fmaxf(am, fmaxf(fmaxf(fabsf(y.x), fabsf(y.y)), fmaxf(fabsf(y.z), fabsf(y.w)))); }
    if (o8row) {
#pragma unroll
        for (int o = 32; o > 0; o >>= 1) am = fmaxf(am, __shfl_xor(am, o));
        am = fmaxf(am, 1e-30f); const float qs = 127.f / am; GAS unsigned* q = (GAS unsigned*)o8row + lane;
#pragma unroll
        for (int j = 0; j < 8; ++j) q[64 * j] = pki8x4(v[j].x * qs, v[j].y * qs, v[j].z * qs, v[j].w * qs);
        if (lane == 0) *cst = (am * (1.f / 127.f)) * wsc; }
}
__device__ __forceinline__ void rstd_rows(const float* ps, float* rstd, int b, int G, int tid) {
    for (int row = b * (NWAVES * 64) + tid; row < S; row += G * NWAVES * 64) { const GAS f32x4* p = (const GAS f32x4*)(ps + (size_t)row * 32); float s = 0.f;
#pragma unroll
        for (int j = 0; j < 8; ++j) { const f32x4 v = p[j]; s += (v.x + v.y) + (v.z + v.w); }
        rstd[row] = 1.0f / sqrtf(s * (1.f / DM) + 1e-6f); }
}
__device__ __forceinline__ void rows_i8(const bf16* H, const float* ps, float* rstd, unsigned char* A8, float* cst, const float wsc, int gw, int NGW, int lane) {
    for (int row = gw; row < S; row += NGW) {
        const float rs = 1.0f / sqrtf(wave_sum(lane < 32 ? ps[(size_t)row * 32 + lane] : 0.f) * (1.f / DM) + 1e-6f);
        const GAS v4u* src = (const GAS v4u*)(H + (size_t)row * DM) + lane; const v4u x[4] = {src[0], src[64], src[128], src[192]}; float am = 0.f;
#pragma unroll
        for (int j = 0; j < 4; ++j) { am = fmaxf(am, fmaxf(fmaxf(fabsf(bflo(x[j].x)), fabsf(bfhi(x[j].x))), fmaxf(fabsf(bflo(x[j].y)), fabsf(bfhi(x[j].y))))); am = fmaxf(am, fmaxf(fmaxf(fabsf(bflo(x[j].z)), fabsf(bfhi(x[j].z))), fmaxf(fabsf(bflo(x[j].w)), fabsf(bfhi(x[j].w))))); }
#pragma unroll
        for (int o = 32; o > 0; o >>= 1) am = fmaxf(am, __shfl_xor(am, o));
        am = fmaxf(am, 1e-30f); const float qs = 127.f / am;
        GAS v2u* dst = (GAS v2u*)(A8 + (size_t)row * DM) + lane;
#pragma unroll
        for (int j = 0; j < 4; ++j) { v2u o; o.x = pki8x4(bflo(x[j].x) * qs, bfhi(x[j].x) * qs, bflo(x[j].y) * qs, bfhi(x[j].y) * qs); o.y = pki8x4(bflo(x[j].z) * qs, bfhi(x[j].z) * qs, bflo(x[j].w) * qs, bfhi(x[j].w) * qs); dst[64 * j] = o; }
        if (lane == 0) { rstd[row] = rs; cst[row] = (am * (1.f / 127.f)) * rs * wsc; } }
}
__device__ __forceinline__ void rms512_bf16(const bf16* src, const float* g, bf16* dst, int lane) {
    const v4u raw = *(const GAS v4u*)(src + 8 * lane);
    float x[8] = {bflo(raw.x), bfhi(raw.x), bflo(raw.y), bfhi(raw.y), bflo(raw.z), bfhi(raw.z), bflo(raw.w), bfhi(raw.w)};
    float s = 0.f;
#pragma unroll
    for (int e = 0; e < 8; ++e) s += x[e] * x[e];
    const float rstd = 1.0f / sqrtf(wave_sum(s) * (1.f / 512.f) + 1e-6f);
    const f32x4 g0 = *(const GAS f32x4*)(g + 8 * lane), g1 = *(const GAS f32x4*)(g + 8 * lane + 4);
    v4u o; o.x = pk2(x[0] * rstd * g0.x, x[1] * rstd * g0.y); o.y = pk2(x[2] * rstd * g0.z, x[3] * rstd * g0.w); o.z = pk2(x[4] * rstd * g1.x, x[5] * rstd * g1.y); o.w = pk2(x[6] * rstd * g1.z, x[7] * rstd * g1.w);
    *(GAS v4u*)(dst + 8 * lane) = o;
}
__device__ __forceinline__ void sincos_d(float ang, float& sn, float& cs) {
    const double t0 = (double)ang * 0.15915494309189535; const double t = t0 - __builtin_rint(t0); const double x = t * 6.283185307179586, x2 = x * x;
    double sp = -1.0 / 51090942171709440000.0;
    sp = sp * x2 + 1.0 / 121645100408832000.0; sp = sp * x2 - 1.0 / 355687428096000.0; sp = sp * x2 + 1.0 / 1307674368000.0; sp = sp * x2 - 1.0 / 6227020800.0; sp = sp * x2 + 1.0 / 39916800.0;
    sp = sp * x2 - 1.0 / 362880.0; sp = sp * x2 + 1.0 / 5040.0; sp = sp * x2 - 1.0 / 120.0; sp = sp * x2 + 1.0 / 6.0; sp = sp * x2 - 1.0; sn = (float)(-sp * x);
    double cp = 1.0 / 1124000727777607680000.0;
    cp = cp * x2 - 1.0 / 2432902008176640000.0; cp = cp * x2 + 1.0 / 6402373705728000.0; cp = cp * x2 - 1.0 / 20922789888000.0; cp = cp * x2 + 1.0 / 87178291200.0; cp = cp * x2 - 1.0 / 479001600.0;
    cp = cp * x2 + 1.0 / 3628800.0; cp = cp * x2 - 1.0 / 40320.0; cp = cp * x2 + 1.0 / 720.0; cp = cp * x2 - 1.0 / 24.0; cp = cp * x2 + 0.5; cp = cp * x2 - 1.0; cs = (float)(-cp);
}

typedef att::Body<64, NP0, NP0, 2048, 3, 0, bf16> BodyA;
typedef att::Body<192, 1536, 2560, 2048, 0, 8, bf16> BodyB;
typedef att::Body<128, 6144, 6144, 2048, 1, 2, bf16> BodyC;
struct DecB { const bf16* Qb; const bf16* KV; bf16* MIX; int vcu, G;
    __device__ __forceinline__ BodyB::Ref operator()(int n) const { const int it = vcu + (n >> 1) * G, h = it >> 5, x = it & 31, qb = (n & 1) ? 63 - x : x;
        BodyB::Ref r; r.Q = Qb + (size_t)(qb * 256) * 1536 + h * 192; r.K = KV + h * 320; r.V = KV + h * 320 + 192; r.O = MIX + (size_t)(qb * 256) * 2048 + 1024 + h * 128; r.kb = nullptr; r.bs = 0.f; r.P0 = qb * 256; r.jlo = 0; return r; } };
static_assert(BodyA::LDS_BYTES <= RING_BYTES && BodyB::LDS_BYTES <= RING_BYTES && BodyC::LDS_BYTES <= RING_BYTES, "attention LDS");
static_assert(BodyA::LDS_BYTES <= 143360 && BodyC::LDS_BYTES <= 143360 && 143360 + 4096 <= RING_BYTES, "sorted keys above the list-driven bodies");

constexpr float SKIP_THRESH = 106.0f;
constexpr int KEYS_OFF = 143360;
template <int MODE>
__device__ __forceinline__ int build_list(LAS unsigned char* scr, volatile LAS unsigned* list, const float* stats, const float* kbtab, float scale, int vcu, int G, int tid) {
    LAS float* KmH = (LAS float*)scr; LAS float* red = (LAS float*)(scr + 256); LAS unsigned* keys = (LAS unsigned*)(scr + KEYS_OFF); LAS float* te = (LAS float*)(scr + 16384);
    { const int vh = tid & 15, part = tid >> 4; float m = 0.f; for (int c = part; c < 256; c += 32) m = fmaxf(m, stats[c * 32 + 16 + vh]); red[part * 16 + vh] = m; }
    if (MODE == 1) {
#pragma unroll
        for (int i = 0; i < 8; ++i) { const int idx = tid + 512 * i; te[idx] = kbtab[(size_t)(idx >> 8) * S + 64 * (idx & 255) + 63]; } }
    __syncthreads();
    if (tid < 16) { float m = 0.f; for (int q = 0; q < 32; ++q) m = fmaxf(m, red[q * 16 + tid]); KmH[tid] = m; }
    __syncthreads();
#pragma unroll 1
    for (int it = tid; it < 1024; it += NWAVES * 64) { const int vh = it >> 6, qb = it & 63, P0 = qb * 256;
        float q2 = 0.f;
#pragma unroll
        for (int i = 0; i < 4; ++i) q2 = fmaxf(q2, stats[(4 * qb + i) * 32 + vh]);
        const float Bq = scale * sqrtf(q2 * KmH[vh]) * 1.01f + 0.05f, thr = SKIP_THRESH + 2.f * Bq;
        int jlo;
        if (MODE == 0) { const float slope = 1.0f / (float)(2 << (vh >> 1)); const float X = (float)P0 - thr / slope - 63.f; jlo = X > 0.f ? (int)floorf(X * (1.f / 64.f)) : 0; }
        else { int lo = 0, hi = 4 * qb;
            const float base = qb > 0 ? te[vh * 256 + 4 * qb - 1] : 0.f;
            while (lo < hi) { const int mid = (lo + hi) >> 1; if (scale * (te[vh * 256 + mid] - base) >= -thr) hi = mid; else lo = mid + 1; }
            jlo = lo; }
        jlo = jlo < 0 ? 0 : (jlo > 4 * qb ? 4 * qb : jlo);
        keys[it] = ((unsigned)(4 * (qb + 1) - jlo) << 10) | (unsigned)(1023 - it); }
    __syncthreads();
#pragma unroll 1
    for (int k = 2; k <= 1024; k <<= 1)
#pragma unroll 1
        for (int j = k >> 1; j > 0; j >>= 1) { const int i = ((tid & ~(j - 1)) << 1) | (tid & (j - 1)), l = i | j; const unsigned a = keys[i], b = keys[l]; const bool up = (i & k) == 0;
            if ((a < b) == up) { keys[i] = b; keys[l] = a; }
            __syncthreads(); }
    return 1024;
}
struct DecAL { const bf16* proj; bf16* OA; volatile LAS unsigned* keys;
    __device__ __forceinline__ BodyA::Ref operator()(int n) const { const unsigned key = (unsigned)__builtin_amdgcn_readfirstlane((int)keys[n]); const int it = 1023 - (int)(key & 1023u), vh = it >> 6, qb = it & 63, h = vh >> 1; const unsigned e = (unsigned)(4 * (qb + 1) - (int)(key >> 10)) << 16;
        BodyA::Ref r; r.Q = proj + (size_t)(qb * 256) * NP0 + vh * 64; r.K = proj + 1024 + vh * 64; r.V = proj + 2048 + h * 128; r.O = OA + (size_t)(qb * 256) * 2048 + vh * 128; r.kb = nullptr; r.bs = 4.0f / (float)(1 << h); r.P0 = qb * 256; r.jlo = (int)(e >> 16); return r; } };
struct DecCL { const bf16* QKV; bf16* O1; const float* kb; volatile LAS unsigned* keys;
    __device__ __forceinline__ BodyC::Ref operator()(int n) const { const unsigned key = (unsigned)__builtin_amdgcn_readfirstlane((int)keys[n]); const int it = 1023 - (int)(key & 1023u), h = it >> 6, qb = it & 63; const unsigned e = (unsigned)(4 * (qb + 1) - (int)(key >> 10)) << 16;
        BodyC::Ref r; r.Q = QKV + (size_t)(qb * 256) * 6144 + h * 128; r.K = QKV + 2048 + h * 128; r.V = QKV + 4096 + h * 128; r.O = O1 + (size_t)(qb * 256) * 2048 + h * 128; r.kb = kb + h * S; r.bs = 0.f; r.P0 = qb * 256; r.jlo = (int)(e >> 16); return r; } };

__global__ void __launch_bounds__(NWAVES * 64, 2) mk_fwd(Args args) {
    extern __shared__ __attribute__((aligned(16))) unsigned char lds[];
    LAS unsigned char* const ldsl = (LAS unsigned char*)lds;
    volatile LAS unsigned* const MISC = (volatile LAS unsigned*)(ldsl + MISC_OFF);
    const int tid = threadIdx.x, lane = tid & 63, wave = __builtin_amdgcn_readfirstlane(tid >> 6);
    const int G = gridDim.x; const int vcu = (G % 8 == 0) ? ((int)blockIdx.x % 8) * (G / 8) + (int)blockIdx.x / 8 : (int)blockIdx.x;
    unsigned char* const ws = args.ws;
    gu32* const ctl = (gu32*)(ws + WS_CTL);
    for (int u = tid; u < (LDS_BYTES - LDSCTL_OFF) / 4; u += NWAVES * 64) ((LAS unsigned*)(ldsl + LDSCTL_OFF))[u] = 0u;
    __syncthreads();
#if MK_PER_PHASE
    XcdBarrier bar; bar.bar = (unsigned*)(ctl + CW_BAR); bar.x = 0; bar.st = nullptr; (void)bar;
#define GRID_BAR() do { } while (0)
#else
    XcdBarrier bar = xcd_barrier_post((unsigned*)(ctl + CW_BAR), MISC + 8);
#define GRID_BAR() xcd_barrier(bar)
#endif
    const int lo = args.ph_lo, hi = args.ph_hi;
#define IN(k) (lo <= (k) && (k) < hi)
#define PHASE_LOCAL_IDS int tid_ph_ = (int)threadIdx.x; asm volatile("" : "+v"(tid_ph_)); const int tid = tid_ph_, lane = tid & 63; (void)tid; (void)lane
#define SEAM(k) do { if (IN((k) + 1)) GRID_BAR(); } while (0)
    const int gw = vcu * NWAVES + wave, NGW = G * NWAVES;
    bf16* const HB = (bf16*)(ws + WS_XN);

    if (IN(0)) { PHASE_LOCAL_IDS;
        LAS float* scr = (LAS float*)(ldsl + wave * 16640);
        LAS float* scl = (LAS float*)(ldsl + 139264);
        if (wave == 0) { const float c0 = w_clip(args.in[I_EV_W_IN], nullptr, N_IN0, nullptr, lane), c1 = w_clip(args.in[I_EV_W_GATE], args.in[I_EV_W_UP], FF, args.in[I_EV_FFN_NORM], lane),
                                     c2 = w_clip(args.in[I_OD_W_IN], nullptr, N_IN1, args.in[I_OD_ATTN_NORM], lane), c3 = w_clip_experts(args.in[I_OD_W_GATE], args.in[I_OD_W_UP], DM, FF, args.in[I_OD_FFN_NORM], lane),
                                     c4 = w8_scale_experts(args.in[I_OD_W_DOWN], FF, DM, lane);
            if (lane == 0) { scl[0] = c0; scl[1] = c1; scl[2] = c2; scl[3] = c3; scl[4] = c4;
                if (blockIdx.x == 0) { float* t = (float*)(ws + WS_SCL); t[0] = c0; t[1] = c1; t[2] = c2; t[3] = c3; t[4] = c4; } } }
        __syncthreads();
        const float clip_in0 = scl[0], clip_gu0 = scl[1], clip_in1 = scl[2], clip_gu1 = scl[3], scale_d1 = scl[4];
        { const float qsi = 127.f / clip_in0;
          tr_matrix(args.in[I_EV_W_IN], DM, N_IN0, 1, 0, (bf16*)(ws + WS_WIN0), 0, scr, gw, NGW, lane, nullptr, 2, qsi);
          tr_matrix(args.in[I_EV_W_IN], DM, N_IN0, 1, 0, (bf16*)(ws + WS_WIN0), 0, scr, gw, NGW, lane, nullptr, 0, 0.f, 64); }
        tr_matrix(args.in[I_EV_W_UQ], 512, 1536, 1, 0, (bf16*)(ws + WS_WUQ), 3, scr, gw, NGW, lane);
        tr_matrix(args.in[I_EV_W_UKV], 512, 2048, 1, 0, (bf16*)(ws + WS_WUKV), 0, scr, gw, NGW, lane);
        tr_matrix(args.in[I_EV_W_OUT], DM, DM, 1, 0, (bf16*)(ws + WS_WOUT0), 0, scr, gw, NGW, lane);
        const float qs0 = 127.f / clip_gu0;
        tr_matrix(args.in[I_EV_W_GATE], DM, FF, 1, 0, (bf16*)(ws + WS_WGU0), 1, scr, gw, NGW, lane, args.in[I_EV_FFN_NORM], 2, qs0);
        tr_matrix(args.in[I_EV_W_UP], DM, FF, 1, 0, (bf16*)(ws + WS_WGU0), 2, scr, gw, NGW, lane, args.in[I_EV_FFN_NORM], 2, qs0);
        tr_matrix(args.in[I_EV_W_DOWN], FF, DM, 1, 0, (bf16*)(ws + WS_WD0), 0, scr, gw, NGW, lane);
        { const float qsi = 127.f / clip_in1;
          tr_matrix(args.in[I_OD_W_IN], DM, N_IN1, 1, 0, (bf16*)(ws + WS_WIN1), 0, scr, gw, NGW, lane, args.in[I_OD_ATTN_NORM], 2, qsi);
          tr_matrix(args.in[I_OD_W_IN], DM, N_IN1, 1, 0, (bf16*)(ws + WS_WIN1), 0, scr, gw, NGW, lane, args.in[I_OD_ATTN_NORM], 0, 0.f, 96); }
        tr_matrix(args.in[I_OD_W_OUT], DM, DM, 1, 0, (bf16*)(ws + WS_WOUT1), 0, scr, gw, NGW, lane);
        const float qs1 = 127.f / clip_gu1;
        tr_matrix(args.in[I_OD_W_GATE], DM, FF, NE, 2 * FF, (bf16*)(ws + WS_WGU1), 1, scr, gw, NGW, lane, args.in[I_OD_FFN_NORM], 2, qs1);
        tr_matrix(args.in[I_OD_W_UP], DM, FF, NE, 2 * FF, (bf16*)(ws + WS_WGU1), 2, scr, gw, NGW, lane, args.in[I_OD_FFN_NORM], 2, qs1);
        tr_matrix(args.in[I_OD_W_DOWN], FF, DM, NE, DM, (bf16*)(ws + WS_WD1), 0, scr, gw, NGW, lane, nullptr, 1, scale_d1);
        { const int gt = gw * 64 + lane, NGT = NGW * 64;
          GAS v4u* z0 = (GAS v4u*)((bf16*)(ws + WS_WIN0) + (size_t)N_IN0 * DM); const int n0 = (N_IN0P - N_IN0) * DM / 8;
          for (int i = gt; i < n0; i += NGT) z0[i] = (v4u){0u, 0u, 0u, 0u};
          GAS v4u* z1 = (GAS v4u*)((bf16*)(ws + WS_WIN1) + (size_t)(N_IN1 + 16) * DM); const int n1 = (N_IN1P - N_IN1 - 16) * DM / 8;
          for (int i = gt; i < n1; i += NGT) z1[i] = (v4u){0u, 0u, 0u, 0u};
          float* cs = (float*)(ws + WS_ROPE);
          for (int i = gt; i < S * 32; i += NGT) { const int pos = i >> 5, k = i & 31; const float ang = (float)pos * ROPE_INV[k]; float sn, c; sincos_d(ang, sn, c); cs[pos * 64 + k] = c; cs[pos * 64 + 32 + k] = sn; }
        }
        { const float wsc0 = clip_in0 * (1.f / 127.f);
          for (int m = gw; m < S; m += NGW) rms_row_bf16(args.in[I_X] + (size_t)m * DM, args.in[I_EV_ATTN_NORM], (bf16*)(ws + WS_XN) + (size_t)m * DM, 1e-6f, lane, ws + WS_A8 + (size_t)m * DM, (float*)(ws + WS_RSTDS) + m, wsc0); }
        SEAM(0);
    }
    if (IN(1)) { PHASE_LOCAL_IDS;
        { pg8::Gemm g{(const bf16*)(ws + WS_A8), (const bf16*)(ws + WS_WIN0), S, NP0, DM / 2, DM / 2}; pg8::StaticOrder so; so.init(S, NP0, G, (int)blockIdx.x);
          pg8::EpiBf16Row E{(bf16*)(ws + WS_PROJ0), NP0, (const float*)(ws + WS_RSTDS)};
          pg8::gemm_phase<pg8::EpiBf16Row, pg8::StaticOrder, true, true, 2>(ldsl, g, so, E); }
        __syncthreads();
        { pg8::Gemm g{(const bf16*)(ws + WS_XN), (const bf16*)(ws + WS_WIN0), S, 256, 512, DM}; pg8::SplitKOrder so{G, (int)blockIdx.x, 16, 1024};
          pg8::EpiPartF32 E{(float*)(ws + WS_KPART), 64, 1024, S, nullptr};
          pg8::gemm_phase<pg8::EpiPartF32, pg8::SplitKOrder, true, true>(ldsl, g, so, E); }
        SEAM(1);
    }
    if (IN(2)) { PHASE_LOCAL_IDS;
        const bf16* proj = (const bf16*)(ws + WS_PROJ0); const float* cs = (const float*)(ws + WS_ROPE); bf16* Kf = (bf16*)(ws + WS_KF);
        LAS float* sm = (LAS float*)ldsl; float* statA = (float*)(ws + WS_STATA);
        for (int c = (int)blockIdx.x; c < 256; c += G) { float qmax = 0.f, kmax = 0.f;
            for (int i = 0; i < 8; ++i) { const int m = 64 * c + 8 * wave + i; const bf16* prow = proj + (size_t)m * NP0;
                rms512_bf16(prow + 3072, args.in[I_EV_Q_NORM], (bf16*)(ws + WS_CQN) + (size_t)m * 512, lane);
                rms512_bf16(prow + 3584, args.in[I_EV_KV_NORM], (bf16*)(ws + WS_CKVN) + (size_t)m * 512, lane);
                if (lane < 32) { const float* kp = (const float*)(ws + WS_KPART) + (size_t)m * 64 + lane; const size_t kq = (size_t)S * 64;
                    const float x1 = (kp[0] + kp[kq]) + (kp[2 * kq] + kp[3 * kq]), x2 = (kp[32] + kp[kq + 32]) + (kp[2 * kq + 32] + kp[3 * kq + 32]); const float cc = cs[m * 64 + lane], sn = cs[m * 64 + 32 + lane];
                    const bf16 o1 = (bf16)f2bf(x1 * cc - x2 * sn), o2 = (bf16)f2bf(x2 * cc + x1 * sn); bf16* kr = Kf + (size_t)m * 2560 + 128 + lane;
#pragma unroll
                    for (int h = 0; h < 8; ++h) { kr[h * 320] = o1; kr[h * 320 + 32] = o2; } }
                { const v4u a0 = *(const GAS v4u*)(prow + 16 * lane), a1 = *(const GAS v4u*)(prow + 16 * lane + 8), b0 = *(const GAS v4u*)(prow + 1024 + 16 * lane), b1 = *(const GAS v4u*)(prow + 1024 + 16 * lane + 8);
                  float sq = 0.f, sk = 0.f;
#pragma unroll
                  for (int e = 0; e < 4; ++e) { sq += bflo(a0[e]) * bflo(a0[e]) + bfhi(a0[e]) * bfhi(a0[e]) + bflo(a1[e]) * bflo(a1[e]) + bfhi(a1[e]) * bfhi(a1[e]);
                                                sk += bflo(b0[e]) * bflo(b0[e]) + bfhi(b0[e]) * bfhi(b0[e]) + bflo(b1[e]) * bflo(b1[e]) + bfhi(b1[e]) * bfhi(b1[e]); }
                  sq += __shfl_xor(sq, 1); sq += __shfl_xor(sq, 2); sk += __shfl_xor(sk, 1); sk += __shfl_xor(sk, 2); qmax = fmaxf(qmax, sq); kmax = fmaxf(kmax, sk); } }
            if ((lane & 3) == 0) { sm[wave * 32 + (lane >> 2)] = qmax; sm[wave * 32 + 16 + (lane >> 2)] = kmax; }
            __syncthreads();
            if (tid < 32) { float v = 0.f; for (int q = 0; q < 8; ++q) v = fmaxf(v, sm[q * 32 + tid]); statA[c * 32 + tid] = v; }
            __syncthreads(); }
        SEAM(2);
    }
    if (IN(3)) { PHASE_LOCAL_IDS;
        { pg8::Gemm g{(const bf16*)(ws + WS_CQN), (const bf16*)(ws + WS_WUQ), S, 1536, 512}; pg8::StaticOrder so; so.init(S, 1536, G, (int)blockIdx.x);
          pg8::EpiQRope E{(bf16*)(ws + WS_QB), (const float*)(ws + WS_ROPE)};
          pg8::gemm_phase<pg8::EpiQRope, pg8::StaticOrder, true, true>(ldsl, g, so, E); }
        __syncthreads();
        { pg8::Gemm g{(const bf16*)(ws + WS_CKVN), (const bf16*)(ws + WS_WUKV), S, 2048, 512}; pg8::StaticOrder so; so.init(S, 2048, G, (int)blockIdx.x);
          pg8::EpiKV E{(bf16*)(ws + WS_KF)};
          pg8::gemm_phase<pg8::EpiKV, pg8::StaticOrder, true, true>(ldsl, g, so, E); }
        SEAM(3);
    }
    if (IN(4)) { PHASE_LOCAL_IDS;
        const int nit = (vcu < 256) ? (256 - vcu + G - 1) / G : 0;
        { volatile LAS unsigned* slot = (volatile LAS unsigned*)(ldsl + LDSCTL_OFF);
          const int nb = build_list<0>(ldsl, slot, (const float*)(ws + WS_STATA), nullptr, SCALE_A, vcu, G, tid);
          DecAL d{(const bf16*)(ws + WS_PROJ0), (bf16*)(ws + WS_OA), (volatile LAS unsigned*)(ldsl + KEYS_OFF)}; att::stream_dyn<BodyA, DecAL>((char*)lds, nb, (unsigned*)(ctl + CW_QA), slot, d, SCALE_A); }
        __syncthreads();
        { DecB d{(const bf16*)(ws + WS_QB), (const bf16*)(ws + WS_KF), (bf16*)(ws + WS_MIX), vcu, G}; att::stream<BodyB, DecB>((char*)lds, 2 * nit, d, SCALE_B); }
        SEAM(4);
    }
    if (IN(5)) { PHASE_LOCAL_IDS;
        const float a1 = wave_sum(args.in[I_EV_LQ1][lane] * args.in[I_EV_LK1][lane]), a2 = wave_sum(args.in[I_EV_LQ2][lane] * args.in[I_EV_LK2][lane]);
        const float lam = expf(a1) - expf(a2) + 0.2f;
        const bf16* OA = (const bf16*)(ws + WS_OA); bf16* MIX = (bf16*)(ws + WS_MIX); const int h = lane >> 3, d0 = (lane & 7) * 16;
        f32x4 sg[4];
#pragma unroll
        for (int q = 0; q < 4; ++q) sg[q] = *(const GAS f32x4*)(args.in[I_EV_SUBLN] + d0 + 4 * q) * 0.8f;
        for (int m = gw; m < S; m += NGW) { const bf16* p0 = OA + (size_t)m * 2048 + (2 * h) * 128 + d0; f32x4 d[4]; float ss = 0.f;
            const v4u a0 = *(const GAS v4u*)p0, a1 = *(const GAS v4u*)(p0 + 8), b0 = *(const GAS v4u*)(p0 + 128), b1 = *(const GAS v4u*)(p0 + 136);
            d[0] = (f32x4){bflo(a0.x) - lam * bflo(b0.x), bfhi(a0.x) - lam * bfhi(b0.x), bflo(a0.y) - lam * bflo(b0.y), bfhi(a0.y) - lam * bfhi(b0.y)};
            d[1] = (f32x4){bflo(a0.z) - lam * bflo(b0.z), bfhi(a0.z) - lam * bfhi(b0.z), bflo(a0.w) - lam * bflo(b0.w), bfhi(a0.w) - lam * bfhi(b0.w)};
            d[2] = (f32x4){bflo(a1.x) - lam * bflo(b1.x), bfhi(a1.x) - lam * bfhi(b1.x), bflo(a1.y) - lam * bflo(b1.y), bfhi(a1.y) - lam * bfhi(b1.y)};
            d[3] = (f32x4){bflo(a1.z) - lam * bflo(b1.z), bfhi(a1.z) - lam * bfhi(b1.z), bflo(a1.w) - lam * bflo(b1.w), bfhi(a1.w) - lam * bfhi(b1.w)};
#pragma unroll
            for (int q = 0; q < 4; ++q) ss += (d[q].x * d[q].x + d[q].y * d[q].y) + (d[q].z * d[q].z + d[q].w * d[q].w);
            ss += __shfl_xor(ss, 1); ss += __shfl_xor(ss, 2); ss += __shfl_xor(ss, 4);
            const float rstd = 1.0f / sqrtf(ss * (1.f / 128.f) + 1e-5f);
            v4u o0, o1; { const f32x4 y0 = d[0] * rstd * sg[0], y1 = d[1] * rstd * sg[1], y2 = d[2] * rstd * sg[2], y3 = d[3] * rstd * sg[3];
              o0.x = pk2(y0.x, y0.y); o0.y = pk2(y0.z, y0.w); o0.z = pk2(y1.x, y1.y); o0.w = pk2(y1.z, y1.w); o1.x = pk2(y2.x, y2.y); o1.y = pk2(y2.z, y2.w); o1.z = pk2(y3.x, y3.y); o1.w = pk2(y3.z, y3.w); }
            GAS v4u* dst = (GAS v4u*)(MIX + (size_t)m * 2048 + h * 128 + d0); dst[0] = o0; dst[1] = o1; }
        SEAM(5);
    }
    if (IN(6)) { PHASE_LOCAL_IDS;
        pg8::Gemm g{(const bf16*)(ws + WS_MIX), (const bf16*)(ws + WS_WOUT0), S, DM, DM}; pg8::StaticOrder so; so.init(S, DM, G, (int)blockIdx.x);
        pg8::EpiResB<true> E{args.in[I_X], HB, (float*)(ws + WS_PS), DM};
        pg8::gemm_phase<pg8::EpiResB<true>, pg8::StaticOrder, true, true>(ldsl, g, so, E);
        SEAM(6);
    }
    if (IN(7)) { PHASE_LOCAL_IDS;
        rows_i8(HB, (const float*)(ws + WS_PS), (float*)(ws + WS_RSTD), ws + WS_A8, (float*)(ws + WS_RSTDS), ((const float*)(ws + WS_SCL))[1] * (1.f / 127.f), gw, NGW, lane);
        SEAM(7);
    }
    if (IN(8)) { PHASE_LOCAL_IDS;
        pg8::Gemm g{(const bf16*)(ws + WS_A8), (const bf16*)(ws + WS_WGU0), S, 2 * FF, DM / 2, DM / 2}; pg8::StaticOrder so; so.init(S, 2 * FF, G, (int)blockIdx.x);
        pg8::EpiSwiGLU<false> E{(bf16*)(ws + WS_HMID0), FF, 2 * FF / 256, (const float*)(ws + WS_RSTDS), 1.f};
        pg8::gemm_phase<pg8::EpiSwiGLU<false>, pg8::StaticOrder, true, true, 2>(ldsl, g, so, E);
        SEAM(8);
    }
    if (IN(9)) { PHASE_LOCAL_IDS;
        pg8::Gemm g{(const bf16*)(ws + WS_HMID0), (const bf16*)(ws + WS_WD0), S, DM, FF}; pg8::StaticOrder so; so.init(S, DM, G, (int)blockIdx.x);
        pg8::EpiResB<false> E{nullptr, HB, (float*)(ws + WS_PS), DM};
        pg8::gemm_phase<pg8::EpiResB<false>, pg8::StaticOrder, true, true>(ldsl, g, so, E);
        SEAM(9);
    }
    if (IN(10)) { PHASE_LOCAL_IDS;
        rows_i8(HB, (const float*)(ws + WS_PS), (float*)(ws + WS_RSTD), ws + WS_A8, (float*)(ws + WS_RSTDS), ((const float*)(ws + WS_SCL))[2] * (1.f / 127.f), gw, NGW, lane);
        SEAM(10);
    }
    if (IN(11)) { PHASE_LOCAL_IDS;
        { pg8::Gemm g{(const bf16*)(ws + WS_A8), (const bf16*)(ws + WS_WIN1), S, 6144, DM / 2, DM / 2}; pg8::StaticOrder so; so.init(S, 6144, G, (int)blockIdx.x);
          pg8::EpiBf16Row E{(bf16*)(ws + WS_QKV1), 6144, (const float*)(ws + WS_RSTDS)};
          pg8::gemm_phase<pg8::EpiBf16Row, pg8::StaticOrder, true, true, 2>(ldsl, g, so, E); }
        __syncthreads();
        { pg8::Gemm g{(const bf16*)(ws + WS_XN), (const bf16*)(ws + WS_WIN1), S, 256, 512, DM}; pg8::SplitKOrder so{G, (int)blockIdx.x, 24, 1024};
          pg8::EpiPartF32 E{(float*)(ws + WS_FPART), 16, 1024, S, (const float*)(ws + WS_RSTD)};
          pg8::gemm_phase<pg8::EpiPartF32, pg8::SplitKOrder, true, true>(ldsl, g, so, E); }
        SEAM(11);
    }
    if (IN(12)) { PHASE_LOCAL_IDS;
        float* logf = (float*)(ws + WS_LOGF); float* csum = (float*)(ws + WS_CSUM); LAS float* red = (LAS float*)ldsl;
        const bf16* qkv = (const bf16*)(ws + WS_QKV1); float* statC = (float*)(ws + WS_STATC); LAS float* sm = red + 1024;
        for (int c = (int)blockIdx.x; c < 256; c += G) { const int r = tid >> 4, h = tid & 15;
            { const float* fp = (const float*)(ws + WS_FPART); const size_t kq = (size_t)S * 16; const float fb = args.in[I_OD_FBIAS][h]; float lsum = 0.f;
#pragma unroll
              for (int rr = 0; rr < 2; ++rr) { const size_t o = (size_t)(64 * c + 32 * rr + r) * 16 + h; const float x = ((fp[o] + fp[o + kq]) + (fp[o + 2 * kq] + fp[o + 3 * kq])) + fb;
                  const float ls = fminf(x, 0.f) - log1pf(__expf(-fabsf(x))); logf[o] = ls; lsum += ls; }
              red[r * 16 + h] = lsum; }
            float qmax = 0.f, kmax = 0.f;
            for (int i = 0; i < 8; ++i) { const bf16* prow = qkv + (size_t)(64 * c + 8 * wave + i) * 6144 + 32 * lane; float sq = 0.f, sk = 0.f;
#pragma unroll
                for (int j = 0; j < 4; ++j) { const v4u a = *(const GAS v4u*)(prow + 8 * j), b = *(const GAS v4u*)(prow + 2048 + 8 * j);
#pragma unroll
                    for (int e = 0; e < 4; ++e) { sq += bflo(a[e]) * bflo(a[e]) + bfhi(a[e]) * bfhi(a[e]); sk += bflo(b[e]) * bflo(b[e]) + bfhi(b[e]) * bfhi(b[e]); } }
                sq += __shfl_xor(sq, 1); sq += __shfl_xor(sq, 2); sk += __shfl_xor(sk, 1); sk += __shfl_xor(sk, 2); qmax = fmaxf(qmax, sq); kmax = fmaxf(kmax, sk); }
            if ((lane & 3) == 0) { sm[wave * 32 + (lane >> 2)] = qmax; sm[wave * 32 + 16 + (lane >> 2)] = kmax; }
            __syncthreads();
            if (tid < 16) { float s = 0.f; for (int q = 0; q < 32; ++q) s += red[q * 16 + tid]; csum[c * 16 + tid] = s; }
            if (tid < 32) { float v = 0.f; for (int q = 0; q < 8; ++q) v = fmaxf(v, sm[q * 32 + tid]); statC[c * 32 + tid] = v; }
            __syncthreads(); }
        SEAM(12);
    }
    if (IN(13)) { PHASE_LOCAL_IDS;
        const float* logf = (const float*)(ws + WS_LOGF); const float* csum = (const float*)(ws + WS_CSUM); float* kbC = (float*)(ws + WS_KBC);
        LAS float* red = (LAS float*)ldsl; LAS float* pre = red + 512; LAS float* val = red + 1024;
        for (int c = (int)blockIdx.x; c < 256; c += G) { const int part = tid >> 4, h = tid & 15;
            { float s = 0.f; for (int cc = part; cc < c; cc += 32) s += csum[cc * 16 + h]; red[part * 16 + h] = s; }
            val[tid] = logf[(size_t)(64 * c) * 16 + tid]; val[512 + tid] = logf[(size_t)(64 * c) * 16 + 512 + tid];
            __syncthreads();
            if (tid < 16) { float s = 0.f; for (int q = 0; q < 32; ++q) s += red[q * 16 + tid]; pre[tid] = s; }
            __syncthreads();
            if (tid < 16) { float run = pre[tid]; for (int r = 0; r < 64; ++r) { run += val[r * 16 + tid]; val[r * 16 + tid] = run; } }
            __syncthreads();
            { const int r = tid & 63, hh = tid >> 6; kbC[(size_t)hh * S + 64 * c + r] = val[r * 16 + hh] * (-1.0f / SCALE_C); kbC[(size_t)(hh + 8) * S + 64 * c + r] = val[r * 16 + hh + 8] * (-1.0f / SCALE_C); }
            __syncthreads(); }
        SEAM(13);
    }
    if (IN(14)) { PHASE_LOCAL_IDS;
        volatile LAS unsigned* slot = (volatile LAS unsigned*)(ldsl + LDSCTL_OFF);
        const int nb = build_list<1>(ldsl, slot, (const float*)(ws + WS_STATC), (const float*)(ws + WS_KBC), SCALE_C, vcu, G, tid);
        DecCL d{(const bf16*)(ws + WS_QKV1), (bf16*)(ws + WS_O1), (const float*)(ws + WS_KBC), (volatile LAS unsigned*)(ldsl + KEYS_OFF)}; att::stream_dyn<BodyC, DecCL>((char*)lds, nb, (unsigned*)(ctl + CW_QC), slot, d, SCALE_C);
        SEAM(14);
    }
    if (IN(15)) { PHASE_LOCAL_IDS;
        pg8::Gemm g{(const bf16*)(ws + WS_O1), (const bf16*)(ws + WS_WOUT1), S, DM, DM}; pg8::StaticOrder so; so.init(S, DM, G, (int)blockIdx.x);
        pg8::EpiResB<false> E{nullptr, HB, (float*)(ws + WS_PS), DM};
        pg8::gemm_phase<pg8::EpiResB<false>, pg8::StaticOrder, true, true>(ldsl, g, so, E);
        SEAM(15);
    }
    if (IN(16)) { PHASE_LOCAL_IDS;
        LAS float* rt = (LAS float*)ldsl; LAS unsigned* cnt = (LAS unsigned*)(ldsl + 65536);
        for (int idx = tid; idx < DM * NE; idx += NWAVES * 64) { const int k = idx >> 3, e = idx & 7; rt[e * DM + k] = args.in[I_OD_ROUTER][idx]; }
        __syncthreads();
        const GAS f32x4* gr = (const GAS f32x4*)args.in[I_OD_FFN_NORM] + lane;
        for (int c = (int)blockIdx.x; c < 256; c += G) {
            if (tid < 8) cnt[tid] = 0u;
            __syncthreads();
            for (int i = 0; i < 8; ++i) { const int row = 64 * c + 8 * wave + i;
                const GAS v2u* xr = (const GAS v2u*)(HB + (size_t)row * DM) + lane; f32x4 v[8]; float s = 0.f;
#pragma unroll
                for (int j = 0; j < 8; ++j) { const v2u a = xr[64 * j]; v[j] = (f32x4){bflo(a.x), bfhi(a.x), bflo(a.y), bfhi(a.y)}; s += (v[j].x * v[j].x + v[j].y * v[j].y) + (v[j].z * v[j].z + v[j].w * v[j].w); }
                const float rstd = 1.0f / sqrtf(wave_sum(s) * (1.f / DM) + 1e-6f);
#pragma unroll
                for (int j = 0; j < 8; ++j) { const f32x4 gg = gr[64 * j]; v[j] = (v[j] * rstd) * gg; }
                if (lane == 0) ((float*)(ws + WS_RSTD))[row] = rstd;
                float lg[8];
#pragma unroll
                for (int e = 0; e < 8; ++e) { float a = 0.f;
#pragma unroll
                    for (int j = 0; j < 8; ++j) { const f32x4 w = *(const LAS f32x4*)(rt + e * DM + 4 * lane + 256 * j); a += (v[j].x * w.x + v[j].y * w.y) + (v[j].z * w.z + v[j].w * w.w); }
                    lg[e] = wave_sum(a); }
                int e1 = 0; float l1 = lg[0];
#pragma unroll
                for (int e = 1; e < 8; ++e) if (lg[e] > l1) { l1 = lg[e]; e1 = e; }
                int e2 = -1; float l2 = -__builtin_inff();
#pragma unroll
                for (int e = 0; e < 8; ++e) if (e != e1 && lg[e] > l2) { l2 = lg[e]; e2 = e; }
                const float g1 = 1.0f / (1.0f + expf(l2 - l1)), g2 = 1.0f - g1;
                if (lane == 0) { *(GAS v4u*)(ws + WS_ROUTE + (size_t)row * 16) = (v4u){(unsigned)e1, (unsigned)e2, __builtin_bit_cast(unsigned, g1), __builtin_bit_cast(unsigned, g2)};
                    __hip_atomic_fetch_add(cnt + e1, 1u, __ATOMIC_RELAXED, __HIP_MEMORY_SCOPE_WORKGROUP); __hip_atomic_fetch_add(cnt + e2, 1u, __ATOMIC_RELAXED, __HIP_MEMORY_SCOPE_WORKGROUP); } }
            __syncthreads();
            if (tid < 8) ((unsigned*)(ws + WS_CNTG))[c * 8 + tid] = cnt[tid];
            __syncthreads(); }
        SEAM(16);
    }
    if (IN(17)) { PHASE_LOCAL_IDS;
        const unsigned* cntg = (const unsigned*)(ws + WS_CNTG); LAS unsigned* red = (LAS unsigned*)ldsl; LAS unsigned* red2 = red + 512; LAS unsigned* T = red + 1024; LAS unsigned* P = red + 1032;
        LAS unsigned* st = red + 1040; LAS unsigned* rl = red + 1056; LAS unsigned* posl = red + 1056 + 256;
        bf16* As = (bf16*)(ws + WS_AS); float* gates = (float*)(ws + WS_GATES); unsigned* tokpos = (unsigned*)(ws + WS_TOKPOS);
        const float gsc = 1.0f / (((const float*)(ws + WS_SCL))[4] * H8_SCALE);
        const float wsc1 = ((const float*)(ws + WS_SCL))[3] * (1.f / 127.f);
        for (int c = (int)blockIdx.x; c < 256; c += G) {
            { const int e = tid & 7, part = tid >> 3; unsigned tot = 0u, pre = 0u; for (int cc = part; cc < 256; cc += 64) { const unsigned x = cntg[cc * 8 + e]; tot += x; if (cc < c) pre += x; } red[part * 8 + e] = tot; red2[part * 8 + e] = pre; }
            if (tid < 64) { const v4u r = *(const GAS v4u*)(ws + WS_ROUTE + (size_t)(64 * c + tid) * 16); rl[tid * 4 + 0] = r.x; rl[tid * 4 + 1] = r.y; rl[tid * 4 + 2] = r.z; rl[tid * 4 + 3] = r.w; }
            __syncthreads();
            if (tid < 8) { unsigned a = 0u, b = 0u; for (int q = 0; q < 64; ++q) { a += red[q * 8 + tid]; b += red2[q * 8 + tid]; } T[tid] = a; P[tid] = b; }
            __syncthreads();
            if (tid < 8) { unsigned s0 = 0u; for (int e = 0; e < tid; ++e) s0 += (T[e] + 255u) & ~255u; st[tid] = s0;
                unsigned run = s0 + P[tid]; for (int r = 0; r < 64; ++r) { if (rl[r * 4 + 0] == (unsigned)tid) posl[r * 2 + 0] = run++; if (rl[r * 4 + 1] == (unsigned)tid) posl[r * 2 + 1] = run++; }
                if (c == 0) ((unsigned*)(ws + WS_TOT))[tid] = T[tid]; }
            __syncthreads();
            for (int i = 0; i < 8; ++i) { const int r = 8 * wave + i, row = 64 * c + r; const GAS v4u* src = (const GAS v4u*)((const bf16*)(ws + WS_XN) + (size_t)row * DM) + lane;
                const v4u x[4] = {src[0], src[64], src[128], src[192]}; const float rs = ((const float*)(ws + WS_RSTD))[row];
                float am = 0.f;
#pragma unroll
                for (int j = 0; j < 4; ++j) { am = fmaxf(am, fmaxf(fmaxf(fabsf(bflo(x[j].x)), fabsf(bfhi(x[j].x))), fmaxf(fabsf(bflo(x[j].y)), fabsf(bfhi(x[j].y))))); am = fmaxf(am, fmaxf(fmaxf(fabsf(bflo(x[j].z)), fabsf(bfhi(x[j].z))), fmaxf(fabsf(bflo(x[j].w)), fabsf(bfhi(x[j].w))))); }
#pragma unroll
                for (int o = 32; o > 0; o >>= 1) am = fmaxf(am, __shfl_xor(am, o));
                am = fmaxf(am, 1e-30f); const float qs = 127.f / am, rowf = (am * (1.f / 127.f)) * rs * wsc1;
                v2u q[4];
#pragma unroll
                for (int j = 0; j < 4; ++j) { q[j].x = pki8x4(bflo(x[j].x) * qs, bfhi(x[j].x) * qs, bflo(x[j].y) * qs, bfhi(x[j].y) * qs); q[j].y = pki8x4(bflo(x[j].z) * qs, bfhi(x[j].z) * qs, bflo(x[j].w) * qs, bfhi(x[j].w) * qs); }
                const v2u q0 = q[0], q1 = q[1], q2 = q[2], q3 = q[3];
#pragma unroll
                for (int sl = 0; sl < 2; ++sl) { const unsigned p = posl[r * 2 + sl]; GAS v2u* dst = (GAS v2u*)((unsigned char*)As + (size_t)p * DM) + lane; dst[0] = q0; dst[64] = q1; dst[128] = q2; dst[192] = q3;
                    if (lane == 0) { gates[p] = __builtin_bit_cast(float, rl[r * 4 + 2 + sl]) * gsc; tokpos[row * 2 + sl] = p; ((float*)(ws + WS_RSTDS))[p] = rowf;   } } }
            { const unsigned e = (unsigned)wave, te = T[e], pad = ((te + 255u) & ~255u) - te;
              if ((unsigned)c < pad) { const unsigned p = st[e] + te + (unsigned)c; GAS v2u* dst = (GAS v2u*)((unsigned char*)As + (size_t)p * DM) + lane; const v2u z = (v2u){0u, 0u}; dst[0] = z; dst[64] = z; dst[128] = z; dst[192] = z; if (lane == 0) { gates[p] = 0.f; ((float*)(ws + WS_RSTDS))[p] = 0.f; } } }
            __syncthreads(); }
        SEAM(17);
    }
    if (IN(18)) { PHASE_LOCAL_IDS;
        pg8::Gemm g{(const bf16*)(ws + WS_AS), (const bf16*)(ws + WS_WGU1), MPAD, NE * 2 * FF, DM / 2, DM / 2}; pg8::GroupedOrder so; so.init((const unsigned*)(ws + WS_TOT), 2 * FF / 256, G, (int)blockIdx.x);
        pg8::EpiSwiGLU<true> E{(bf16*)(ws + WS_HMS), FF, 2 * FF / 256, (const float*)(ws + WS_RSTDS), H8_SCALE};
        pg8::gemm_phase<pg8::EpiSwiGLU<true>, pg8::GroupedOrder, true, true, 2>(ldsl, g, so, E);
        SEAM(18);
    }
    if (IN(19)) { PHASE_LOCAL_IDS;
        pg8::GroupedOrder so; so.init((const unsigned*)(ws + WS_TOT), DM / 256, G, (int)blockIdx.x);
        const int full = (so.nwg / G) * G, left = so.nwg - full; const bool halves = left > 0 && 2 * left <= G;
        if (halves) so.hi = full;
        { pg8::Gemm g{(const bf16*)(ws + WS_HMS), (const bf16*)(ws + WS_WD1), MPAD, NE * DM, FF / 2, FF / 2};
          pg8::EpiMoEDown E{(bf16*)(ws + WS_YS), (const float*)(ws + WS_GATES), DM / 256};
          pg8::gemm_phase<pg8::EpiMoEDown, pg8::GroupedOrder, true, true, 1>(ldsl, g, so, E); }
        if (halves) { __syncthreads();
          pg8::Gemm g{(const bf16*)(ws + WS_HMS), (const bf16*)(ws + WS_WD1), MPAD, NE * DM, FF / 4, FF / 2};
          pg8::GroupedSplitOrder<1> ss{so, full, 2 * left, FF / 2};
          pg8::EpiMoEDownPart E{(float*)(ws + WS_PART), (unsigned*)(ctl + CW_SPLIT), DM / 256, FF / 2};
          pg8::gemm_phase<pg8::EpiMoEDownPart, pg8::GroupedSplitOrder<1>, true, true, 1>(ldsl, g, ss, E); }
        SEAM(19);
    }
    if (IN(20)) { PHASE_LOCAL_IDS;
        const bf16* Y = (const bf16*)(ws + WS_YS); const unsigned* split = (const unsigned*)(ctl + CW_SPLIT); const float* PART = (const float*)(ws + WS_PART); const float* gates = (const float*)(ws + WS_GATES); const unsigned* tokpos = (const unsigned*)(ws + WS_TOKPOS); const GAS f32x4* gr = (const GAS f32x4*)args.in[I_FINAL_NORM] + lane;
        unsigned bad = __hip_atomic_load(ctl + CW_TMO, RLX_AGENT) | __hip_atomic_load(ctl + CW_BAR + XB_TMO, RLX_AGENT);
        for (int m = gw; m < S; m += NGW) { const unsigned p0 = tokpos[m * 2], p1 = tokpos[m * 2 + 1];
            GAS f32x4* xo = (GAS f32x4*)(args.out + (size_t)m * DM) + lane; const GAS v2u* hr = (const GAS v2u*)(HB + (size_t)m * DM) + lane; const GAS v2u* y0 = (const GAS v2u*)(Y + (size_t)p0 * DM) + lane; const GAS v2u* y1 = (const GAS v2u*)(Y + (size_t)p1 * DM) + lane;
            f32x4 v[8]; float s = 0.f;
            const v4u fa = *(const GAS v4u*)(split + (p0 >> 8) * 8), fb = *(const GAS v4u*)(split + (p0 >> 8) * 8 + 4), fc = *(const GAS v4u*)(split + (p1 >> 8) * 8), fd = *(const GAS v4u*)(split + (p1 >> 8) * 8 + 4);
            const unsigned anysplit = (fa.x | fa.y | fa.z | fa.w) | (fb.x | fb.y | fb.z | fb.w) | (fc.x | fc.y | fc.z | fc.w) | (fd.x | fd.y | fd.z | fd.w);
            if (__builtin_expect(anysplit == 0u, 1)) {
#pragma unroll
                for (int j = 0; j < 8; ++j) { const v2u a = y0[64 * j], b = y1[64 * j], hh = hr[64 * j]; v[j] = (f32x4){(bflo(hh.x) + bflo(a.x)) + bflo(b.x), (bfhi(hh.x) + bfhi(a.x)) + bfhi(b.x), (bflo(hh.y) + bflo(a.y)) + bflo(b.y), (bfhi(hh.y) + bfhi(a.y)) + bfhi(b.y)}; }
            } else {
#pragma unroll
                for (int j = 0; j < 8; ++j) { f32x4 add = (f32x4){0.f, 0.f, 0.f, 0.f};
#pragma unroll
                    for (int sl = 0; sl < 2; ++sl) { const unsigned p = sl ? p1 : p0; const unsigned xs = split[(p >> 8) * 8 + j];
                        if (xs) { const GAS f32x4* q = (const GAS f32x4*)(PART + ((size_t)(xs - 1u) << 18) + (size_t)(p & 255u) * 256) + lane; add = add + (q[0] + q[16384]) * gates[p]; }
                        else { const v2u a = (sl ? y1 : y0)[64 * j]; add = add + (f32x4){bflo(a.x), bfhi(a.x), bflo(a.y), bfhi(a.y)}; } }
                    { const v2u hh = hr[64 * j]; v[j] = (f32x4){bflo(hh.x), bfhi(hh.x), bflo(hh.y), bfhi(hh.y)} + add; } }
            }
#pragma unroll
            for (int j = 0; j < 8; ++j) s += (v[j].x * v[j].x + v[j].y * v[j].y) + (v[j].z * v[j].z + v[j].w * v[j].w);
            float rstd = 1.0f / sqrtf(wave_sum(s) * (1.f / DM) + 1e-6f); if (bad) rstd = __builtin_nanf("");
#pragma unroll
            for (int j = 0; j < 8; ++j) xo[64 * j] = (v[j] * rstd) * gr[64 * j]; }
    }
#undef IN
#undef SEAM
#undef GRID_BAR
}

extern "C" void kernel_launch(void* const* d_in, const int* in_sizes, int n_in, void* d_out, int out_size, void* d_ws, size_t ws_size, hipStream_t stream) {
    static int grid = 0;
    if (grid == 0) {
        if (n_in != 27 || in_sizes[0] != S * DM || out_size != S * DM || ws_size < WS_END) { fprintf(stderr, "kernel_launch: shape/workspace mismatch (n_in %d, in0 %d, out %d, ws %zu, need %zu); nothing launched\n", n_in, n_in > 0 ? in_sizes[0] : -1, out_size, ws_size, (size_t)WS_END); grid = -1; return; }
        int dev = 0, cus = 0, per_cu = 0;
        if (hipGetDevice(&dev) != hipSuccess || hipDeviceGetAttribute(&cus, hipDeviceAttributeMultiprocessorCount, dev) != hipSuccess) { fprintf(stderr, "kernel_launch: device query failed\n"); grid = -1; return; }
        if (hipFuncSetAttribute((const void*)mk_fwd, hipFuncAttributeMaxDynamicSharedMemorySize, LDS_BYTES) != hipSuccess) { fprintf(stderr, "kernel_launch: hipFuncSetAttribute failed\n"); grid = -1; return; }
        if (hipOccupancyMaxActiveBlocksPerMultiprocessor(&per_cu, (const void*)mk_fwd, NWAVES * 64, LDS_BYTES) != hipSuccess || per_cu < 1) fprintf(stderr, "kernel_launch: note: occupancy query reports %d workgroups per CU\n", per_cu);
        (void)hipGetLastError();
        grid = cus;
    }
    if (grid < 0) return;
    if (hipMemsetAsync((char*)d_ws + WS_CTL, 0, CTL_ZERO_BYTES, stream) != hipSuccess) { fprintf(stderr, "kernel_launch: hipMemsetAsync failed\n"); return; }
    Args a{};
    for (int i = 0; i < 27; ++i) a.in[i] = (const float*)d_in[i];
    a.out = (float*)d_out; a.ws = (unsigned char*)d_ws;
#if MK_PER_PHASE
#ifndef MK_PROBE_MASK
#define MK_PROBE_MASK 0
#endif
    for (int p = 0; p < NPH; ++p) { a.ph_lo = p; a.ph_hi = p + 1; const int reps = ((MK_PROBE_MASK >> p) & 1) ? 5 : 1;
        for (int r = 0; r < reps; ++r) hipLaunchKernelGGL(mk_fwd, dim3(grid), dim3(NWAVES * 64), LDS_BYTES, stream, a); }
#else
    a.ph_lo = 0; a.ph_hi = NPH; hipLaunchKernelGGL(mk_fwd, dim3(grid), dim3(NWAVES * 64), LDS_BYTES, stream, a);
#endif
    const hipError_t le = hipPeekAtLastError();
    if (le != hipSuccess) fprintf(stderr, "kernel_launch: launch failed: %s\n", hipGetErrorName(le));
}
```

```cpp
#include <hip/hip_runtime.h>
#include <cstdio>
#include <cstdint>
namespace pg8 {
#define PG8_LAS __attribute__((address_space(3)))
typedef unsigned short bf16_t;
typedef short bf16x8 __attribute__((ext_vector_type(8)));
typedef float f32x4 __attribute__((ext_vector_type(4)));
typedef unsigned u32x4 __attribute__((ext_vector_type(4)));
typedef int i32x4 __attribute__((ext_vector_type(4)));
typedef int i32x8 __attribute__((ext_vector_type(8)));
constexpr int BM = 256, BK = 64, HALF = 128, HTB = HALF * BK * 2  , STAGE_BYTES = 8 * HTB, NXCD = 8, WGM = 4;

__host__ __device__ __forceinline__ int lds_byte(int r, int c) { const int st = (r >> 4) * 2 + (c >> 5), rr = r & 15, cc = c & 31, ob = rr * 64 + cc * 2; return st * 1024 + (ob ^ (((ob >> 9) & 1) << 5)); }
__host__ __device__ __forceinline__ void stage_rc(int b, int& R, int& C) { const int st = b / 1024, sb = b % 1024, swz = sb ^ (((sb >> 9) & 1) << 5); R = (st >> 1) * 16 + swz / 64; C = (st & 1) * 32 + (swz % 64) / 2; }
__host__ __device__ __forceinline__ int perm32(int rho) { const int n = rho >> 4, i = rho & 15; return 8 * (i >> 2) + 4 * n + (i & 3); }

struct Unit { int pm, pn, ko, aux; };
struct Gemm { const bf16_t* A; const bf16_t* Bt; int M, N, K, ld; };

struct StaticOrder {
    int nM, nN, nwg, G, c;
    __host__ __device__ void init(int M, int N, int G_, int c_) { nM = M / BM; nN = N / BM; nwg = nM * nN; G = G_; c = c_; }
    __host__ __device__ bool next(int i, Unit& u) const {
        const long L = (long)i * G + c; if (L >= nwg) return false;
        int wgid = (int)L; { const int q = nwg / NXCD, r = nwg % NXCD, xcd = wgid % NXCD, off = wgid / NXCD; wgid = (xcd < r ? xcd * (q + 1) : r * (q + 1) + (xcd - r) * q) + off; }
        const int nig = WGM * nN, gid = wgid / nig, fm = gid * WGM, gsz = (nM - fm) < WGM ? (nM - fm) : WGM;
        u.pm = fm + ((wgid % nig) % gsz); u.pn = (wgid % nig) / gsz; return true;
    }
    __device__ __forceinline__ void a_ready(const Unit&) const {}
    __device__ __forceinline__ void done(const Unit&) const {}
};

__device__ __forceinline__ float sat8(float x) { return __builtin_amdgcn_fmed3f(x, -448.f, 448.f); }
__device__ __forceinline__ unsigned pk8x4(float a, float b, float c, float d) { int w = __builtin_amdgcn_cvt_pk_fp8_f32(sat8(a), sat8(b), 0, false); w = __builtin_amdgcn_cvt_pk_fp8_f32(sat8(c), sat8(d), w, true); return (unsigned)w; }
__device__ __forceinline__ unsigned cvt_pk_bf16(float lo, float hi) { unsigned r; asm volatile("v_cvt_pk_bf16_f32 %0, %1, %2" : "=v"(r) : "v"(lo), "v"(hi)); return r; }
typedef float f32x2 __attribute__((ext_vector_type(2)));
__device__ __forceinline__ f32x2 gelu_pk(f32x2 v) {
    const f32x2 av = __builtin_elementwise_abs(v), d = av * 0.2316418882f + 1.0f;
    f32x2 t; t.x = __builtin_amdgcn_rcpf(d.x); t.y = __builtin_amdgcn_rcpf(d.y);
    f32x2 q = t * 0.5307027145f + (-0.7265760135f); q = q * t + 0.7107068705f; q = q * t + (-0.142248368f); q = q * t + 0.127414796f; q = q * t;
    const f32x2 s = (v * v) * (-0.72134752044f);
    f32x2 e; e.x = __builtin_amdgcn_exp2f(s.x); e.y = __builtin_amdgcn_exp2f(s.y);
    const f32x2 m = v * (q * e), r = v - m;
    f32x2 o; o.x = v.x < 0.f ? m.x : r.x; o.y = v.y < 0.f ? m.y : r.y; return o;
}

template <int ACT  > struct EpiBf16 {
    static constexpr bool PERM = true, AFTER_DRAIN = false; static_assert(ACT == 0 || ACT == 1, "EpiBf16: ACT is 0 (none) or 1 (gelu_pk)");
    bf16_t* O; int ldc; const float* bias; int split_cols; size_t split_stride; float scale0;
    __device__ __forceinline__ void operator()(const f32x4 (&acc)[2][2][4][2], const Unit& u, int wr, int wc, int fr, int fq) const {
        const int row0 = u.pm * BM + wr * 64 + fr; int colt = u.pn * BM; bf16_t* base = O;
        float sc = 1.f; if (split_cols) { const int t = colt / split_cols; base += (size_t)t * split_stride; colt -= t * split_cols; if (t == 0) sc = scale0; }
        const int col0 = colt + wc * 32 + 8 * fq, bcol0 = u.pn * BM + wc * 32 + 8 * fq;
        f32x4 bv[2][2];
#pragma unroll
        for (int bj = 0; bj < 2; ++bj)
#pragma unroll
            for (int n = 0; n < 2; ++n) bv[bj][n] = bias ? *(const f32x4*)(bias + bcol0 + bj * HALF + 4 * n) : (f32x4){0.f, 0.f, 0.f, 0.f};
#pragma unroll
        for (int ai = 0; ai < 2; ++ai)
#pragma unroll
            for (int m = 0; m < 4; ++m) { bf16_t* rowp = base + (size_t)(row0 + ai * HALF + m * 16) * ldc + col0;
#pragma unroll
                for (int bj = 0; bj < 2; ++bj) { f32x4 v0 = acc[ai][bj][m][0] + bv[bj][0], v1 = acc[ai][bj][m][1] + bv[bj][1];
                    if (ACT == 1) { f32x2 a = gelu_pk((f32x2){v0[0], v0[1]}), b = gelu_pk((f32x2){v0[2], v0[3]}), c = gelu_pk((f32x2){v1[0], v1[1]}), d = gelu_pk((f32x2){v1[2], v1[3]});
                        v0 = (f32x4){a.x, a.y, b.x, b.y}; v1 = (f32x4){c.x, c.y, d.x, d.y}; }
                    v0 = v0 * sc; v1 = v1 * sc; u32x4 w; w.x = cvt_pk_bf16(v0[0], v0[1]); w.y = cvt_pk_bf16(v0[2], v0[3]); w.z = cvt_pk_bf16(v1[0], v1[1]); w.w = cvt_pk_bf16(v1[2], v1[3]);
                    *(u32x4*)(rowp + bj * HALF) = w; } }
    }
};

template <class Epi, class Sched, bool ALIGN_EPI = false, bool SP2 = false, int QM = 0>
__device__ __forceinline__ void gemm_phase(PG8_LAS unsigned char* lds, const Gemm g, const Sched& S, const Epi& E) {
    constexpr bool F8 = (QM == 1), I8 = (QM == 2);
    const int tid = threadIdx.x, wid = __builtin_amdgcn_readfirstlane(tid >> 6), lane = tid & 63, wr = wid >> 2, wc = wid & 3, fr = lane & 15, fq = lane >> 4;
    const int K = g.K, nt = K / BK, ld = g.ld ? g.ld : g.K;
    unsigned voffA[2], voffB[2];
#pragma unroll
    for (int i = 0; i < 2; ++i) { int R, C; stage_rc(tid * 16 + i * 8192, R, C); const int Rb = Epi::PERM ? ((R & ~31) + perm32(R & 31)) : R;
        voffA[i] = (unsigned)(R * ld + C) * 2u; voffB[i] = (unsigned)(Rb * ld + C) * 2u; }
    const size_t kstep = (size_t)(BK * 2);
    const size_t hstep = (size_t)HALF * ld * 2;
    const size_t tstep = 2 * hstep;
    const unsigned ldsw = (unsigned)wid * 1024u;
    const int aoff = lds_byte(wr * 64 + fr, fq * 8), boff = lds_byte(wc * 32 + fr, fq * 8);
#define PG8_SA(b, h) (((b) * 2 + (h)) * HTB)
#define PG8_SB(b, h) ((4 + (b) * 2 + (h)) * HTB)
#define PG8_STAGE(bufoff, gbase, voff) do { _Pragma("unroll") for (int _i = 0; _i < 2; ++_i) \
        __builtin_amdgcn_global_load_lds((const unsigned*)((const char*)(gbase) + (voff)[_i]), (PG8_LAS unsigned*)(lds + (bufoff) + ldsw + _i * 8192), 16, 0, 0); } while (0)
#define PG8_RD8(p_) __builtin_shufflevector(*(const PG8_LAS i32x4*)(p_), *(const PG8_LAS i32x4*)((p_) + 1024), 0, 1, 2, 3, 4, 5, 6, 7)
#define PG8_LDA(dst, b, h) do { if constexpr (F8) { _Pragma("unroll") for (int m = 0; m < 4; ++m) dst##8[m] = PG8_RD8(lds + PG8_SA(b, h) + aoff + m * 2048); }                                       \
        else { _Pragma("unroll") for (int m = 0; m < 4; ++m) _Pragma("unroll") for (int k = 0; k < 2; ++k) dst[m][k] = *(const PG8_LAS bf16x8*)(lds + PG8_SA(b, h) + aoff + m * 2048 + k * 1024); } } while (0)
#define PG8_LDB(dst, b, h) do { if constexpr (F8) { _Pragma("unroll") for (int n = 0; n < 2; ++n) dst##8[n] = PG8_RD8(lds + PG8_SB(b, h) + boff + n * 2048); }                                       \
        else { _Pragma("unroll") for (int n = 0; n < 2; ++n) _Pragma("unroll") for (int k = 0; k < 2; ++k) dst[n][k] = *(const PG8_LAS bf16x8*)(lds + PG8_SB(b, h) + boff + n * 2048 + k * 1024); } } while (0)
#define PG8_MMA(ai, bj, At, Bt) do { __builtin_amdgcn_s_setprio(1); _Pragma("unroll") for (int m = 0; m < 4; ++m) _Pragma("unroll") for (int n = 0; n < 2; ++n) {                               \
        if constexpr (F8) asm volatile("v_mfma_f32_16x16x128_f8f6f4 %0, %1, %2, %0" : "+v"(acc[ai][bj][m][n]) : "v"(Bt##8[n]), "v"(At##8[m]));     \
        else if constexpr (I8) { _Pragma("unroll") for (int k = 0; k < 2; ++k) acc[ai][bj][m][n] = __builtin_bit_cast(f32x4, __builtin_amdgcn_mfma_i32_16x16x64_i8(__builtin_bit_cast(i32x4, Bt[n][k]), __builtin_bit_cast(i32x4, At[m][k]), __builtin_bit_cast(i32x4, acc[ai][bj][m][n]), 0, 0, 0)); } \
        else { _Pragma("unroll") for (int k = 0; k < 2; ++k) acc[ai][bj][m][n] = __builtin_amdgcn_mfma_f32_16x16x32_bf16(Bt[n][k], At[m][k], acc[ai][bj][m][n], 0, 0, 0); } }                \
        __builtin_amdgcn_s_setprio(0); } while (0)
#define PG8_WAIT_V(n) asm volatile("s_waitcnt vmcnt(" #n ")" ::: "memory")
#define PG8_WAIT_L(n) asm volatile("s_waitcnt lgkmcnt(" #n ")" ::: "memory")
#define PG8_BAR __builtin_amdgcn_s_barrier()
#define PG8_SCHED __builtin_amdgcn_sched_barrier(0)
    Unit cur, nxt; int ui = 0; cur.ko = 0; nxt.ko = 0; cur.aux = 0; nxt.aux = 0;
    if (!S.next(0, cur)) return;
    f32x4 acc[2][2][4][2];
#pragma unroll
    for (int a = 0; a < 2; ++a)
#pragma unroll
        for (int b = 0; b < 2; ++b)
#pragma unroll
            for (int m = 0; m < 4; ++m)
#pragma unroll
                for (int n = 0; n < 2; ++n) acc[a][b][m][n] = (f32x4){0.f, 0.f, 0.f, 0.f};
    bf16x8 At[4][2], B0[2][2], B1[2][2]; i32x8 At8[4], B08[2], B18[2]; (void)At; (void)B0; (void)B1; (void)At8; (void)B08; (void)B18;
    const char* cA = (const char*)g.A + (size_t)cur.pm * tstep + cur.ko; const char* cB = (const char*)g.Bt + (size_t)cur.pn * tstep + cur.ko;
    S.a_ready(cur);
    if constexpr (SP2) {
        PG8_STAGE(PG8_SB(0, 0), cB, voffB); PG8_STAGE(PG8_SB(0, 1), cB + hstep, voffB); PG8_STAGE(PG8_SA(0, 0), cA, voffA); PG8_STAGE(PG8_SA(0, 1), cA + hstep, voffA);
        if (wr == 1) PG8_BAR;
        PG8_WAIT_V(2); PG8_BAR;
        PG8_STAGE(PG8_SB(1, 0), cB + kstep, voffB); PG8_STAGE(PG8_SA(1, 0), cA + kstep, voffA); PG8_STAGE(PG8_SB(1, 1), cB + hstep + kstep, voffB);
        PG8_WAIT_V(6); PG8_BAR;
    } else {
        PG8_STAGE(PG8_SB(0, 0), cB, voffB); PG8_STAGE(PG8_SA(0, 0), cA, voffA); PG8_STAGE(PG8_SB(0, 1), cB + hstep, voffB); PG8_STAGE(PG8_SA(0, 1), cA + hstep, voffA);
        if (wr == 1) PG8_BAR;
        PG8_WAIT_V(4); PG8_BAR;
        PG8_STAGE(PG8_SB(1, 0), cB + kstep, voffB); PG8_STAGE(PG8_SA(1, 0), cA + kstep, voffA); PG8_STAGE(PG8_SB(1, 1), cB + hstep + kstep, voffB);
        PG8_WAIT_V(6); PG8_BAR;
    }
    for (;;) {
        const bool has_next = S.next(ui + 1, nxt);
        const char* nA = has_next ? (const char*)g.A + (size_t)nxt.pm * tstep + nxt.ko : cA; const char* nB = has_next ? (const char*)g.Bt + (size_t)nxt.pn * tstep + nxt.ko : cB;
        for (int t = 0; t < nt; t += 2) {
            const bool last = (t == nt - 2);
            const char* a1 = cA + (size_t)(t + 1) * kstep;
            const char* a2 = last ? nA : cA + (size_t)(t + 2) * kstep; const char* b2 = last ? nB : cB + (size_t)(t + 2) * kstep;
            const char* a3 = a2 + kstep; const char* b3 = b2 + kstep;
            if (last && has_next) S.a_ready(nxt);
            if constexpr (SP2) {
            PG8_LDB(B0, 0, 0); PG8_LDB(B1, 0, 1); PG8_SCHED; PG8_LDA(At, 0, 0); PG8_STAGE(PG8_SA(1, 1), a1 + hstep, voffA);
            PG8_WAIT_V(8); PG8_WAIT_L(0); PG8_BAR; PG8_MMA(0, 0, At, B0); PG8_MMA(0, 1, At, B1); PG8_BAR; PG8_SCHED;
            PG8_LDA(At, 0, 1); PG8_STAGE(PG8_SB(0, 0), b2, voffB); PG8_STAGE(PG8_SB(0, 1), b2 + hstep, voffB); PG8_STAGE(PG8_SA(0, 0), a2, voffA);
            PG8_WAIT_V(8); PG8_WAIT_L(0); PG8_BAR; PG8_MMA(1, 0, At, B0); PG8_MMA(1, 1, At, B1); PG8_BAR; PG8_SCHED;
            PG8_LDB(B0, 1, 0); PG8_LDB(B1, 1, 1); PG8_SCHED; PG8_LDA(At, 1, 0); PG8_STAGE(PG8_SA(0, 1), a2 + hstep, voffA);
            PG8_WAIT_V(8); PG8_WAIT_L(0); PG8_BAR; PG8_MMA(0, 0, At, B0); PG8_MMA(0, 1, At, B1); PG8_BAR; PG8_SCHED;
            PG8_LDA(At, 1, 1); PG8_STAGE(PG8_SB(1, 0), b3, voffB); PG8_STAGE(PG8_SB(1, 1), b3 + hstep, voffB); PG8_STAGE(PG8_SA(1, 0), a3, voffA);
            PG8_WAIT_V(8); PG8_WAIT_L(0); PG8_BAR; PG8_MMA(1, 0, At, B0); PG8_MMA(1, 1, At, B1); PG8_BAR; PG8_SCHED;
            } else {
            PG8_LDB(B0, 0, 0); PG8_SCHED; PG8_LDA(At, 0, 0); PG8_STAGE(PG8_SA(1, 1), a1 + hstep, voffA);
            PG8_WAIT_L(8); PG8_BAR; PG8_WAIT_L(0); PG8_MMA(0, 0, At, B0); PG8_BAR; PG8_SCHED;
            PG8_LDB(B1, 0, 1); PG8_STAGE(PG8_SB(0, 0), b2, voffB);
            PG8_BAR; PG8_WAIT_L(0); PG8_MMA(0, 1, At, B1); PG8_BAR;
            PG8_LDA(At, 0, 1); PG8_STAGE(PG8_SA(0, 0), a2, voffA);
            PG8_BAR; PG8_WAIT_L(0); PG8_MMA(1, 0, At, B0); PG8_BAR; PG8_SCHED;
            PG8_STAGE(PG8_SB(0, 1), b2 + hstep, voffB);
            PG8_WAIT_V(6); PG8_BAR; PG8_MMA(1, 1, At, B1); PG8_BAR;
            PG8_LDB(B0, 1, 0); PG8_SCHED; PG8_LDA(At, 1, 0); PG8_STAGE(PG8_SA(0, 1), a2 + hstep, voffA);
            PG8_WAIT_L(8); PG8_BAR; PG8_WAIT_L(0); PG8_MMA(0, 0, At, B0); PG8_BAR; PG8_SCHED;
            PG8_LDB(B1, 1, 1); PG8_STAGE(PG8_SB(1, 0), b3, voffB);
            PG8_BAR; PG8_WAIT_L(0); PG8_MMA(0, 1, At, B1); PG8_BAR;
            PG8_LDA(At, 1, 1); PG8_STAGE(PG8_SA(1, 0), a3, voffA);
            PG8_BAR; PG8_WAIT_L(0); PG8_MMA(1, 0, At, B0); PG8_BAR; PG8_SCHED;
            PG8_STAGE(PG8_SB(1, 1), b3 + hstep, voffB);
            PG8_WAIT_V(6); PG8_BAR; PG8_MMA(1, 1, At, B1); PG8_BAR;
            }
        }
        if constexpr (ALIGN_EPI) { if (wr == 0) PG8_BAR; }
        if constexpr (F8) asm volatile("s_nop 15\n\ts_nop 15" ::: "memory");
        if constexpr (I8) {
#pragma unroll
            for (int a = 0; a < 2; ++a)
#pragma unroll
                for (int b = 0; b < 2; ++b)
#pragma unroll
                    for (int m = 0; m < 4; ++m)
#pragma unroll
                        for (int n = 0; n < 2; ++n) { const i32x4 iv = __builtin_bit_cast(i32x4, acc[a][b][m][n]); acc[a][b][m][n] = (f32x4){(float)iv[0], (float)iv[1], (float)iv[2], (float)iv[3]}; } }
        if constexpr (!Epi::AFTER_DRAIN) { E(acc, cur, wr, wc, fr, fq); S.done(cur); }
        if (!has_next) break;
#pragma unroll
        for (int a = 0; a < 2; ++a)
#pragma unroll
            for (int b = 0; b < 2; ++b)
#pragma unroll
                for (int m = 0; m < 4; ++m)
#pragma unroll
                    for (int n = 0; n < 2; ++n) acc[a][b][m][n] = (f32x4){0.f, 0.f, 0.f, 0.f};
        if constexpr (F8) asm volatile("s_nop 7" ::: "memory");
        cur = nxt; cA = nA; cB = nB; ++ui;
        if constexpr (ALIGN_EPI) { if (wr == 1) PG8_BAR; }
    }
    PG8_WAIT_V(0);
    if constexpr (!ALIGN_EPI) { if (wr == 0) PG8_BAR; }
    PG8_BAR;
    if constexpr (Epi::AFTER_DRAIN) { E.fused(acc, cur, wr, wc, fr, fq, lds, wid, lane); S.done(cur); }
#undef PG8_SA
#undef PG8_SB
#undef PG8_STAGE
#undef PG8_LDA
#undef PG8_LDB
#undef PG8_MMA
#undef PG8_RD8
#undef PG8_WAIT_V
#undef PG8_WAIT_L
#undef PG8_BAR
#undef PG8_SCHED
}
}
namespace pg8 {
__device__ __forceinline__ u32x4 pack8bf(const f32x4 v0, const f32x4 v1) { u32x4 w; w.x = cvt_pk_bf16(v0[0], v0[1]); w.y = cvt_pk_bf16(v0[2], v0[3]); w.z = cvt_pk_bf16(v1[0], v1[1]); w.w = cvt_pk_bf16(v1[2], v1[3]); return w; }

struct EpiQRope {
    static constexpr bool PERM = true, AFTER_DRAIN = false;
    bf16_t* Qb; const float* cs;
    __device__ __forceinline__ void operator()(const f32x4 (&acc)[2][2][4][2], const Unit& u, int wr, int wc, int fr, int fq) const {
        const int row0 = u.pm * BM + wr * 64 + fr;
        if (u.pn < 4) {
#pragma unroll
            for (int ai = 0; ai < 2; ++ai)
#pragma unroll
                for (int m = 0; m < 4; ++m) { bf16_t* rowp = Qb + (size_t)(row0 + ai * HALF + m * 16) * 1536 + wc * 32 + 8 * fq;
#pragma unroll
                    for (int bj = 0; bj < 2; ++bj) *(u32x4*)(rowp + (2 * u.pn + bj) * 192) = pack8bf(acc[ai][bj][m][0], acc[ai][bj][m][1]); }
        } else {
            const int head = 4 * (u.pn - 4) + wc, i0 = 8 * fq;
#pragma unroll
            for (int ai = 0; ai < 2; ++ai)
#pragma unroll
                for (int m = 0; m < 4; ++m) { const int row = row0 + ai * HALF + m * 16; const float* c = cs + (size_t)row * 64 + i0;
                    const f32x4 c0 = *(const f32x4*)c, c1 = *(const f32x4*)(c + 4), s0 = *(const f32x4*)(c + 32), s1 = *(const f32x4*)(c + 36);
                    const f32x4 x1a = acc[ai][0][m][0], x1b = acc[ai][0][m][1], x2a = acc[ai][1][m][0], x2b = acc[ai][1][m][1];
                    const f32x4 o1a = x1a * c0 - x2a * s0, o1b = x1b * c1 - x2b * s1, o2a = x2a * c0 + x1a * s0, o2b = x2b * c1 + x1b * s1;
                    bf16_t* rowp = Qb + (size_t)row * 1536 + head * 192 + 128 + i0;
                    *(u32x4*)(rowp) = pack8bf(o1a, o1b); *(u32x4*)(rowp + 32) = pack8bf(o2a, o2b); }
        }
    }
};
struct EpiKV {
    static constexpr bool PERM = true, AFTER_DRAIN = false;
    bf16_t* KV;
    __device__ __forceinline__ void operator()(const f32x4 (&acc)[2][2][4][2], const Unit& u, int wr, int wc, int fr, int fq) const {
        const int row0 = u.pm * BM + wr * 64 + fr, d = wc * 32 + 8 * fq;
#pragma unroll
        for (int ai = 0; ai < 2; ++ai)
#pragma unroll
            for (int m = 0; m < 4; ++m) { const size_t row = (size_t)(row0 + ai * HALF + m * 16);
                *(u32x4*)(KV + row * 2560 + u.pn * 320 + d) = pack8bf(acc[ai][0][m][0], acc[ai][0][m][1]);
                *(u32x4*)(KV + row * 2560 + u.pn * 320 + 192 + d) = pack8bf(acc[ai][1][m][0], acc[ai][1][m][1]); }
    }
};
template <bool BASE_F32, bool RSC = false> struct EpiResB {
    static constexpr bool PERM = true, AFTER_DRAIN = false;
    const float* basef; bf16_t* hb; float* ps; int ldc; const float* rsc;
    __device__ __forceinline__ void operator()(const f32x4 (&acc)[2][2][4][2], const Unit& u, int wr, int wc, int fr, int fq) const {
        const int row0 = u.pm * BM + wr * 64 + fr, col0 = u.pn * BM + wc * 32 + 8 * fq;
#pragma unroll
        for (int ai = 0; ai < 2; ++ai) {
            f32x4 bf[BASE_F32 ? 4 : 1][2][2]; u32x4 bh[BASE_F32 ? 1 : 4][2];
#pragma unroll
            for (int m = 0; m < 4; ++m) { const size_t off = (size_t)(row0 + ai * HALF + m * 16) * ldc + col0;
#pragma unroll
                for (int bj = 0; bj < 2; ++bj) { if (BASE_F32) { bf[BASE_F32 ? m : 0][bj][0] = *(const f32x4*)(basef + off + bj * HALF); bf[BASE_F32 ? m : 0][bj][1] = *(const f32x4*)(basef + off + bj * HALF + 4); }
                                                 else bh[BASE_F32 ? 0 : m][bj] = *(const u32x4*)(hb + off + bj * HALF); } }
#pragma unroll
            for (int m = 0; m < 4; ++m) { const int row = row0 + ai * HALF + m * 16; const size_t off = (size_t)row * ldc + col0; float ss = 0.f; const float rf = RSC ? rsc[row] : 1.f;
#pragma unroll
                for (int bj = 0; bj < 2; ++bj) { f32x4 b0, b1;
                    if (BASE_F32) { b0 = bf[BASE_F32 ? m : 0][bj][0]; b1 = bf[BASE_F32 ? m : 0][bj][1]; }
                    else { const u32x4 w = bh[BASE_F32 ? 0 : m][bj];
                        b0 = (f32x4){__builtin_bit_cast(float, w.x << 16), __builtin_bit_cast(float, w.x & 0xffff0000u), __builtin_bit_cast(float, w.y << 16), __builtin_bit_cast(float, w.y & 0xffff0000u)};
                        b1 = (f32x4){__builtin_bit_cast(float, w.z << 16), __builtin_bit_cast(float, w.z & 0xffff0000u), __builtin_bit_cast(float, w.w << 16), __builtin_bit_cast(float, w.w & 0xffff0000u)}; }
                    const f32x4 v0 = RSC ? b0 + acc[ai][bj][m][0] * rf : b0 + acc[ai][bj][m][0], v1 = RSC ? b1 + acc[ai][bj][m][1] * rf : b1 + acc[ai][bj][m][1];
                    ss += ((v0[0] * v0[0] + v0[1] * v0[1]) + (v0[2] * v0[2] + v0[3] * v0[3])) + ((v1[0] * v1[0] + v1[1] * v1[1]) + (v1[2] * v1[2] + v1[3] * v1[3]));
                    *(u32x4*)(hb + off + bj * HALF) = pack8bf(v0, v1); }
                ss += __shfl_xor(ss, 16); ss += __shfl_xor(ss, 32);
                if (fq == 0) ps[(size_t)row * 32 + u.pn * 4 + wc] = ss; }
            asm volatile("" ::: "memory"); }
    }
};
struct EpiBf16Row {
    static constexpr bool PERM = true, AFTER_DRAIN = false;
    bf16_t* O; int ldc; const float* rstd;
    __device__ __forceinline__ void operator()(const f32x4 (&acc)[2][2][4][2], const Unit& u, int wr, int wc, int fr, int fq) const {
        const int row0 = u.pm * BM + wr * 64 + fr, col0 = u.pn * BM + wc * 32 + 8 * fq;
        float rs[2][4];
#pragma unroll
        for (int ai = 0; ai < 2; ++ai)
#pragma unroll
            for (int m = 0; m < 4; ++m) rs[ai][m] = rstd[row0 + ai * HALF + m * 16];
#pragma unroll
        for (int ai = 0; ai < 2; ++ai)
#pragma unroll
            for (int m = 0; m < 4; ++m) { const int row = row0 + ai * HALF + m * 16; const float r = rs[ai][m]; bf16_t* rowp = O + (size_t)row * ldc + col0;
#pragma unroll
                for (int bj = 0; bj < 2; ++bj) *(u32x4*)(rowp + bj * HALF) = pack8bf(acc[ai][bj][m][0] * r, acc[ai][bj][m][1] * r); }
    }
};
template <bool OUT8 = false> struct EpiSwiGLU {
    static constexpr bool PERM = true, AFTER_DRAIN = false;
    bf16_t* Hm; int ldh; int ntn; const float* rstd; float osc;
    __device__ __forceinline__ void operator()(const f32x4 (&acc)[2][2][4][2], const Unit& u, int wr, int wc, int fr, int fq) const {
        const int row0 = u.pm * BM + wr * 64 + fr, col = (u.pn % ntn) * 128 + wc * 32 + 8 * fq;
        float rs[2][4];
#pragma unroll
        for (int ai = 0; ai < 2; ++ai)
#pragma unroll
            for (int m = 0; m < 4; ++m) rs[ai][m] = rstd[row0 + ai * HALF + m * 16];
#pragma unroll
        for (int ai = 0; ai < 2; ++ai)
#pragma unroll
            for (int m = 0; m < 4; ++m) { f32x4 h[2]; const float r = rs[ai][m];
#pragma unroll
                for (int n = 0; n < 2; ++n) { const f32x4 g = acc[ai][0][m][n] * r, up = acc[ai][1][m][n] * r;
#pragma unroll
                    for (int e = 0; e < 4; ++e) { const float s = __builtin_amdgcn_rcpf(1.0f + __builtin_amdgcn_exp2f(-1.4426950408889634f * g[e])); h[n][e] = g[e] * s * up[e]; } }
                if constexpr (OUT8) { typedef unsigned u32x2 __attribute__((ext_vector_type(2)));
                    u32x2 w; w.x = pk8x4(h[0][0] * osc, h[0][1] * osc, h[0][2] * osc, h[0][3] * osc); w.y = pk8x4(h[1][0] * osc, h[1][1] * osc, h[1][2] * osc, h[1][3] * osc);
                    *(u32x2*)((unsigned char*)Hm + (size_t)(row0 + ai * HALF + m * 16) * ldh + col) = w; }
                else *(u32x4*)(Hm + (size_t)(row0 + ai * HALF + m * 16) * ldh + col) = pack8bf(h[0], h[1]); }
    }
};
struct EpiMoEDown {
    static constexpr bool PERM = true, AFTER_DRAIN = false;
    bf16_t* Y; const float* gate; int ntn;
    __device__ __forceinline__ void operator()(const f32x4 (&acc)[2][2][4][2], const Unit& u, int wr, int wc, int fr, int fq) const {
        const int row0 = u.pm * BM + wr * 64 + fr, col0 = (u.pn % ntn) * BM + wc * 32 + 8 * fq;
        float gs[2][4];
#pragma unroll
        for (int ai = 0; ai < 2; ++ai)
#pragma unroll
            for (int m = 0; m < 4; ++m) gs[ai][m] = gate[row0 + ai * HALF + m * 16];
#pragma unroll
        for (int ai = 0; ai < 2; ++ai)
#pragma unroll
            for (int m = 0; m < 4; ++m) { const int row = row0 + ai * HALF + m * 16; const float gt = gs[ai][m]; bf16_t* rowp = Y + (size_t)row * 2048 + col0;
#pragma unroll
                for (int bj = 0; bj < 2; ++bj) *(u32x4*)(rowp + bj * HALF) = pack8bf(acc[ai][bj][m][0] * gt, acc[ai][bj][m][1] * gt); }
    }
};
struct EpiPartF32 {
    static constexpr bool PERM = true, AFTER_DRAIN = false;
    float* out; int ncols, kbytes, rows; const float* rstd;
    __device__ __forceinline__ void operator()(const f32x4 (&acc)[2][2][4][2], const Unit& u, int wr, int wc, int fr, int fq) const {
        const int row0 = u.pm * BM + wr * 64 + fr, col = wc * 32 + 8 * fq, kq = u.ko / kbytes;
        if (col < ncols) {
            float rs[2][4];
#pragma unroll
            for (int ai = 0; ai < 2; ++ai)
#pragma unroll
                for (int m = 0; m < 4; ++m) rs[ai][m] = rstd ? rstd[row0 + ai * HALF + m * 16] : 1.f;
#pragma unroll
            for (int ai = 0; ai < 2; ++ai)
#pragma unroll
                for (int m = 0; m < 4; ++m) { const int row = row0 + ai * HALF + m * 16; const float r = rs[ai][m]; float* p = out + ((size_t)kq * rows + (size_t)row) * ncols + col; *(f32x4*)p = acc[ai][0][m][0] * r; *(f32x4*)(p + 4) = acc[ai][0][m][1] * r; }
        }
    }
};
struct SplitKOrder {
    int G, c, PN, kbytes;
    __device__ __forceinline__ bool next(int i, Unit& u) const { const int L = i * G + c; if (L >= 256) return false; u.pm = L >> 2; u.pn = PN; u.ko = (L & 3) * kbytes; return true; }
    __device__ __forceinline__ void a_ready(const Unit&) const {}
    __device__ __forceinline__ void done(const Unit&) const {}
};
struct GroupedOrder {
    int nN, nwg, G, c, MT, t1, t2, t3, t4, t5, t6, t7, hi;
    __device__ __forceinline__ void init(const unsigned* tot, int nN_, int G_, int c_) {
        int t = 0; nN = nN_; G = G_; c = c_;
        t += (int)((tot[0] + 255u) >> 8); t1 = t; t += (int)((tot[1] + 255u) >> 8); t2 = t; t += (int)((tot[2] + 255u) >> 8); t3 = t; t += (int)((tot[3] + 255u) >> 8); t4 = t;
        t += (int)((tot[4] + 255u) >> 8); t5 = t; t += (int)((tot[5] + 255u) >> 8); t6 = t; t += (int)((tot[6] + 255u) >> 8); t7 = t; t += (int)((tot[7] + 255u) >> 8); MT = t; nwg = MT * nN; hi = nwg;
    }
    __device__ __forceinline__ bool next(int i, Unit& u) const { const long L = (long)i * G + c; if (L >= hi) return false; map((int)L, u); return true; }
    __device__ __forceinline__ void map(int L, Unit& u) const {
        int wgid = L; { const int q = nwg / NXCD, r = nwg % NXCD, xcd = wgid % NXCD, off = wgid / NXCD; wgid = (xcd < r ? xcd * (q + 1) : r * (q + 1) + (xcd - r) * q) + off; }
        const int nig = WGM * nN, gid = wgid / nig, fm = gid * WGM, gsz = (MT - fm) < WGM ? (MT - fm) : WGM;
        const int pm = fm + ((wgid % nig) % gsz), pn = (wgid % nig) / gsz;
        const int e = (pm >= t1) + (pm >= t2) + (pm >= t3) + (pm >= t4) + (pm >= t5) + (pm >= t6) + (pm >= t7);
        u.pm = pm; u.pn = e * nN + pn;
    }
    __device__ __forceinline__ void a_ready(const Unit&) const {}
    __device__ __forceinline__ void done(const Unit&) const {}
};
template <int LOG> struct GroupedSplitOrder {
    GroupedOrder b; int first, nq, kbytes;
    __device__ __forceinline__ bool next(int i, Unit& u) const { const int Lq = i * b.G + b.c; if (Lq >= nq) return false; b.map(first + (Lq >> LOG), u); u.ko = (Lq & ((1 << LOG) - 1)) * kbytes; u.aux = Lq >> LOG; return true; }
    __device__ __forceinline__ void a_ready(const Unit&) const {}
    __device__ __forceinline__ void done(const Unit&) const {}
};
struct EpiMoEDownPart {
    static constexpr bool PERM = true, AFTER_DRAIN = false;
    float* part; unsigned* split; int ntn, kbytes;
    __device__ __forceinline__ void operator()(const f32x4 (&acc)[2][2][4][2], const Unit& u, int wr, int wc, int fr, int fq) const {
        const int kq = u.ko / kbytes, pn = u.pn % ntn; float* base = part + ((size_t)(u.aux * 4 + kq) << 16) + (size_t)(wr * 64 + fr) * 256 + wc * 32 + 8 * fq;
        if (kq == 0 && wr == 0 && wc == 0 && fr == 0 && fq == 0) split[u.pm * ntn + pn] = (unsigned)u.aux + 1u;
#pragma unroll
        for (int ai = 0; ai < 2; ++ai)
#pragma unroll
            for (int m = 0; m < 4; ++m) { float* rowp = base + (size_t)(ai * HALF + m * 16) * 256;
#pragma unroll
                for (int bj = 0; bj < 2; ++bj) { *(f32x4*)(rowp + bj * HALF) = acc[ai][bj][m][0]; *(f32x4*)(rowp + bj * HALF + 4) = acc[ai][bj][m][1]; } }
    }
};
}
#include <cmath>
#define ATT_PV_SPLIT 1
namespace att {
typedef unsigned short bf16_t;
typedef short bf16x8 __attribute__((ext_vector_type(8)));
typedef short s16x4 __attribute__((ext_vector_type(4)));
typedef float f32x16 __attribute__((ext_vector_type(16)));
typedef float f32x4 __attribute__((ext_vector_type(4)));
typedef unsigned u32x4 __attribute__((ext_vector_type(4)));
constexpr int NW = 8, QBLK = 32, KVBLK = 64, QB = NW * QBLK, DV = 128, SHM_V = KVBLK * DV * 2;
constexpr float THR = 40.f;
#define ATT_SBAR() __builtin_amdgcn_sched_barrier(0)
__device__ __forceinline__ int v_st(int k, int c) { const int kk = (k & ~0xC) | ((k & 4) << 1) | ((k & 8) >> 1); return ((kk >> 3) * 4 + (c >> 5)) * 512 + ((kk & 7) * 32 + (c & 31)) * 2; }
__device__ __forceinline__ int v_rd_base(int lane) { return ((lane & 3) << 3) | (((lane >> 2) & 3) << 6) | (((lane >> 4) & 1) << 5) | (((lane >> 5) & 1) << 8); }
constexpr int v_rd_off(int d0, int ks, int half) { return d0 * 512 + ks * 4096 + half * 2048; }
__device__ __forceinline__ int crow(int r, int hi) { return (r & 3) + 8 * (r >> 2) + 4 * hi; }
__device__ __forceinline__ unsigned cvtpk(float lo, float hi) { unsigned r; asm volatile("v_cvt_pk_bf16_f32 %0, %1, %2" : "=v"(r) : "v"(lo), "v"(hi)); return r; }
__device__ __forceinline__ bf16x8 ld8(const bf16_t* p) { return *reinterpret_cast<const bf16x8*>(p); }
__device__ __forceinline__ void mask_tile(f32x16& p0, f32x16& p1, int dq) {
    const float NEG = -__builtin_inff();
#define ATT_MSK(x, c_) asm volatile("v_cmp_gt_i32 vcc, %2, %1\n\tv_cndmask_b32 %0, %0, %3, vcc" : "+v"(x) : "v"(dq), "n"(c_), "v"(NEG) : "vcc")
#pragma unroll
    for (int r = 0; r < 16; ++r) { const int c = (r & 3) + 8 * (r >> 2); ATT_MSK(p0[r], c); ATT_MSK(p1[r], c + 32); }
#undef ATT_MSK
}
__device__ __forceinline__ void partialSM(f32x16& p0, f32x16& p1, float& m_reg, float& mn, float& alpha, const float SCALE) {
    float pmax = p0[0];
#pragma unroll
    for (int r = 1; r < 16; ++r) pmax = fmaxf(pmax, p0[r]);
#pragma unroll
    for (int r = 0; r < 16; ++r) pmax = fmaxf(pmax, p1[r]);
    { auto rr = __builtin_amdgcn_permlane32_swap(__float_as_uint(pmax), __float_as_uint(pmax), false, false);
      pmax = fmaxf(__uint_as_float(rr[0]), __uint_as_float(rr[1])); }
    const float C2 = 1.4426950408889634f * SCALE;
    if (__builtin_expect(__all((pmax - m_reg) * SCALE <= THR), 1)) { mn = m_reg; alpha = 1.f; }
    else { mn = fmaxf(m_reg, pmax); alpha = __builtin_amdgcn_exp2f((m_reg - mn) * C2); m_reg = mn; }
    const float mnL = -mn * C2;
#pragma unroll
    for (int r = 0; r < 16; ++r) p0[r] = fmaf(p0[r], C2, mnL);
#pragma unroll
    for (int r = 0; r < 16; ++r) p1[r] = fmaf(p1[r], C2, mnL);
#pragma unroll
    for (int r = 0; r < 16; ++r) p0[r] = __builtin_amdgcn_exp2f(p0[r]);
}
__device__ __forceinline__ void finishSM(f32x16& p0, f32x16& p1, float alpha, float& l_reg, bf16x8& pa0, bf16x8& pa1, bf16x8& pa2, bf16x8& pa3) {
#pragma unroll
    for (int r = 0; r < 16; ++r) p1[r] = __builtin_amdgcn_exp2f(p1[r]);
    float ps = 0;
#pragma unroll
    for (int r = 0; r < 16; ++r) ps += p0[r];
#pragma unroll
    for (int r = 0; r < 16; ++r) ps += p1[r];
    { auto rr = __builtin_amdgcn_permlane32_swap(__float_as_uint(ps), __float_as_uint(ps), false, false);
      ps = __uint_as_float(rr[0]) + __uint_as_float(rr[1]); }
    l_reg = l_reg * alpha + ps;
#define ATT_PK4(P, B_, OUT) do { unsigned a0 = cvtpk(P[B_+0], P[B_+1]), a1 = cvtpk(P[B_+2], P[B_+3]);                          \
        unsigned b0 = cvtpk(P[B_+4], P[B_+5]), b1 = cvtpk(P[B_+6], P[B_+7]);                                             \
        auto r0 = __builtin_amdgcn_permlane32_swap(a0, b0, false, false); auto r1 = __builtin_amdgcn_permlane32_swap(a1, b1, false, false); \
        u32x4 w = {r0[0], r1[0], r0[1], r1[1]}; OUT = *reinterpret_cast<bf16x8*>(&w); } while (0)
    ATT_PK4(p0, 0, pa0); ATT_PK4(p0, 8, pa1); ATT_PK4(p1, 0, pa2); ATT_PK4(p1, 8, pa3);
#undef ATT_PK4
}
template <int VB>
__device__ __forceinline__ void pv_tile(f32x16* o, int vb0, bf16x8 pa0, bf16x8 pa1, bf16x8 pa2, bf16x8 pa3) {
#define ATT_TRRD(dst, off) asm volatile("ds_read_b64_tr_b16 %0, %1 offset:%2" : "=&v"(dst) : "v"(vb0), "i"(off) : "memory")
#ifndef ATT_PV_SPLIT
#define ATT_PV_SPLIT 0
#endif
#if ATT_PV_SPLIT
#define ATT_PV_D0(d0) do { s16x4 l0, l1, h0, h1; constexpr int b_ = VB * SHM_V + v_rd_off(d0, 0, 0); \
        ATT_TRRD(l0, b_); ATT_TRRD(h0, b_ + 2048); ATT_TRRD(l1, b_ + 4096); ATT_TRRD(h1, b_ + 6144); \
        asm volatile("s_waitcnt lgkmcnt(0)" ::: "memory"); ATT_SBAR();   \
        o[d0] = __builtin_amdgcn_mfma_f32_32x32x16_bf16(pa0, (bf16x8){l0[0], l0[1], l0[2], l0[3], h0[0], h0[1], h0[2], h0[3]}, o[d0], 0, 0, 0);   \
        o[d0] = __builtin_amdgcn_mfma_f32_32x32x16_bf16(pa1, (bf16x8){l1[0], l1[1], l1[2], l1[3], h1[0], h1[1], h1[2], h1[3]}, o[d0], 0, 0, 0);   \
        ATT_SBAR(); ATT_TRRD(l0, b_ + 8192); ATT_TRRD(h0, b_ + 10240); ATT_TRRD(l1, b_ + 12288); ATT_TRRD(h1, b_ + 14336); \
        asm volatile("s_waitcnt lgkmcnt(0)" ::: "memory"); ATT_SBAR();   \
        o[d0] = __builtin_amdgcn_mfma_f32_32x32x16_bf16(pa2, (bf16x8){l0[0], l0[1], l0[2], l0[3], h0[0], h0[1], h0[2], h0[3]}, o[d0], 0, 0, 0);   \
        o[d0] = __builtin_amdgcn_mfma_f32_32x32x16_bf16(pa3, (bf16x8){l1[0], l1[1], l1[2], l1[3], h1[0], h1[1], h1[2], h1[3]}, o[d0], 0, 0, 0); } while (0)
#else
#define ATT_PV_D0(d0) do { s16x4 l0, l1, l2, l3, h0, h1, h2, h3; constexpr int b_ = VB * SHM_V + v_rd_off(d0, 0, 0); \
        ATT_TRRD(l0, b_); ATT_TRRD(h0, b_ + 2048); ATT_TRRD(l1, b_ + 4096); ATT_TRRD(h1, b_ + 6144); ATT_TRRD(l2, b_ + 8192); ATT_TRRD(h2, b_ + 10240); ATT_TRRD(l3, b_ + 12288); ATT_TRRD(h3, b_ + 14336); \
        asm volatile("s_waitcnt lgkmcnt(0)" ::: "memory"); ATT_SBAR();   \
        o[d0] = __builtin_amdgcn_mfma_f32_32x32x16_bf16(pa0, (bf16x8){l0[0], l0[1], l0[2], l0[3], h0[0], h0[1], h0[2], h0[3]}, o[d0], 0, 0, 0);   \
        o[d0] = __builtin_amdgcn_mfma_f32_32x32x16_bf16(pa1, (bf16x8){l1[0], l1[1], l1[2], l1[3], h1[0], h1[1], h1[2], h1[3]}, o[d0], 0, 0, 0);   \
        o[d0] = __builtin_amdgcn_mfma_f32_32x32x16_bf16(pa2, (bf16x8){l2[0], l2[1], l2[2], l2[3], h2[0], h2[1], h2[2], h2[3]}, o[d0], 0, 0, 0);   \
        o[d0] = __builtin_amdgcn_mfma_f32_32x32x16_bf16(pa3, (bf16x8){l3[0], l3[1], l3[2], l3[3], h3[0], h3[1], h3[2], h3[3]}, o[d0], 0, 0, 0); } while (0)
#endif
    ATT_PV_D0(0); ATT_PV_D0(1); ATT_PV_D0(2); ATT_PV_D0(3);
#undef ATT_PV_D0
#undef ATT_TRRD
}

template <int VB>
__device__ __forceinline__ void pv_sm(f32x16* o, int vb0, bf16x8 pa0, bf16x8 pa1, bf16x8 pa2, bf16x8 pa3, f32x16& p0, f32x16& p1, float& m_reg, float& mn, float& alpha, const float SCALE) {
#define ATT_TRRD(dst, off) asm volatile("ds_read_b64_tr_b16 %0, %1 offset:%2" : "=&v"(dst) : "v"(vb0), "i"(off) : "memory")
#define ATT_RD4(base_) ATT_TRRD(l0, base_); ATT_TRRD(h0, base_ + 2048); ATT_TRRD(l1, base_ + 4096); ATT_TRRD(h1, base_ + 6144)
#define ATT_MM2(d0, pa_, pb_) do { asm volatile("s_waitcnt lgkmcnt(0)" : "+v"(l0), "+v"(h0), "+v"(l1), "+v"(h1) :: "memory"); ATT_SBAR();                        \
        o[d0] = __builtin_amdgcn_mfma_f32_32x32x16_bf16(pa_, (bf16x8){l0[0], l0[1], l0[2], l0[3], h0[0], h0[1], h0[2], h0[3]}, o[d0], 0, 0, 0);   \
        o[d0] = __builtin_amdgcn_mfma_f32_32x32x16_bf16(pb_, (bf16x8){l1[0], l1[1], l1[2], l1[3], h1[0], h1[1], h1[2], h1[3]}, o[d0], 0, 0, 0); ATT_SBAR(); } while (0)
    const float C2 = 1.4426950408889634f * SCALE;
    s16x4 l0, l1, h0, h1; constexpr int b0_ = VB * SHM_V;
    ATT_RD4(b0_ + v_rd_off(0, 0, 0));
    float ma = fmaxf(fmaxf(p0[0], p0[1]), p0[2]);
#pragma unroll
    for (int r = 3; r < 15; r += 2) ma = fmaxf(fmaxf(ma, p0[r]), p0[r + 1]);
    ma = fmaxf(ma, p0[15]);
    ATT_MM2(0, pa0, pa1);
    ATT_RD4(b0_ + v_rd_off(0, 0, 0) + 8192);
    float mb = fmaxf(fmaxf(p1[0], p1[1]), p1[2]);
#pragma unroll
    for (int r = 3; r < 15; r += 2) mb = fmaxf(fmaxf(mb, p1[r]), p1[r + 1]);
    mb = fmaxf(mb, p1[15]);
    ATT_MM2(0, pa2, pa3);
    ATT_RD4(b0_ + v_rd_off(1, 0, 0));
    float pmax = fmaxf(ma, mb);
    { auto rr = __builtin_amdgcn_permlane32_swap(__float_as_uint(pmax), __float_as_uint(pmax), false, false); pmax = fmaxf(__uint_as_float(rr[0]), __uint_as_float(rr[1])); }
    const bool keep = __all((pmax - m_reg) * SCALE <= THR);
    mn = keep ? m_reg : fmaxf(m_reg, pmax); alpha = __builtin_amdgcn_exp2f((m_reg - mn) * C2); m_reg = mn;
    const float mnL = -mn * C2;
#define ATT_VFMA(x) asm volatile("v_fma_f32 %0, %0, %1, %2" : "+v"(x) : "s"(C2), "v"(mnL))
#define ATT_VEXP(x) asm volatile("v_exp_f32 %0, %0" : "+v"(x))
    ATT_MM2(1, pa0, pa1);
    ATT_RD4(b0_ + v_rd_off(1, 0, 0) + 8192);
#pragma unroll
    for (int r = 0; r < 16; ++r) ATT_VFMA(p0[r]);
    ATT_MM2(1, pa2, pa3);
    ATT_RD4(b0_ + v_rd_off(2, 0, 0));
#pragma unroll
    for (int r = 0; r < 16; ++r) ATT_VFMA(p1[r]);
#pragma unroll
    for (int r = 0; r < 4; ++r) ATT_VEXP(p0[r]);
    ATT_MM2(2, pa0, pa1);
    ATT_RD4(b0_ + v_rd_off(2, 0, 0) + 8192);
#pragma unroll
    for (int r = 4; r < 8; ++r) ATT_VEXP(p0[r]);
    ATT_MM2(2, pa2, pa3);
    ATT_RD4(b0_ + v_rd_off(3, 0, 0));
#pragma unroll
    for (int r = 8; r < 12; ++r) ATT_VEXP(p0[r]);
    ATT_MM2(3, pa0, pa1);
    ATT_RD4(b0_ + v_rd_off(3, 0, 0) + 8192);
#pragma unroll
    for (int r = 12; r < 16; ++r) ATT_VEXP(p0[r]);
    ATT_MM2(3, pa2, pa3);
#undef ATT_VFMA
#undef ATT_VEXP
#undef ATT_MM2
#undef ATT_RD4
#undef ATT_TRRD
}

template <int DQK, int LDQ, int LDKV, int LDO, int BIAS, int QL, class TOut>
struct Body {
    static constexpr int RB = DQK * 2, SHM_K = KVBLK * RB, NKL = (DQK == 192) ? 4 : 2, ND0 = DQK / 16, ND0R = ND0 - QL;
    static constexpr bool TAB = (BIAS == 1 || BIAS == 2);
    static constexpr int OFF_K = 2 * SHM_V, OFF_WS = OFF_K + 2 * SHM_K, OFF_B = OFF_WS + NW * 64 * 4, OFF_Q = OFF_B + 512, LDS_BYTES = OFF_Q + NW * QL * 1024;
    struct Ref { const bf16_t* Q; const bf16_t* K; const bf16_t* V; TOut* O; const float* kb; float bs; int P0, jlo; };
    struct Seam { bf16x8 qr[ND0R > 0 ? ND0R : 1]; bf16x8 st_v0, st_v1; bf16x8 st_k[NKL]; float st_b; };
    template <int KB>
    static __device__ __forceinline__ void qkt(f32x16& p0, f32x16& p1, const char* K_lds, const char* B_lds, const char* Q_lds, int r32, int hi, const bf16x8* qr, float bs, float lb) {
        if (BIAS == 1) { p0 = *reinterpret_cast<const f32x16*>(B_lds + KB * 256 + hi * 128); p1 = *reinterpret_cast<const f32x16*>(B_lds + KB * 256 + hi * 128 + 64); }
        else if (BIAS == 3) {
            const float bs8 = 8.f * bs, bs32 = 32.f * bs;
            p0[0] = lb; p0[1] = p0[0] + bs; p0[2] = p0[1] + bs; p0[3] = p0[2] + bs;
#pragma unroll
            for (int r = 4; r < 16; ++r) p0[r] = p0[r - 4] + bs8;
#pragma unroll
            for (int r = 0; r < 16; ++r) p1[r] = p0[r] + bs32;
        }
        else { p0 = f32x16{}; p1 = f32x16{}; }
        const char* kb[4];
#pragma unroll
        for (int dd = 0; dd < 4; ++dd) kb[dd] = K_lds + KB * SHM_K + r32 * RB + ((dd * 32 + hi * 16) ^ ((r32 & 7) << 4));
#pragma unroll
        for (int d0 = 0; d0 < ND0; ++d0) { const char* a = kb[d0 & 3] + (d0 >> 2) * 128;
            bf16x8 b0 = *reinterpret_cast<const bf16x8*>(a);
            bf16x8 b1 = *reinterpret_cast<const bf16x8*>(a + 32 * RB);
            bf16x8 q; if (d0 < ND0R) q = qr[d0 < ND0R ? d0 : 0]; else q = *reinterpret_cast<const bf16x8*>(Q_lds + (d0 - ND0R) * 1024);
            p0 = __builtin_amdgcn_mfma_f32_32x32x16_bf16(b0, q, p0, 0, 0, 0);
            p1 = __builtin_amdgcn_mfma_f32_32x32x16_bf16(b1, q, p1, 0, 0, 0); }
    }
    static __device__ __forceinline__ void add_bias(f32x16& p0, f32x16& p1, const char* B_lds, int kbuf, int hi) {
#pragma unroll
        for (int g = 0; g < 4; ++g) { const f32x4 b0 = *reinterpret_cast<const f32x4*>(B_lds + kbuf * 256 + hi * 128 + g * 16), b1 = *reinterpret_cast<const f32x4*>(B_lds + kbuf * 256 + hi * 128 + 64 + g * 16);
            p0[4 * g + 0] += b0[0]; p0[4 * g + 1] += b0[1]; p0[4 * g + 2] += b0[2]; p0[4 * g + 3] += b0[3]; p1[4 * g + 0] += b1[0]; p1[4 * g + 1] += b1[1]; p1[4 * g + 2] += b1[2]; p1[4 * g + 3] += b1[3]; }
    }
#define ATT_VMW() asm volatile("s_waitcnt vmcnt(0)" ::: "memory")
#define ATT_VMWN(n) asm volatile("s_waitcnt vmcnt(%0)" :: "i"(n) : "memory")
#define ATT_SLOAD(Kp, Vp, Bp, k0) do { const size_t o_ = (size_t)((k0) + sr) * LDKV + sc; S.st_v0 = ld8((Vp) + o_); S.st_v1 = ld8((Vp) + o_ + 32 * LDKV);              \
        if (DQK >= 128 || sc < 64) { S.st_k[0] = ld8((Kp) + o_); S.st_k[1] = ld8((Kp) + o_ + 32 * LDKV); }                                                             \
        if (DQK == 192) { if (sc < 64) { S.st_k[NKL - 2] = ld8((Kp) + o_ + 128); S.st_k[NKL - 1] = ld8((Kp) + o_ + 32 * LDKV + 128); } }                                \
        if (TAB) { S.st_b = (Bp)[(k0) + lane]; } } while (0)
#define ATT_SWRITE_K(bf) do { if (DQK >= 128 || sc < 64) { *(bf16x8*)(K_lds + (bf) * SHM_K + kws) = S.st_k[0]; *(bf16x8*)(K_lds + (bf) * SHM_K + kws + 32 * RB) = S.st_k[1]; }   \
        if (DQK == 192) { if (sc < 64) { *(bf16x8*)(K_lds + (bf) * SHM_K + kws + 256) = S.st_k[NKL - 2]; *(bf16x8*)(K_lds + (bf) * SHM_K + kws + 32 * RB + 256) = S.st_k[NKL - 1]; } }  \
        if (TAB) { *(float*)(B_lds + (bf) * 256 + bws) = S.st_b; } } while (0)
#define ATT_SWRITE_V(bf) do { *(bf16x8*)(V_lds + (bf) * SHM_V + vst0) = S.st_v0; *(bf16x8*)(V_lds + (bf) * SHM_V + vst1) = S.st_v1; } while (0)
#define ATT_QLOAD(Qp) do { _Pragma("unroll") for (int d0 = 0; d0 < ND0R; ++d0) S.qr[d0] = ld8((Qp) + (size_t)(wid * QBLK + r32) * LDQ + d0 * 16 + hi * 8); } while (0)
#define ATT_QSPILL(Qp) do { if (QL > 0) { bf16x8 t_[QL > 0 ? QL : 1]; _Pragma("unroll") for (int j_ = 0; j_ < QL; ++j_) t_[j_] = ld8((Qp) + (size_t)(wid * QBLK + r32) * LDQ + (ND0R + j_) * 16 + hi * 8);   \
        _Pragma("unroll") for (int j_ = 0; j_ < QL; ++j_) *(bf16x8*)(Q_lds + j_ * 1024) = t_[j_]; } } while (0)
    static __device__ __forceinline__ void prime(const Ref& cur, char* lds, Seam& S) {
        const int tid = threadIdx.x, wid = __builtin_amdgcn_readfirstlane(tid >> 6), lane = tid & 63, r32 = lane & 31, hi = lane >> 5;
        const int sr = tid >> 4, sc = (tid & 15) * 8, kws = sr * RB + (sc >> 6) * 128 + (((sc & 63) * 2) ^ ((sr & 7) << 4));
        const int bws = ((((lane & 31) >> 2) & 1) * 32 + (lane >> 5) * 16 + (lane & 3) + 4 * ((lane & 31) >> 3)) * 4; (void)bws;
        char* K_lds = lds + OFF_K; char* B_lds = lds + OFF_B; (void)B_lds; char* Q_lds = lds + OFF_Q + wid * (QL * 1024) + lane * 16; (void)Q_lds;
        const int kb0 = cur.jlo * KVBLK;
        ATT_QLOAD(cur.Q);
        ATT_SLOAD(cur.K, cur.V, cur.kb, kb0); ATT_VMW(); ATT_SWRITE_K(0); ATT_QSPILL(cur.Q);
        __syncthreads();
    }
    template <class NF>
    static __device__ __forceinline__ void block(const Ref& cur, NF& nf, char* lds, Seam& S, const float SCALE) {
        const int tid = threadIdx.x, wid = __builtin_amdgcn_readfirstlane(tid >> 6), lane = tid & 63, r32 = lane & 31, hi = lane >> 5;
        const int j_lo = cur.jlo, j_hi = (cur.P0 + QB - 1) / KVBLK + 1;
        const int NT = j_hi - j_lo;
        const int qlo = cur.P0 + wid * QBLK, qm = qlo + r32 - 4 * hi;
        char* V_lds = lds; char* K_lds = lds + OFF_K; char* B_lds = lds + OFF_B; (void)B_lds; char* Q_lds = lds + OFF_Q + wid * (QL * 1024) + lane * 16; (void)Q_lds;
        float* ws = (float*)(lds + OFF_WS) + wid * 64; float* li_l = ws, * al_l = ws + 32;
        float m_reg = -1e30f, l_reg = 0; f32x16 o[4] = {};
        const int sr = tid >> 4, sc = (tid & 15) * 8, vst0 = v_st(sr, sc), vst1 = v_st(32 + sr, sc);
        const int kws = sr * RB + (sc >> 6) * 128 + (((sc & 63) * 2) ^ ((sr & 7) << 4));
        const int bws = ((((lane & 31) >> 2) & 1) * 32 + (lane >> 5) * 16 + (lane & 3) + 4 * ((lane & 31) >> 3)) * 4; (void)bws;
        const int vb0 = (int)(uintptr_t)V_lds + v_rd_base(lane);
        const bf16_t* Kh = cur.K; const bf16_t* Vh = cur.V; const float* Bh = cur.kb; const float bs = cur.bs; (void)bs;
#define ATT_RESC(a) do { if (__any((a) < 1.f)) { if (hi == 0) al_l[r32] = (a); asm volatile("s_waitcnt lgkmcnt(0)" ::: "memory");              \
                     _Pragma("unroll") for (int d_ = 0; d_ < 4; ++d_) _Pragma("unroll") for (int r = 0; r < 16; ++r) o[d_][r] *= al_l[crow(r, hi)]; } } while (0)
#define ATT_KBASE(t) ((j_lo + (t)) * KVBLK)
#define ATT_LB(t) ((BIAS == 3) ? bs * (float)(ATT_KBASE(t) - cur.P0 + 4 * hi) : 0.f)
#define ATT_MASKT(P0_, P1_, t, KB_) do { const int kb_ = ATT_KBASE(t); if (BIAS == 2) add_bias(P0_, P1_, B_lds, KB_, hi);                              \
        if (kb_ + KVBLK - 1 > qlo) mask_tile(P0_, P1_, qm - kb_); } while (0)
#define ATT_SEAM_K0() do { ATT_VMWN(ND0R); ATT_SWRITE_K(0); ATT_SBAR(); } while (0)
        f32x16 pA0, pA1, pB0, pB1; float mnA, mnB, alA, alB; bf16x8 pa0, pa1, pa2, pa3;
        ATT_SWRITE_V(0); ATT_SBAR();
        if (NT > 1) { ATT_SLOAD(Kh, Vh, Bh, ATT_KBASE(1)); }
        ATT_SBAR(); qkt<0>(pA0, pA1, K_lds, B_lds, Q_lds, r32, hi, S.qr, bs, ATT_LB(0));
        ATT_MASKT(pA0, pA1, 0, 0); partialSM(pA0, pA1, m_reg, mnA, alA, SCALE);
        if (NT > 1) { ATT_VMW(); ATT_SWRITE_V(1); ATT_SWRITE_K(1); }
        __syncthreads();
#define ATT_HALF_STEP(PX0, PX1, mnX, alX, PY0, PY1, alY, t, KB, VB, SB) do {                                                      \
        ATT_SBAR(); qkt<KB>(PX0, PX1, K_lds, B_lds, Q_lds, r32, hi, S.qr, bs, ATT_LB(t));                                                    \
        finishSM(PY0, PY1, alY, l_reg, pa0, pa1, pa2, pa3); ATT_SBAR();                                                           \
        if ((t) + 1 < NT) { ATT_SLOAD(Kh, Vh, Bh, ATT_KBASE((t) + 1)); ATT_SBAR(); }                                              \
        ATT_MASKT(PX0, PX1, (t), KB); ATT_SBAR(); pv_sm<VB>(o, vb0, pa0, pa1, pa2, pa3, PX0, PX1, m_reg, mnX, alX, SCALE);                        \
        __syncthreads();                                                                                                      \
        if ((t) + 1 < NT) { ATT_VMW(); ATT_SWRITE_V(SB); ATT_SWRITE_K(SB); }                                                      \
        ATT_RESC(alX); __syncthreads(); } while (0)
        bool issued = false;
        for (int t = 1; t + 1 < NT; t += 2) {
            if (!issued && t + 8 >= NT) { nf.issue(); issued = true; }
            ATT_HALF_STEP(pB0, pB1, mnB, alB, pA0, pA1, alA, t, 1, 0, 0);
            ATT_HALF_STEP(pA0, pA1, mnA, alA, pB0, pB1, alB, t + 1, 0, 1, 1);
        }
        const bool even = (NT & 1) == 0;
        if (even) { ATT_SBAR(); qkt<1>(pB0, pB1, K_lds, B_lds, Q_lds, r32, hi, S.qr, bs, ATT_LB(NT - 1)); ATT_SBAR(); }
        if (!issued) nf.issue();
        const Ref nxt = nf.get(cur); const int kbn = nxt.jlo * KVBLK;
        ATT_SLOAD(nxt.K, nxt.V, nxt.kb, kbn); ATT_SBAR();
        ATT_QLOAD(nxt.Q);
        ATT_SBAR();
        finishSM(pA0, pA1, alA, l_reg, pa0, pa1, pa2, pa3); ATT_SBAR();
        pv_tile<0>(o, vb0, pa0, pa1, pa2, pa3);
        if (even) { ATT_MASKT(pB0, pB1, NT - 1, 1); partialSM(pB0, pB1, m_reg, mnB, alB, SCALE); __syncthreads(); ATT_RESC(alB);
            finishSM(pB0, pB1, alB, l_reg, pa0, pa1, pa2, pa3); ATT_SBAR(); pv_tile<1>(o, vb0, pa0, pa1, pa2, pa3); }
        ATT_SBAR(); ATT_SEAM_K0();
        if (hi == 0) li_l[r32] = l_reg; asm volatile("s_waitcnt lgkmcnt(0)" ::: "memory");
        float rli[16];
#pragma unroll
        for (int r = 0; r < 16; ++r) rli[r] = __builtin_amdgcn_rcpf(li_l[crow(r, hi)]);
        TOut* Ow = cur.O + (size_t)(wid * QBLK) * LDO;
        if constexpr (sizeof(TOut) == 4) {
#pragma unroll
            for (int r = 0; r < 16; ++r) { const int orow = crow(r, hi);
#pragma unroll
                for (int d0 = 0; d0 < 4; ++d0) Ow[(size_t)orow * LDO + d0 * 32 + r32] = o[d0][r] * rli[r]; }
        } else {
            const bool odd = (r32 & 1) != 0; bf16_t* Ob = (bf16_t*)Ow + (odd ? 32 + r32 - 1 : r32);
#pragma unroll
            for (int r = 0; r < 16; ++r) { const int orow = crow(r, hi); const float v0 = o[0][r] * rli[r], v1 = o[1][r] * rli[r], v2 = o[2][r] * rli[r], v3 = o[3][r] * rli[r];
                const float s01 = odd ? v0 : v1, s23 = odd ? v2 : v3;
                const float g01 = __builtin_bit_cast(float, __builtin_amdgcn_update_dpp(0, __builtin_bit_cast(int, s01), 0xB1, 0xF, 0xF, false));
                const float g23 = __builtin_bit_cast(float, __builtin_amdgcn_update_dpp(0, __builtin_bit_cast(int, s23), 0xB1, 0xF, 0xF, false));
                const unsigned w01 = odd ? cvtpk(g01, v1) : cvtpk(v0, g01), w23 = odd ? cvtpk(g23, v3) : cvtpk(v2, g23);
                *(unsigned*)(Ob + (size_t)orow * LDO) = w01; *(unsigned*)(Ob + (size_t)orow * LDO + 64) = w23; }
        }
        ATT_QSPILL(nxt.Q);
        __syncthreads();
#undef ATT_RESC
#undef ATT_KBASE
#undef ATT_LB
#undef ATT_MASKT
#undef ATT_SEAM_K0
#undef ATT_HALF_STEP
    }
#undef ATT_VMW
#undef ATT_VMWN
#undef ATT_SLOAD
#undef ATT_SWRITE_K
#undef ATT_SWRITE_V
#undef ATT_QLOAD
#undef ATT_QSPILL
};
template <class B> struct StaticNext { typename B::Ref nxt; __device__ __forceinline__ void issue() {} __device__ __forceinline__ typename B::Ref get(const typename B::Ref&) { return nxt; } };
template <class B, class Dec>
__device__ __forceinline__ void stream(char* lds, int nblk, const Dec& dec, const float scale) {
    if (nblk <= 0) return;
    typename B::Ref cur = dec(0); typename B::Seam S;
    B::prime(cur, lds, S);
    for (int n = 0; n < nblk; ++n) {
        StaticNext<B> nf; nf.nxt = (n + 1 < nblk) ? dec(n + 1) : cur;
        B::block(cur, nf, lds, S, scale);
        cur = nf.nxt;
    }
}
template <class B, class Dec> struct QueueNext {
    unsigned* ctr; volatile __attribute__((address_space(3))) unsigned* slot; const Dec* dec; int total; unsigned claim; bool more; int pnext;
    __device__ __forceinline__ void issue() { if (threadIdx.x == 0) claim = __hip_atomic_fetch_add(ctr, 1u, __ATOMIC_RELAXED, __HIP_MEMORY_SCOPE_AGENT); }
    __device__ __forceinline__ typename B::Ref get(const typename B::Ref& cur) {
        if (threadIdx.x == 0) slot[2] = claim;
        __syncthreads();
        const int p = (int)slot[2]; more = p < total; pnext = p;
        return more ? (*dec)(p) : cur; }
    __device__ __forceinline__ typename B::Ref get_last() const { return (*dec)(pnext); }
};
template <class B, class Dec>
__device__ __forceinline__ void stream_dyn(char* lds, int total, unsigned* ctr, volatile __attribute__((address_space(3))) unsigned* slot, const Dec& dec, const float scale) {
    if (threadIdx.x == 0) slot[0] = __hip_atomic_fetch_add(ctr, 1u, __ATOMIC_RELAXED, __HIP_MEMORY_SCOPE_AGENT);
    __syncthreads();
    const int pc = (int)slot[0];
    if (pc >= total) return;
    typename B::Ref cur = dec(pc); typename B::Seam S;
    B::prime(cur, lds, S);
    QueueNext<B, Dec> nf; nf.ctr = ctr; nf.slot = slot; nf.dec = &dec; nf.total = total; nf.claim = 0u; nf.more = false;
    for (;;) {
        B::block(cur, nf, lds, S, scale);
        if (!nf.more) break;
        cur = nf.get_last(); }
}
#undef ATT_SBAR
}
#define GAS __attribute__((address_space(1)))
#define LAS __attribute__((address_space(3)))
typedef unsigned short bf16;
typedef unsigned v4u __attribute__((ext_vector_type(4)));
typedef float f32x4 __attribute__((ext_vector_type(4)));
typedef short bf16x8 __attribute__((ext_vector_type(8)));
typedef GAS unsigned gu32;
typedef GAS unsigned long long gu64;
#define RLX_AGENT __ATOMIC_RELAXED, __HIP_MEMORY_SCOPE_AGENT
#define LDS_WAIT() asm volatile("s_waitcnt lgkmcnt(0)" ::: "memory")
#define VM_WAIT() asm volatile("s_waitcnt vmcnt(0)" ::: "memory")
__device__ __forceinline__ unsigned long long rt() { return __builtin_amdgcn_s_memrealtime(); }
__device__ __forceinline__ unsigned f2bf(float f) { unsigned u = __builtin_bit_cast(unsigned, f); return (u + 0x7fffu + ((u >> 16) & 1u)) >> 16; }
__device__ __forceinline__ unsigned pk2(float lo, float hi) { return f2bf(lo) | (f2bf(hi) << 16); }

#define XB_TMO      128
#define XB_XCNT(j)  (256  + 64 * (j))
#define XB_XSUB(j)  (1280 + 64 * (j))
#define XB_XGEN(j)  (2304 + 64 * (j))
#define XB_TOP      3328
#define XB_TOPGEN   3392
#define XCD_BAR_WORDS 3456
#define XB_SPIN_CAP (1u << 18)

__device__ __forceinline__ unsigned xb_ld(unsigned* p)              { return __hip_atomic_load(p, __ATOMIC_RELAXED, __HIP_MEMORY_SCOPE_AGENT); }
__device__ __forceinline__ unsigned xb_add(unsigned* p, unsigned v) { return __hip_atomic_fetch_add(p, v, __ATOMIC_RELAXED, __HIP_MEMORY_SCOPE_AGENT); }
__device__ __forceinline__ unsigned xb_xcc_id() { return (unsigned)__builtin_amdgcn_s_getreg((3 << 11) | 20) & 0xFu; }
#define XB_SPIN(cond, bar) do { unsigned _sp = 0; while (cond) { __builtin_amdgcn_s_sleep(1); \
    if ((++_sp & 255u) == 0u) { if (xb_ld(&(bar)[XB_TMO])) break; if (_sp > XB_SPIN_CAP) { atomicAdd(&(bar)[XB_TMO], 1u); break; } } } } while (0)

struct XcdBarrier {
    unsigned* bar; unsigned x;
    volatile LAS unsigned* st;
};

__device__ __forceinline__ XcdBarrier xcd_barrier_post(unsigned* bar, volatile LAS unsigned* st) {
    XcdBarrier b; b.bar = bar; b.x = xb_xcc_id(); b.st = st;
    if (threadIdx.x == 0) (void)xb_add(&bar[XB_XCNT(b.x)], 1u);
    return b;
}
__device__ __forceinline__ void xcd_barrier_complete(unsigned* bar, unsigned x, unsigned& nloc, unsigned& nx) {
    const unsigned G = gridDim.x * gridDim.y * gridDim.z;
    unsigned sum, cnt, mine, sp = 0u;
    for (;;) {
        sum = 0u; cnt = 0u; mine = 0u;
#pragma unroll
        for (unsigned j = 0; j < 16; ++j) { const unsigned c = xb_ld(&bar[XB_XCNT(j)]); sum += c; cnt += (c > 0u) ? 1u : 0u; mine = (j == x) ? c : mine; }
        if (sum == G) break;
        __builtin_amdgcn_s_sleep(1);
        if ((++sp & 255u) == 0u) { if (xb_ld(&bar[XB_TMO])) break; if (sp > XB_SPIN_CAP) { atomicAdd(&bar[XB_TMO], 1u); break; } }
    }
    nloc = mine > 0u ? mine : 1u; nx = cnt > 0u ? cnt : 1u;
}

__device__ __forceinline__ void xcd_barrier(const XcdBarrier& b) {
    asm volatile("s_waitcnt vmcnt(0)" ::: "memory");
    __syncthreads();
    if (threadIdx.x == 0) {
        unsigned* bar = b.bar;
        __builtin_amdgcn_s_waitcnt(0);
        unsigned nloc = b.st[0], nx = b.st[1];
        if (nloc == 0u) { xcd_barrier_complete(bar, b.x, nloc, nx); b.st[0] = nloc; b.st[1] = nx; }
        const unsigned old = xb_add(&bar[XB_XSUB(b.x)], 1u);
        const unsigned gen = old / nloc;
        if (old + 1u == (gen + 1u) * nloc) {
            __builtin_amdgcn_fence(__ATOMIC_RELEASE, "agent");
            asm volatile("s_waitcnt vmcnt(0)" ::: "memory");
            const unsigned og = xb_add(&bar[XB_TOP], 1u);
            const unsigned tg = og / nx;
            if (og + 1u == (tg + 1u) * nx) xb_add(&bar[XB_TOPGEN], 1u);
            else XB_SPIN(xb_ld(&bar[XB_TOPGEN]) == tg, bar);
            __builtin_amdgcn_fence(__ATOMIC_ACQUIRE, "agent");
            xb_add(&bar[XB_XGEN(b.x)], 1u);
            asm volatile("s_waitcnt vmcnt(0)" ::: "memory");
        } else {
            XB_SPIN(xb_ld(&bar[XB_XGEN(b.x)]) == gen, bar);
            __builtin_amdgcn_fence(__ATOMIC_ACQUIRE, "agent");
            asm volatile("s_waitcnt vmcnt(0)" ::: "memory");
        }
    }
    __syncthreads();
}
constexpr int NWAVES = 8;
#ifndef MK_PER_PHASE
#define MK_PER_PHASE 0
#endif
constexpr int NPH = 21;

constexpr int S = 16384, DM = 2048, FF = 5632, NE = 8;
constexpr int N_IN0 = 4160, N_IN0P = 4352, N_IN1 = 6160, N_IN1P = 6400, NP0 = 4096;
constexpr float SCALE_A = 0.125f, SCALE_B = 0.07216878364870322f, SCALE_C = 0.08838834764831845f;

constexpr size_t MiB = 1u << 20;
constexpr size_t WS_CTL = 0, CTL_ZERO_BYTES = 1 * MiB;
constexpr size_t WS_ROPE = 1 * MiB, WS_KBC = 6 * MiB, WS_LOGF = 7 * MiB, WS_CSUM = 8 * MiB, WS_ROUTE = 8 * MiB + 512 * 1024, WS_CNTG = 9 * MiB, WS_TOT = 9 * MiB + 64 * 1024, WS_SCL = 9 * MiB + 64 * 1024 + 1024  ,
                 WS_TOKPOS = 9 * MiB + 512 * 1024, WS_GATES = 10 * MiB, WS_STATA = 5 * MiB, WS_STATC = 5 * MiB + 64 * 1024, WS_FPART = 11 * MiB, WS_KPART = 1096 * MiB, WS_PART = 880 * MiB,
                 WS_PS = 1 * MiB  , WS_RSTD = 5 * MiB + 256 * 1024, WS_RSTDS = 5 * MiB + 512 * 1024;
constexpr size_t WS_WIN0 = 16 * MiB, WS_WUQ = 33 * MiB, WS_WUKV = 35 * MiB, WS_WOUT0 = 37 * MiB, WS_WGU0 = 45 * MiB, WS_WD0 = 89 * MiB, WS_WIN1 = 111 * MiB, WS_WOUT1 = 136 * MiB,
                 WS_WGU1 = 144 * MiB, WS_WD1 = 496 * MiB;
constexpr size_t WS_XN = 672 * MiB;
constexpr size_t WS_PROJ0 = 736 * MiB, WS_CQN = 872 * MiB, WS_CKVN = 888 * MiB, WS_KF = 904 * MiB  , WS_QB = 984 * MiB, WS_OA = 1032 * MiB, WS_MIX = 1160 * MiB, WS_HMID0 = 736 * MiB;
constexpr size_t WS_A8 = 984 * MiB  , WS_QKV1 = 736 * MiB, WS_O1 = 928 * MiB, WS_AS = 736 * MiB, WS_HMS = 1024 * MiB, WS_YS = 736 * MiB;
constexpr size_t WS_END = 1398 * MiB;
constexpr int MPAD = 34816;
static_assert(WS_WD1 + (size_t)NE * DM * FF * 2 <= WS_XN && WS_HMS + (size_t)MPAD * FF * 2 <= WS_END && WS_YS + (size_t)MPAD * DM * 4 <= WS_HMS && WS_MIX + (size_t)S * DM * 2 <= WS_END, "d_ws map");
constexpr int CW_TMO = 0, CW_CODE = 1, CW_BAR = 4096, CW_QA = 8192, CW_QC = 8256, CW_SPLIT = 12288;

constexpr int RING_BYTES = 150528;
constexpr int LDSCTL_OFF = RING_BYTES, MISC_OFF = LDSCTL_OFF + 320;
constexpr int LDS_BYTES = RING_BYTES + 512;
static_assert(MISC_OFF + 128 <= LDS_BYTES, "LDS map");

typedef unsigned v2u __attribute__((ext_vector_type(2)));
__device__ __forceinline__ float bflo(unsigned w) { return __builtin_bit_cast(float, w << 16); }
__device__ __forceinline__ float bfhi(unsigned w) { return __builtin_bit_cast(float, w & 0xffff0000u); }
__device__ __forceinline__ float wave_sum(float v) {
#pragma unroll
    for (int o = 1; o < 64; o <<= 1) v += __shfl_xor(v, o);
    return v;
}
__device__ const float ROPE_INV[32] = {1.000000000e+00f, 7.498942614e-01f, 5.623413324e-01f, 4.216965139e-01f, 3.162277639e-01f, 2.371373773e-01f, 1.778279394e-01f, 1.333521307e-01f,
    1.000000015e-01f, 7.498941571e-02f, 5.623413250e-02f, 4.216965288e-02f, 3.162277490e-02f, 2.371373773e-02f, 1.778279431e-02f, 1.333521493e-02f, 9.999999776e-03f, 7.498941850e-03f,
    5.623413250e-03f, 4.216964822e-03f, 3.162277630e-03f, 2.371373586e-03f, 1.778279431e-03f, 1.333521446e-03f, 1.000000047e-03f, 7.498942432e-04f, 5.623413017e-04f, 4.216965172e-04f,
    3.162277571e-04f, 2.371373703e-04f, 1.778279402e-04f, 1.333521504e-04f};

struct Args { const float* in[27]; float* out; unsigned char* ws; int ph_lo, ph_hi; };
enum { I_X = 0, I_EV_ATTN_NORM, I_EV_W_IN, I_EV_Q_NORM, I_EV_W_UQ, I_EV_KV_NORM, I_EV_W_UKV, I_EV_LQ1, I_EV_LK1, I_EV_LQ2, I_EV_LK2, I_EV_SUBLN, I_EV_W_OUT, I_EV_FFN_NORM, I_EV_W_GATE, I_EV_W_UP,
       I_EV_W_DOWN, I_OD_ATTN_NORM, I_OD_W_IN, I_OD_FBIAS, I_OD_W_OUT, I_OD_FFN_NORM, I_OD_ROUTER, I_OD_W_GATE, I_OD_W_UP, I_OD_W_DOWN, I_FINAL_NORM };

__device__ __forceinline__ int rowmap(int type, int n) {
    if (type == 1) return (n >> 7) * 256 + (n & 127);
    if (type == 2) return (n >> 7) * 256 + 128 + (n & 127);
    if (type == 3) { const int h = n / 192, w = n - h * 192; if (w < 128) return h * 128 + w; const int i = w & 31, half = (w - 128) >> 5; return (4 + (h >> 2)) * 256 + half * 128 + (h & 3) * 32 + i; }
    return n;
}
using pg8::pk8x4;
constexpr float H8_SCALE = 8.f;
__device__ __forceinline__ unsigned pki8x4(float a, float b, float c, float d) {
    const int ia = (int)__builtin_rintf(__builtin_amdgcn_fmed3f(a, -127.f, 127.f)), ib = (int)__builtin_rintf(__builtin_amdgcn_fmed3f(b, -127.f, 127.f)), ic = (int)__builtin_rintf(__builtin_amdgcn_fmed3f(c, -127.f, 127.f)), id = (int)__builtin_rintf(__builtin_amdgcn_fmed3f(d, -127.f, 127.f));
    return ((unsigned)ia & 255u) | (((unsigned)ib & 255u) << 8) | (((unsigned)ic & 255u) << 16) | ((unsigned)id << 24); }
template <bool PAIR, bool GAIN>
__device__ __forceinline__ float w_clip_t(const float* Wa, const float* Wb, int N, const float* gain, int lane) {
    f32x4 a[16], b[PAIR ? 16 : 1]; float g[GAIN ? 16 : 1];
#pragma unroll
    for (int k = 0; k < 16; ++k) { a[k] = *(const GAS f32x4*)(Wa + (size_t)k * N + 4 * lane); if (PAIR) b[PAIR ? k : 0] = *(const GAS f32x4*)(Wb + (size_t)k * N + 4 * lane); if (GAIN) g[GAIN ? k : 0] = gain[k]; }
    float ss = 0.f;
#pragma unroll
    for (int k = 0; k < 16; ++k) { const float gg = GAIN ? g[GAIN ? k : 0] : 1.f; const f32x4 x = a[k] * gg; ss += (x.x * x.x + x.y * x.y) + (x.z * x.z + x.w * x.w);
        if (PAIR) { const f32x4 y = b[PAIR ? k : 0] * gg; ss += (y.x * y.x + y.y * y.y) + (y.z * y.z + y.w * y.w); } }
    return fmaxf(4.f * sqrtf(wave_sum(ss) * (PAIR ? 1.f / 8192.f : 1.f / 4096.f)), 1e-30f);
}
__device__ __forceinline__ float w_clip(const float* Wa, const float* Wb, int N, const float* gain, int lane) {
    if (Wb) return gain ? w_clip_t<true, true>(Wa, Wb, N, gain, lane) : w_clip_t<true, false>(Wa, Wb, N, gain, lane);
    return gain ? w_clip_t<false, true>(Wa, Wb, N, gain, lane) : w_clip_t<false, false>(Wa, Wb, N, gain, lane);
}
__device__ __forceinline__ float w_clip_experts(const float* Wa, const float* Wb, int K, int N, const float* gain, int lane) {
    f32x4 a[NE][2], b[NE][2]; const float g0 = gain ? gain[0] : 1.f, g1 = gain ? gain[1] : 1.f;
#pragma unroll
    for (int e = 0; e < NE; ++e)
#pragma unroll
        for (int k = 0; k < 2; ++k) { a[e][k] = *(const GAS f32x4*)(Wa + ((size_t)e * K + k) * N + 4 * lane); b[e][k] = *(const GAS f32x4*)(Wb + ((size_t)e * K + k) * N + 4 * lane); }
    float c = 0.f;
#pragma unroll
    for (int e = 0; e < NE; ++e) { float ss = 0.f;
#pragma unroll
        for (int k = 0; k < 2; ++k) { const float g = k ? g1 : g0; const f32x4 x = a[e][k] * g, y = b[e][k] * g;
            ss += ((x.x * x.x + x.y * x.y) + (x.z * x.z + x.w * x.w)) + ((y.x * y.x + y.y * y.y) + (y.z * y.z + y.w * y.w)); }
        c = fmaxf(c, wave_sum(ss)); }
    return fmaxf(4.f * sqrtf(c * (1.f / 1024.f)), 1e-30f);
}
__device__ __forceinline__ float w8_scale_experts(const float* W, int K, int N, int lane) {
    f32x4 a[NE][2];
#pragma unroll
    for (int e = 0; e < NE; ++e)
#pragma unroll
        for (int k = 0; k < 2; ++k) a[e][k] = *(const GAS f32x4*)(W + ((size_t)e * K + k) * N + 4 * lane);
    float c = 0.f;
#pragma unroll
    for (int e = 0; e < NE; ++e) { float ss = 0.f;
#pragma unroll
        for (int k = 0; k < 2; ++k) { const f32x4 x = a[e][k]; ss += (x.x * x.x + x.y * x.y) + (x.z * x.z + x.w * x.w); }
        c = fmaxf(c, wave_sum(ss)); }
    return exp2f(floorf(log2f(2.f / fmaxf(sqrtf(c * (1.f / 512.f)), 1e-30f))));
}
struct TrJob { const float* W; int K, N; bf16* WT; int type, nbn, per, rows_per; const float* gain; int f8; float qs; int nb_lo; };
__device__ __forceinline__ void tr_load(const TrJob& J, int it, int lane, f32x4 (&v)[16]) {
    const int s = it / J.per, r = it - s * J.per, kb = r / J.nbn, nb = J.nb_lo + (r - kb * J.nbn);
    const int k0 = 64 * kb, n0 = 64 * nb, n4 = (lane & 15) * 4, kq = lane >> 4; const float* W = J.W + (size_t)s * J.K * J.N;
#pragma unroll
    for (int j = 0; j < 16; ++j) { const int k = 4 * j + kq; v[j] = (n0 + n4 < J.N) ? *(const GAS f32x4*)(W + (size_t)(k0 + k) * J.N + n0 + n4) : (f32x4){0.f, 0.f, 0.f, 0.f}; }
}
__device__ __forceinline__ void tr_store(const TrJob& J, int it, int lane, const f32x4 (&v)[16], LAS float* scr) {
    const int s = it / J.per, r = it - s * J.per, kb = r / J.nbn, nb = J.nb_lo + (r - kb * J.nbn);
    const int k0 = 64 * kb, n0 = 64 * nb, n4 = (lane & 15) * 4, kq = lane >> 4; bf16* WT = J.WT + (size_t)s * J.rows_per * J.K;
#pragma unroll
    for (int j = 0; j < 16; ++j) { const int k = 4 * j + kq; LAS float* d = scr + k * 65 + n4; d[0] = v[j].x; d[1] = v[j].y; d[2] = v[j].z; d[3] = v[j].w; }
    LDS_WAIT(); asm volatile("" ::: "memory");
    if (J.f8) {
        const int c4 = lane & 3; f32x4 g[4] = {(f32x4){1.f, 1.f, 1.f, 1.f}, (f32x4){1.f, 1.f, 1.f, 1.f}, (f32x4){1.f, 1.f, 1.f, 1.f}, (f32x4){1.f, 1.f, 1.f, 1.f}};
        if (J.gain) {
#pragma unroll
            for (int t = 0; t < 4; ++t) g[t] = *(const GAS f32x4*)(J.gain + k0 + 16 * c4 + 4 * t); }
#pragma unroll
        for (int t = 0; t < 4; ++t) g[t] = g[t] * J.qs;
#pragma unroll
        for (int i = 0; i < 4; ++i) { const int n = 16 * i + (lane >> 2); const LAS float* q = scr + (16 * c4) * 65 + n; v4u o;
            if (J.f8 == 2) { o.x = pki8x4(q[0 * 65] * g[0].x, q[1 * 65] * g[0].y, q[2 * 65] * g[0].z, q[3 * 65] * g[0].w); o.y = pki8x4(q[4 * 65] * g[1].x, q[5 * 65] * g[1].y, q[6 * 65] * g[1].z, q[7 * 65] * g[1].w);
                             o.z = pki8x4(q[8 * 65] * g[2].x, q[9 * 65] * g[2].y, q[10 * 65] * g[2].z, q[11 * 65] * g[2].w); o.w = pki8x4(q[12 * 65] * g[3].x, q[13 * 65] * g[3].y, q[14 * 65] * g[3].z, q[15 * 65] * g[3].w); }
            else { o.x = pk8x4(q[0 * 65] * g[0].x, q[1 * 65] * g[0].y, q[2 * 65] * g[0].z, q[3 * 65] * g[0].w); o.y = pk8x4(q[4 * 65] * g[1].x, q[5 * 65] * g[1].y, q[6 * 65] * g[1].z, q[7 * 65] * g[1].w);
                   o.z = pk8x4(q[8 * 65] * g[2].x, q[9 * 65] * g[2].y, q[10 * 65] * g[2].z, q[11 * 65] * g[2].w); o.w = pk8x4(q[12 * 65] * g[3].x, q[13 * 65] * g[3].y, q[14 * 65] * g[3].z, q[15 * 65] * g[3].w); }
            if (n0 + n < ((J.N + 31) & ~31)) *(GAS v4u*)((unsigned char*)J.WT + ((size_t)s * J.rows_per + rowmap(J.type, n0 + n)) * J.K + k0 + 16 * c4) = o; }
    } else {
        const int c = lane & 7;
        f32x4 g0 = (f32x4){1.f, 1.f, 1.f, 1.f}, g1 = g0; if (J.gain) { g0 = *(const GAS f32x4*)(J.gain + k0 + 8 * c); g1 = *(const GAS f32x4*)(J.gain + k0 + 8 * c + 4); }
#pragma unroll
        for (int i = 0; i < 8; ++i) { const int n = 8 * i + (lane >> 3); const LAS float* q = scr + (8 * c) * 65 + n;
            const float f0 = q[0 * 65] * g0.x, f1 = q[1 * 65] * g0.y, f2 = q[2 * 65] * g0.z, f3 = q[3 * 65] * g0.w, f4 = q[4 * 65] * g1.x, f5 = q[5 * 65] * g1.y, f6 = q[6 * 65] * g1.z, f7 = q[7 * 65] * g1.w;
            v4u o; o.x = pg8::cvt_pk_bf16(f0, f1); o.y = pg8::cvt_pk_bf16(f2, f3); o.z = pg8::cvt_pk_bf16(f4, f5); o.w = pg8::cvt_pk_bf16(f6, f7);
            if (n0 + n < ((J.N + 31) & ~31)) *(GAS v4u*)(WT + (size_t)rowmap(J.type, n0 + n) * J.K + k0 + 8 * c) = o; }
    }
    LDS_WAIT(); asm volatile("" ::: "memory");
}
__device__ __forceinline__ void tr_matrix(const float* W, int K, int N, int NS, int rows_per, bf16* WT, int type, LAS float* scr, int gw, int NGW, int lane, const float* gain = nullptr, int f8 = 0, float qs = 0.f, int nb_lo = 0) {
    TrJob J; J.gain = gain; J.f8 = f8; J.qs = qs; J.nb_lo = nb_lo; J.W = W; J.K = K; J.N = N; J.WT = WT; J.type = type; J.nbn = (N + 63) / 64 - nb_lo; J.per = J.nbn * (K / 64); J.rows_per = rows_per;
    const int total = J.per * NS; int it = gw; if (it >= total) return;
    f32x4 va[16], vb[16];
    tr_load(J, it, lane, va);
    for (;;) {
        const int it2 = it + NGW; const bool h2 = it2 < total; if (h2) tr_load(J, it2, lane, vb);
        tr_store(J, it, lane, va, scr);
        if (!h2) break;
        const int it3 = it2 + NGW; const bool h3 = it3 < total; if (h3) tr_load(J, it3, lane, va);
        tr_store(J, it2, lane, vb, scr);
        if (!h3) break;
        it = it3;
    }
}
__device__ __forceinline__ void rms_row_bf16(const float* xrow, const float* g, bf16* orow, float eps, int lane, unsigned char* o8row = nullptr, float* cst = nullptr, float wsc = 0.f) {
    const GAS f32x4* xr = (const GAS f32x4*)xrow + lane; const GAS f32x4* gr = (const GAS f32x4*)g + lane;
    f32x4 v[8]; float s = 0.f;
#pragma unroll
    for (int j = 0; j < 8; ++j) { v[j] = xr[64 * j]; s += (v[j].x * v[j].x + v[j].y * v[j].y) + (v[j].z * v[j].z + v[j].w * v[j].w); }
    const float rstd = 1.0f / sqrtf(wave_sum(s) * (1.f / DM) + eps);
    GAS unsigned long long* o8 = (GAS unsigned long long*)orow + lane; float am = 0.f;
#pragma unroll
    for (int j = 0; j < 8; ++j) { const f32x4 gg = gr[64 * j]; const f32x4 y = (v[j] * rstd) * gg; o8[64 * j] = (unsigned long long)pk2(y.x, y.y) | ((unsigned long long)pk2(y.z, y.w) << 32);
        v[j] = y; am = fmaxf(am, fmaxf(fmaxf(fabsf(y.x), fabsf(y.y)), fmaxf(fabsf(y.z), fabsf(y.w)))); }
    if (o8row) {
#pragma unroll
        for (int o = 32; o > 0; o >>= 1) am = fmaxf(am, __shfl_xor(am, o));
        am = fmaxf(am, 1e-30f); const float qs = 127.f / am; GAS unsigned* q = (GAS unsigned*)o8row + lane;
#pragma unroll
        for (int j = 0; j < 8; ++j) q[64 * j] = pki8x4(v[j].x * qs, v[j].y * qs, v[j].z * qs, v[j].w * qs);
        if (lane == 0) *cst = (am * (1.f / 127.f)) * wsc; }
}
__device__ __forceinline__ void rstd_rows(const float* ps, float* rstd, int b, int G, int tid) {
    for (int row = b * (NWAVES * 64) + tid; row < S; row += G * NWAVES * 64) { const GAS f32x4* p = (const GAS f32x4*)(ps + (size_t)row * 32); float s = 0.f;
#pragma unroll
        for (int j = 0; j < 8; ++j) { const f32x4 v = p[j]; s += (v.x + v.y) + (v.z + v.w); }
        rstd[row] = 1.0f / sqrtf(s * (1.f / DM) + 1e-6f); }
}
__device__ __forceinline__ void rows_i8(const bf16* H, const float* ps, float* rstd, unsigned char* A8, float* cst, const float wsc, int gw, int NGW, int lane) {
    for (int row = gw; row < S; row += NGW) {
        const float rs = 1.0f / sqrtf(wave_sum(lane < 32 ? ps[(size_t)row * 32 + lane] : 0.f) * (1.f / DM) + 1e-6f);
        const GAS v4u* src = (const GAS v4u*)(H + (size_t)row * DM) + lane; const v4u x[4] = {src[0], src[64], src[128], src[192]}; float am = 0.f;
#pragma unroll
        for (int j = 0; j < 4; ++j) { am = fmaxf(am, fmaxf(fmaxf(fabsf(bflo(x[j].x)), fabsf(bfhi(x[j].x))), fmaxf(fabsf(bflo(x[j].y)), fabsf(bfhi(x[j].y))))); am = fmaxf(am, fmaxf(fmaxf(fabsf(bflo(x[j].z)), fabsf(bfhi(x[j].z))), fmaxf(fabsf(bflo(x[j].w)), fabsf(bfhi(x[j].w))))); }
#pragma unroll
        for (int o = 32; o > 0; o >>= 1) am = fmaxf(am, __shfl_xor(am, o));
        am = fmaxf(am, 1e-30f); const float qs = 127.f / am;
        GAS v2u* dst = (GAS v2u*)(A8 + (size_t)row * DM) + lane;
#pragma unroll
        for (int j = 0; j < 4; ++j) { v2u o; o.x = pki8x4(bflo(x[j].x) * qs, bfhi(x[j].x) * qs, bflo(x[j].y) * qs, bfhi(x[j].y) * qs); o.y = pki8x4(bflo(x[j].z) * qs, bfhi(x[j].z) * qs, bflo(x[j].w) * qs, bfhi(x[j].w) * qs); dst[64 * j] = o; }
        if (lane == 0) { rstd[row] = rs; cst[row] = (am * (1.f / 127.f)) * rs * wsc; } }
}
__device__ __forceinline__ void rms512_bf16(const bf16* src, const float* g, bf16* dst, int lane) {
    const v4u raw = *(const GAS v4u*)(src + 8 * lane);
    float x[8] = {bflo(raw.x), bfhi(raw.x), bflo(raw.y), bfhi(raw.y), bflo(raw.z), bfhi(raw.z), bflo(raw.w), bfhi(raw.w)};
    float s = 0.f;
#pragma unroll
    for (int e = 0; e < 8; ++e) s += x[e] * x[e];
    const float rstd = 1.0f / sqrtf(wave_sum(s) * (1.f / 512.f) + 1e-6f);
    const f32x4 g0 = *(const GAS f32x4*)(g + 8 * lane), g1 = *(const GAS f32x4*)(g + 8 * lane + 4);
    v4u o; o.x = pk2(x[0] * rstd * g0.x, x[1] * rstd * g0.y); o.y = pk2(x[2] * rstd * g0.z, x[3] * rstd * g0.w); o.z = pk2(x[4] * rstd * g1.x, x[5] * rstd * g1.y); o.w = pk2(x[6] * rstd * g1.z, x[7] * rstd * g1.w);
    *(GAS v4u*)(dst + 8 * lane) = o;
}
__device__ __forceinline__ void sincos_d(float ang, float& sn, float& cs) {
    const double t0 = (double)ang * 0.15915494309189535; const double t = t0 - __builtin_rint(t0); const double x = t * 6.283185307179586, x2 = x * x;
    double sp = -1.0 / 51090942171709440000.0;
    sp = sp * x2 + 1.0 / 121645100408832000.0; sp = sp * x2 - 1.0 / 355687428096000.0; sp = sp * x2 + 1.0 / 1307674368000.0; sp = sp * x2 - 1.0 / 6227020800.0; sp = sp * x2 + 1.0 / 39916800.0;
    sp = sp * x2 - 1.0 / 362880.0; sp = sp * x2 + 1.0 / 5040.0; sp = sp * x2 - 1.0 / 120.0; sp = sp * x2 + 1.0 / 6.0; sp = sp * x2 - 1.0; sn = (float)(-sp * x);
    double cp = 1.0 / 1124000727777607680000.0;
    cp = cp * x2 - 1.0 / 2432902008176640000.0; cp = cp * x2 + 1.0 / 6402373705728000.0; cp = cp * x2 - 1.0 / 20922789888000.0; cp = cp * x2 + 1.0 / 87178291200.0; cp = cp * x2 - 1.0 / 479001600.0;
    cp = cp * x2 + 1.0 / 3628800.0; cp = cp * x2 - 1.0 / 40320.0; cp = cp * x2 + 1.0 / 720.0; cp = cp * x2 - 1.0 / 24.0; cp = cp * x2 + 0.5; cp = cp * x2 - 1.0; cs = (float)(-cp);
}

typedef att::Body<64, NP0, NP0, 2048, 3, 0, bf16> BodyA;
typedef att::Body<192, 1536, 2560, 2048, 0, 8, bf16> BodyB;
typedef att::Body<128, 6144, 6144, 2048, 1, 2, bf16> BodyC;
struct DecB { const bf16* Qb; const bf16* KV; bf16* MIX; int vcu, G;
    __device__ __forceinline__ BodyB::Ref operator()(int n) const { const int it = vcu + (n >> 1) * G, h = it >> 5, x = it & 31, qb = (n & 1) ? 63 - x : x;
        BodyB::Ref r; r.Q = Qb + (size_t)(qb * 256) * 1536 + h * 192; r.K = KV + h * 320; r.V = KV + h * 320 + 192; r.O = MIX + (size_t)(qb * 256) * 2048 + 1024 + h * 128; r.kb = nullptr; r.bs = 0.f; r.P0 = qb * 256; r.jlo = 0; return r; } };
static_assert(BodyA::LDS_BYTES <= RING_BYTES && BodyB::LDS_BYTES <= RING_BYTES && BodyC::LDS_BYTES <= RING_BYTES, "attention LDS");
static_assert(BodyA::LDS_BYTES <= 143360 && BodyC::LDS_BYTES <= 143360 && 143360 + 4096 <= RING_BYTES, "sorted keys above the list-driven bodies");

constexpr float SKIP_THRESH = 106.0f;
constexpr int KEYS_OFF = 143360;
template <int MODE>
__device__ __forceinline__ int build_list(LAS unsigned char* scr, volatile LAS unsigned* list, const float* stats, const float* kbtab, float scale, int vcu, int G, int tid) {
    LAS float* KmH = (LAS float*)scr; LAS float* red = (LAS float*)(scr + 256); LAS unsigned* keys = (LAS unsigned*)(scr + KEYS_OFF); LAS float* te = (LAS float*)(scr + 16384);
    { const int vh = tid & 15, part = tid >> 4; float m = 0.f; for (int c = part; c < 256; c += 32) m = fmaxf(m, stats[c * 32 + 16 + vh]); red[part * 16 + vh] = m; }
    if (MODE == 1) {
#pragma unroll
        for (int i = 0; i < 8; ++i) { const int idx = tid + 512 * i; te[idx] = kbtab[(size_t)(idx >> 8) * S + 64 * (idx & 255) + 63]; } }
    __syncthreads();
    if (tid < 16) { float m = 0.f; for (int q = 0; q < 32; ++q) m = fmaxf(m, red[q * 16 + tid]); KmH[tid] = m; }
    __syncthreads();
#pragma unroll 1
    for (int it = tid; it < 1024; it += NWAVES * 64) { const int vh = it >> 6, qb = it & 63, P0 = qb * 256;
        float q2 = 0.f;
#pragma unroll
        for (int i = 0; i < 4; ++i) q2 = fmaxf(q2, stats[(4 * qb + i) * 32 + vh]);
        const float Bq = scale * sqrtf(q2 * KmH[vh]) * 1.01f + 0.05f, thr = SKIP_THRESH + 2.f * Bq;
        int jlo;
        if (MODE == 0) { const float slope = 1.0f / (float)(2 << (vh >> 1)); const float X = (float)P0 - thr / slope - 63.f; jlo = X > 0.f ? (int)floorf(X * (1.f / 64.f)) : 0; }
        else { int lo = 0, hi = 4 * qb;
            const float base = qb > 0 ? te[vh * 256 + 4 * qb - 1] : 0.f;
            while (lo < hi) { const int mid = (lo + hi) >> 1; if (scale * (te[vh * 256 + mid] - base) >= -thr) hi = mid; else lo = mid + 1; }
            jlo = lo; }
        jlo = jlo < 0 ? 0 : (jlo > 4 * qb ? 4 * qb : jlo);
        keys[it] = ((unsigned)(4 * (qb + 1) - jlo) << 10) | (unsigned)(1023 - it); }
    __syncthreads();
#pragma unroll 1
    for (int k = 2; k <= 1024; k <<= 1)
#pragma unroll 1
        for (int j = k >> 1; j > 0; j >>= 1) { const int i = ((tid & ~(j - 1)) << 1) | (tid & (j - 1)), l = i | j; const unsigned a = keys[i], b = keys[l]; const bool up = (i & k) == 0;
            if ((a < b) == up) { keys[i] = b; keys[l] = a; }
            __syncthreads(); }
    return 1024;
}
struct DecAL { const bf16* proj; bf16* OA; volatile LAS unsigned* keys;
    __device__ __forceinline__ BodyA::Ref operator()(int n) const { const unsigned key = (unsigned)__builtin_amdgcn_readfirstlane((int)keys[n]); const int it = 1023 - (int)(key & 1023u), vh = it >> 6, qb = it & 63, h = vh >> 1; const unsigned e = (unsigned)(4 * (qb + 1) - (int)(key >> 10)) << 16;
        BodyA::Ref r; r.Q = proj + (size_t)(qb * 256) * NP0 + vh * 64; r.K = proj + 1024 + vh * 64; r.V = proj + 2048 + h * 128; r.O = OA + (size_t)(qb * 256) * 2048 + vh * 128; r.kb = nullptr; r.bs = 4.0f / (float)(1 << h); r.P0 = qb * 256; r.jlo = (int)(e >> 16); return r; } };
struct DecCL { const bf16* QKV; bf16* O1; const float* kb; volatile LAS unsigned* keys;
    __device__ __forceinline__ BodyC::Ref operator()(int n) const { const unsigned key = (unsigned)__builtin_amdgcn_readfirstlane((int)keys[n]); const int it = 1023 - (int)(key & 1023u), h = it >> 6, qb = it & 63; const unsigned e = (unsigned)(4 * (qb + 1) - (int)(key >> 10)) << 16;
        BodyC::Ref r; r.Q = QKV + (size_t)(qb * 256) * 6144 + h * 128; r.K = QKV + 2048 + h * 128; r.V = QKV + 4096 + h * 128; r.O = O1 + (size_t)(qb * 256) * 2048 + h * 128; r.kb = kb + h * S; r.bs = 0.f; r.P0 = qb * 256; r.jlo = (int)(e >> 16); return r; } };

__global__ void __launch_bounds__(NWAVES * 64, 2) mk_fwd(Args args) {
    extern __shared__ __attribute__((aligned(16))) unsigned char lds[];
    LAS unsigned char* const ldsl = (LAS unsigned char*)lds;
    volatile LAS unsigned* const MISC = (volatile LAS unsigned*)(ldsl + MISC_OFF);
    const int tid = threadIdx.x, lane = tid & 63, wave = __builtin_amdgcn_readfirstlane(tid >> 6);
    const int G = gridDim.x; const int vcu = (G % 8 == 0) ? ((int)blockIdx.x % 8) * (G / 8) + (int)blockIdx.x / 8 : (int)blockIdx.x;
    unsigned char* const ws = args.ws;
    gu32* const ctl = (gu32*)(ws + WS_CTL);
    for (int u = tid; u < (LDS_BYTES - LDSCTL_OFF) / 4; u += NWAVES * 64) ((LAS unsigned*)(ldsl + LDSCTL_OFF))[u] = 0u;
    __syncthreads();
#if MK_PER_PHASE
    XcdBarrier bar; bar.bar = (unsigned*)(ctl + CW_BAR); bar.x = 0; bar.st = nullptr; (void)bar;
#define GRID_BAR() do { } while (0)
#else
    XcdBarrier bar = xcd_barrier_post((unsigned*)(ctl + CW_BAR), MISC + 8);
#define GRID_BAR() xcd_barrier(bar)
#endif
    const int lo = args.ph_lo, hi = args.ph_hi;
#define IN(k) (lo <= (k) && (k) < hi)
#define PHASE_LOCAL_IDS int tid_ph_ = (int)threadIdx.x; asm volatile("" : "+v"(tid_ph_)); const int tid = tid_ph_, lane = tid & 63; (void)tid; (void)lane
#define SEAM(k) do { if (IN((k) + 1)) GRID_BAR(); } while (0)
    const int gw = vcu * NWAVES + wave, NGW = G * NWAVES;
    bf16* const HB = (bf16*)(ws + WS_XN);

    if (IN(0)) { PHASE_LOCAL_IDS;
        LAS float* scr = (LAS float*)(ldsl + wave * 16640);
        LAS float* scl = (LAS float*)(ldsl + 139264);
        if (wave == 0) { const float c0 = w_clip(args.in[I_EV_W_IN], nullptr, N_IN0, nullptr, lane), c1 = w_clip(args.in[I_EV_W_GATE], args.in[I_EV_W_UP], FF, args.in[I_EV_FFN_NORM], lane),
                                     c2 = w_clip(args.in[I_OD_W_IN], nullptr, N_IN1, args.in[I_OD_ATTN_NORM], lane), c3 = w_clip_experts(args.in[I_OD_W_GATE], args.in[I_OD_W_UP], DM, FF, args.in[I_OD_FFN_NORM], lane),
                                     c4 = w8_scale_experts(args.in[I_OD_W_DOWN], FF, DM, lane);
            if (lane == 0) { scl[0] = c0; scl[1] = c1; scl[2] = c2; scl[3] = c3; scl[4] = c4;
                if (blockIdx.x == 0) { float* t = (float*)(ws + WS_SCL); t[0] = c0; t[1] = c1; t[2] = c2; t[3] = c3; t[4] = c4; } } }
        __syncthreads();
        const float clip_in0 = scl[0], clip_gu0 = scl[1], clip_in1 = scl[2], clip_gu1 = scl[3], scale_d1 = scl[4];
        { const float qsi = 127.f / clip_in0;
          tr_matrix(args.in[I_EV_W_IN], DM, N_IN0, 1, 0, (bf16*)(ws + WS_WIN0), 0, scr, gw, NGW, lane, nullptr, 2, qsi);
          tr_matrix(args.in[I_EV_W_IN], DM, N_IN0, 1, 0, (bf16*)(ws + WS_WIN0), 0, scr, gw, NGW, lane, nullptr, 0, 0.f, 64); }
        tr_matrix(args.in[I_EV_W_UQ], 512, 1536, 1, 0, (bf16*)(ws + WS_WUQ), 3, scr, gw, NGW, lane);
        tr_matrix(args.in[I_EV_W_UKV], 512, 2048, 1, 0, (bf16*)(ws + WS_WUKV), 0, scr, gw, NGW, lane);
        tr_matrix(args.in[I_EV_W_OUT], DM, DM, 1, 0, (bf16*)(ws + WS_WOUT0), 0, scr, gw, NGW, lane);
        const float qs0 = 127.f / clip_gu0;
        tr_matrix(args.in[I_EV_W_GATE], DM, FF, 1, 0, (bf16*)(ws + WS_WGU0), 1, scr, gw, NGW, lane, args.in[I_EV_FFN_NORM], 2, qs0);
        tr_matrix(args.in[I_EV_W_UP], DM, FF, 1, 0, (bf16*)(ws + WS_WGU0), 2, scr, gw, NGW, lane, args.in[I_EV_FFN_NORM], 2, qs0);
        tr_matrix(args.in[I_EV_W_DOWN], FF, DM, 1, 0, (bf16*)(ws + WS_WD0), 0, scr, gw, NGW, lane);
        { const float qsi = 127.f / clip_in1;
          tr_matrix(args.in[I_OD_W_IN], DM, N_IN1, 1, 0, (bf16*)(ws + WS_WIN1), 0, scr, gw, NGW, lane, args.in[I_OD_ATTN_NORM], 2, qsi);
          tr_matrix(args.in[I_OD_W_IN], DM, N_IN1, 1, 0, (bf16*)(ws + WS_WIN1), 0, scr, gw, NGW, lane, args.in[I_OD_ATTN_NORM], 0, 0.f, 96); }
        tr_matrix(args.in[I_OD_W_OUT], DM, DM, 1, 0, (bf16*)(ws + WS_WOUT1), 0, scr, gw, NGW, lane);
        const float qs1 = 127.f / clip_gu1;
        tr_matrix(args.in[I_OD_W_GATE], DM, FF, NE, 2 * FF, (bf16*)(ws + WS_WGU1), 1, scr, gw, NGW, lane, args.in[I_OD_FFN_NORM], 2, qs1);
        tr_matrix(args.in[I_OD_W_UP], DM, FF, NE, 2 * FF, (bf16*)(ws + WS_WGU1), 2, scr, gw, NGW, lane, args.in[I_OD_FFN_NORM], 2, qs1);
        tr_matrix(args.in[I_OD_W_DOWN], FF, DM, NE, DM, (bf16*)(ws + WS_WD1), 0, scr, gw, NGW, lane, nullptr, 1, scale_d1);
        { const int gt = gw * 64 + lane, NGT = NGW * 64;
          GAS v4u* z0 = (GAS v4u*)((bf16*)(ws + WS_WIN0) + (size_t)N_IN0 * DM); const int n0 = (N_IN0P - N_IN0) * DM / 8;
          for (int i = gt; i < n0; i += NGT) z0[i] = (v4u){0u, 0u, 0u, 0u};
          GAS v4u* z1 = (GAS v4u*)((bf16*)(ws + WS_WIN1) + (size_t)(N_IN1 + 16) * DM); const int n1 = (N_IN1P - N_IN1 - 16) * DM / 8;
          for (int i = gt; i < n1; i += NGT) z1[i] = (v4u){0u, 0u, 0u, 0u};
          float* cs = (float*)(ws + WS_ROPE);
          for (int i = gt; i < S * 32; i += NGT) { const int pos = i >> 5, k = i & 31; const float ang = (float)pos * ROPE_INV[k]; float sn, c; sincos_d(ang, sn, c); cs[pos * 64 + k] = c; cs[pos * 64 + 32 + k] = sn; }
        }
        { const float wsc0 = clip_in0 * (1.f / 127.f);
          for (int m = gw; m < S; m += NGW) rms_row_bf16(args.in[I_X] + (size_t)m * DM, args.in[I_EV_ATTN_NORM], (bf16*)(ws + WS_XN) + (size_t)m * DM, 1e-6f, lane, ws + WS_A8 + (size_t)m * DM, (float*)(ws + WS_RSTDS) + m, wsc0); }
        SEAM(0);
    }
    if (IN(1)) { PHASE_LOCAL_IDS;
        { pg8::Gemm g{(const bf16*)(ws + WS_A8), (const bf16*)(ws + WS_WIN0), S, NP0, DM / 2, DM / 2}; pg8::StaticOrder so; so.init(S, NP0, G, (int)blockIdx.x);
          pg8::EpiBf16Row E{(bf16*)(ws + WS_PROJ0), NP0, (const float*)(ws + WS_RSTDS)};
          pg8::gemm_phase<pg8::EpiBf16Row, pg8::StaticOrder, true, true, 2>(ldsl, g, so, E); }
        __syncthreads();
        { pg8::Gemm g{(const bf16*)(ws + WS_XN), (const bf16*)(ws + WS_WIN0), S, 256, 512, DM}; pg8::SplitKOrder so{G, (int)blockIdx.x, 16, 1024};
          pg8::EpiPartF32 E{(float*)(ws + WS_KPART), 64, 1024, S, nullptr};
          pg8::gemm_phase<pg8::EpiPartF32, pg8::SplitKOrder, true, true>(ldsl, g, so, E); }
        SEAM(1);
    }
    if (IN(2)) { PHASE_LOCAL_IDS;
        const bf16* proj = (const bf16*)(ws + WS_PROJ0); const float* cs = (const float*)(ws + WS_ROPE); bf16* Kf = (bf16*)(ws + WS_KF);
        LAS float* sm = (LAS float*)ldsl; float* statA = (float*)(ws + WS_STATA);
        for (int c = (int)blockIdx.x; c < 256; c += G) { float qmax = 0.f, kmax = 0.f;
            for (int i = 0; i < 8; ++i) { const int m = 64 * c + 8 * wave + i; const bf16* prow = proj + (size_t)m * NP0;
                rms512_bf16(prow + 3072, args.in[I_EV_Q_NORM], (bf16*)(ws + WS_CQN) + (size_t)m * 512, lane);
                rms512_bf16(prow + 3584, args.in[I_EV_KV_NORM], (bf16*)(ws + WS_CKVN) + (size_t)m * 512, lane);
                if (lane < 32) { const float* kp = (const float*)(ws + WS_KPART) + (size_t)m * 64 + lane; const size_t kq = (size_t)S * 64;
                    const float x1 = (kp[0] + kp[kq]) + (kp[2 * kq] + kp[3 * kq]), x2 = (kp[32] + kp[kq + 32]) + (kp[2 * kq + 32] + kp[3 * kq + 32]); const float cc = cs[m * 64 + lane], sn = cs[m * 64 + 32 + lane];
                    const bf16 o1 = (bf16)f2bf(x1 * cc - x2 * sn), o2 = (bf16)f2bf(x2 * cc + x1 * sn); bf16* kr = Kf + (size_t)m * 2560 + 128 + lane;
#pragma unroll
                    for (int h = 0; h < 8; ++h) { kr[h * 320] = o1; kr[h * 320 + 32] = o2; } }
                { const v4u a0 = *(const GAS v4u*)(prow + 16 * lane), a1 = *(const GAS v4u*)(prow + 16 * lane + 8), b0 = *(const GAS v4u*)(prow + 1024 + 16 * lane), b1 = *(const GAS v4u*)(prow + 1024 + 16 * lane + 8);
                  float sq = 0.f, sk = 0.f;
#pragma unroll
                  for (int e = 0; e < 4; ++e) { sq += bflo(a0[e]) * bflo(a0[e]) + bfhi(a0[e]) * bfhi(a0[e]) + bflo(a1[e]) * bflo(a1[e]) + bfhi(a1[e]) * bfhi(a1[e]);
                                                sk += bflo(b0[e]) * bflo(b0[e]) + bfhi(b0[e]) * bfhi(b0[e]) + bflo(b1[e]) * bflo(b1[e]) + bfhi(b1[e]) * bfhi(b1[e]); }
                  sq += __shfl_xor(sq, 1); sq += __shfl_xor(sq, 2); sk += __shfl_xor(sk, 1); sk += __shfl_xor(sk, 2); qmax = fmaxf(qmax, sq); kmax = fmaxf(kmax, sk); } }
            if ((lane & 3) == 0) { sm[wave * 32 + (lane >> 2)] = qmax; sm[wave * 32 + 16 + (lane >> 2)] = kmax; }
            __syncthreads();
            if (tid < 32) { float v = 0.f; for (int q = 0; q < 8; ++q) v = fmaxf(v, sm[q * 32 + tid]); statA[c * 32 + tid] = v; }
            __syncthreads(); }
        SEAM(2);
    }
    if (IN(3)) { PHASE_LOCAL_IDS;
        { pg8::Gemm g{(const bf16*)(ws + WS_CQN), (const bf16*)(ws + WS_WUQ), S, 1536, 512}; pg8::StaticOrder so; so.init(S, 1536, G, (int)blockIdx.x);
          pg8::EpiQRope E{(bf16*)(ws + WS_QB), (const float*)(ws + WS_ROPE)};
          pg8::gemm_phase<pg8::EpiQRope, pg8::StaticOrder, true, true>(ldsl, g, so, E); }
        __syncthreads();
        { pg8::Gemm g{(const bf16*)(ws + WS_CKVN), (const bf16*)(ws + WS_WUKV), S, 2048, 512}; pg8::StaticOrder so; so.init(S, 2048, G, (int)blockIdx.x);
          pg8::EpiKV E{(bf16*)(ws + WS_KF)};
          pg8::gemm_phase<pg8::EpiKV, pg8::StaticOrder, true, true>(ldsl, g, so, E); }
        SEAM(3);
    }
    if (IN(4)) { PHASE_LOCAL_IDS;
        const int nit = (vcu < 256) ? (256 - vcu + G - 1) / G : 0;
        { volatile LAS unsigned* slot = (volatile LAS unsigned*)(ldsl + LDSCTL_OFF);
          const int nb = build_list<0>(ldsl, slot, (const float*)(ws + WS_STATA), nullptr, SCALE_A, vcu, G, tid);
          DecAL d{(const bf16*)(ws + WS_PROJ0), (bf16*)(ws + WS_OA), (volatile LAS unsigned*)(ldsl + KEYS_OFF)}; att::stream_dyn<BodyA, DecAL>((char*)lds, nb, (unsigned*)(ctl + CW_QA), slot, d, SCALE_A); }
        __syncthreads();
        { DecB d{(const bf16*)(ws + WS_QB), (const bf16*)(ws + WS_KF), (bf16*)(ws + WS_MIX), vcu, G}; att::stream<BodyB, DecB>((char*)lds, 2 * nit, d, SCALE_B); }
        SEAM(4);
    }
    if (IN(5)) { PHASE_LOCAL_IDS;
        const float a1 = wave_sum(args.in[I_EV_LQ1][lane] * args.in[I_EV_LK1][lane]), a2 = wave_sum(args.in[I_EV_LQ2][lane] * args.in[I_EV_LK2][lane]);
        const float lam = expf(a1) - expf(a2) + 0.2f;
        const bf16* OA = (const bf16*)(ws + WS_OA); bf16* MIX = (bf16*)(ws + WS_MIX); const int h = lane >> 3, d0 = (lane & 7) * 16;
        f32x4 sg[4];
#pragma unroll
        for (int q = 0; q < 4; ++q) sg[q] = *(const GAS f32x4*)(args.in[I_EV_SUBLN] + d0 + 4 * q) * 0.8f;
        for (int m = gw; m < S; m += NGW) { const bf16* p0 = OA + (size_t)m * 2048 + (2 * h) * 128 + d0; f32x4 d[4]; float ss = 0.f;
            const v4u a0 = *(const GAS v4u*)p0, a1 = *(const GAS v4u*)(p0 + 8), b0 = *(const GAS v4u*)(p0 + 128), b1 = *(const GAS v4u*)(p0 + 136);
            d[0] = (f32x4){bflo(a0.x) - lam * bflo(b0.x), bfhi(a0.x) - lam * bfhi(b0.x), bflo(a0.y) - lam * bflo(b0.y), bfhi(a0.y) - lam * bfhi(b0.y)};
            d[1] = (f32x4){bflo(a0.z) - lam * bflo(b0.z), bfhi(a0.z) - lam * bfhi(b0.z), bflo(a0.w) - lam * bflo(b0.w), bfhi(a0.w) - lam * bfhi(b0.w)};
            d[2] = (f32x4){bflo(a1.x) - lam * bflo(b1.x), bfhi(a1.x) - lam * bfhi(b1.x), bflo(a1.y) - lam * bflo(b1.y), bfhi(a1.y) - lam * bfhi(b1.y)};
            d[3] = (f32x4){bflo(a1.z) - lam * bflo(b1.z), bfhi(a1.z) - lam * bfhi(b1.z), bflo(a1.w) - lam * bflo(b1.w), bfhi(a1.w) - lam * bfhi(b1.w)};
#pragma unroll
            for (int q = 0; q < 4; ++q) ss += (d[q].x * d[q].x + d[q].y * d[q].y) + (d[q].z * d[q].z + d[q].w * d[q].w);
            ss += __shfl_xor(ss, 1); ss += __shfl_xor(ss, 2); ss += __shfl_xor(ss, 4);
            const float rstd = 1.0f / sqrtf(ss * (1.f / 128.f) + 1e-5f);
            v4u o0, o1; { const f32x4 y0 = d[0] * rstd * sg[0], y1 = d[1] * rstd * sg[1], y2 = d[2] * rstd * sg[2], y3 = d[3] * rstd * sg[3];
              o0.x = pk2(y0.x, y0.y); o0.y = pk2(y0.z, y0.w); o0.z = pk2(y1.x, y1.y); o0.w = pk2(y1.z, y1.w); o1.x = pk2(y2.x, y2.y); o1.y = pk2(y2.z, y2.w); o1.z = pk2(y3.x, y3.y); o1.w = pk2(y3.z, y3.w); }
            GAS v4u* dst = (GAS v4u*)(MIX + (size_t)m * 2048 + h * 128 + d0); dst[0] = o0; dst[1] = o1; }
        SEAM(5);
    }
    if (IN(6)) { PHASE_LOCAL_IDS;
        pg8::Gemm g{(const bf16*)(ws + WS_MIX), (const bf16*)(ws + WS_WOUT0), S, DM, DM}; pg8::StaticOrder so; so.init(S, DM, G, (int)blockIdx.x);
        pg8::EpiResB<true> E{args.in[I_X], HB, (float*)(ws + WS_PS), DM};
        pg8::gemm_phase<pg8::EpiResB<true>, pg8::StaticOrder, true, true>(ldsl, g, so, E);
        SEAM(6);
    }
    if (IN(7)) { PHASE_LOCAL_IDS;
        rows_i8(HB, (const float*)(ws + WS_PS), (float*)(ws + WS_RSTD), ws + WS_A8, (float*)(ws + WS_RSTDS), ((const float*)(ws + WS_SCL))[1] * (1.f / 127.f), gw, NGW, lane);
        SEAM(7);
    }
    if (IN(8)) { PHASE_LOCAL_IDS;
        pg8::Gemm g{(const bf16*)(ws + WS_A8), (const bf16*)(ws + WS_WGU0), S, 2 * FF, DM / 2, DM / 2}; pg8::StaticOrder so; so.init(S, 2 * FF, G, (int)blockIdx.x);
        pg8::EpiSwiGLU<false> E{(bf16*)(ws + WS_HMID0), FF, 2 * FF / 256, (const float*)(ws + WS_RSTDS), 1.f};
        pg8::gemm_phase<pg8::EpiSwiGLU<false>, pg8::StaticOrder, true, true, 2>(ldsl, g, so, E);
        SEAM(8);
    }
    if (IN(9)) { PHASE_LOCAL_IDS;
        pg8::Gemm g{(const bf16*)(ws + WS_HMID0), (const bf16*)(ws + WS_WD0), S, DM, FF}; pg8::StaticOrder so; so.init(S, DM, G, (int)blockIdx.x);
        pg8::EpiResB<false> E{nullptr, HB, (float*)(ws + WS_PS), DM};
        pg8::gemm_phase<pg8::EpiResB<false>, pg8::StaticOrder, true, true>(ldsl, g, so, E);
        SEAM(9);
    }
    if (IN(10)) { PHASE_LOCAL_IDS;
        rows_i8(HB, (const float*)(ws + WS_PS), (float*)(ws + WS_RSTD), ws + WS_A8, (float*)(ws + WS_RSTDS), ((const float*)(ws + WS_SCL))[2] * (1.f / 127.f), gw, NGW, lane);
        SEAM(10);
    }
    if (IN(11)) { PHASE_LOCAL_IDS;
        { pg8::Gemm g{(const bf16*)(ws + WS_A8), (const bf16*)(ws + WS_WIN1), S, 6144, DM / 2, DM / 2}; pg8::StaticOrder so; so.init(S, 6144, G, (int)blockIdx.x);
          pg8::EpiBf16Row E{(bf16*)(ws + WS_QKV1), 6144, (const float*)(ws + WS_RSTDS)};
          pg8::gemm_phase<pg8::EpiBf16Row, pg8::StaticOrder, true, true, 2>(ldsl, g, so, E); }
        __syncthreads();
        { pg8::Gemm g{(const bf16*)(ws + WS_XN), (const bf16*)(ws + WS_WIN1), S, 256, 512, DM}; pg8::SplitKOrder so{G, (int)blockIdx.x, 24, 1024};
          pg8::EpiPartF32 E{(float*)(ws + WS_FPART), 16, 1024, S, (const float*)(ws + WS_RSTD)};
          pg8::gemm_phase<pg8::EpiPartF32, pg8::SplitKOrder, true, true>(ldsl, g, so, E); }
        SEAM(11);
    }
    if (IN(12)) { PHASE_LOCAL_IDS;
        float* logf = (float*)(ws + WS_LOGF); float* csum = (float*)(ws + WS_CSUM); LAS float* red = (LAS float*)ldsl;
        const bf16* qkv = (const bf16*)(ws + WS_QKV1); float* statC = (float*)(ws + WS_STATC); LAS float* sm = red + 1024;
        for (int c = (int)blockIdx.x; c < 256; c += G) { const int r = tid >> 4, h = tid & 15;
            { const float* fp = (const float*)(ws + WS_FPART); const size_t kq = (size_t)S * 16; const float fb = args.in[I_OD_FBIAS][h]; float lsum = 0.f;
#pragma unroll
              for (int rr = 0; rr < 2; ++rr) { const size_t o = (size_t)(64 * c + 32 * rr + r) * 16 + h; const float x = ((fp[o] + fp[o + kq]) + (fp[o + 2 * kq] + fp[o + 3 * kq])) + fb;
                  const float ls = fminf(x, 0.f) - log1pf(__expf(-fabsf(x))); logf[o] = ls; lsum += ls; }
              red[r * 16 + h] = lsum; }
            float qmax = 0.f, kmax = 0.f;
            for (int i = 0; i < 8; ++i) { const bf16* prow = qkv + (size_t)(64 * c + 8 * wave + i) * 6144 + 32 * lane; float sq = 0.f, sk = 0.f;
#pragma unroll
                for (int j = 0; j < 4; ++j) { const v4u a = *(const GAS v4u*)(prow + 8 * j), b = *(const GAS v4u*)(prow + 2048 + 8 * j);
#pragma unroll
                    for (int e = 0; e < 4; ++e) { sq += bflo(a[e]) * bflo(a[e]) + bfhi(a[e]) * bfhi(a[e]); sk += bflo(b[e]) * bflo(b[e]) + bfhi(b[e]) * bfhi(b[e]); } }
                sq += __shfl_xor(sq, 1); sq += __shfl_xor(sq, 2); sk += __shfl_xor(sk, 1); sk += __shfl_xor(sk, 2); qmax = fmaxf(qmax, sq); kmax = fmaxf(kmax, sk); }
            if ((lane & 3) == 0) { sm[wave * 32 + (lane >> 2)] = qmax; sm[wave * 32 + 16 + (lane >> 2)] = kmax; }
            __syncthreads();
            if (tid < 16) { float s = 0.f; for (int q = 0; q < 32; ++q) s += red[q * 16 + tid]; csum[c * 16 + tid] = s; }
            if (tid < 32) { float v = 0.f; for (int q = 0; q < 8; ++q) v = fmaxf(v, sm[q * 32 + tid]); statC[c * 32 + tid] = v; }
            __syncthreads(); }
        SEAM(12);
    }
    if (IN(13)) { PHASE_LOCAL_IDS;
        const float* logf = (const float*)(ws + WS_LOGF); const float* csum = (const float*)(ws + WS_CSUM); float* kbC = (float*)(ws + WS_KBC);
        LAS float* red = (LAS float*)ldsl; LAS float* pre = red + 512; LAS float* val = red + 1024;
        for (int c = (int)blockIdx.x; c < 256; c += G) { const int part = tid >> 4, h = tid & 15;
            { float s = 0.f; for (int cc = part; cc < c; cc += 32) s += csum[cc * 16 + h]; red[part * 16 + h] = s; }
            val[tid] = logf[(size_t)(64 * c) * 16 + tid]; val[512 + tid] = logf[(size_t)(64 * c) * 16 + 512 + tid];
            __syncthreads();
            if (tid < 16) { float s = 0.f; for (int q = 0; q < 32; ++q) s += red[q * 16 + tid]; pre[tid] = s; }
            __syncthreads();
            if (tid < 16) { float run = pre[tid]; for (int r = 0; r < 64; ++r) { run += val[r * 16 + tid]; val[r * 16 + tid] = run; } }
            __syncthreads();
            { const int r = tid & 63, hh = tid >> 6; kbC[(size_t)hh * S + 64 * c + r] = val[r * 16 + hh] * (-1.0f / SCALE_C); kbC[(size_t)(hh + 8) * S + 64 * c + r] = val[r * 16 + hh + 8] * (-1.0f / SCALE_C); }
            __syncthreads(); }
        SEAM(13);
    }
    if (IN(14)) { PHASE_LOCAL_IDS;
        volatile LAS unsigned* slot = (volatile LAS unsigned*)(ldsl + LDSCTL_OFF);
        const int nb = build_list<1>(ldsl, slot, (const float*)(ws + WS_STATC), (const float*)(ws + WS_KBC), SCALE_C, vcu, G, tid);
        DecCL d{(const bf16*)(ws + WS_QKV1), (bf16*)(ws + WS_O1), (const float*)(ws + WS_KBC), (volatile LAS unsigned*)(ldsl + KEYS_OFF)}; att::stream_dyn<BodyC, DecCL>((char*)lds, nb, (unsigned*)(ctl + CW_QC), slot, d, SCALE_C);
        SEAM(14);
    }
    if (IN(15)) { PHASE_LOCAL_IDS;
        pg8::Gemm g{(const bf16*)(ws + WS_O1), (const bf16*)(ws + WS_WOUT1), S, DM, DM}; pg8::StaticOrder so; so.init(S, DM, G, (int)blockIdx.x);
        pg8::EpiResB<false> E{nullptr, HB, (float*)(ws + WS_PS), DM};
        pg8::gemm_phase<pg8::EpiResB<false>, pg8::StaticOrder, true, true>(ldsl, g, so, E);
        SEAM(15);
    }
    if (IN(16)) { PHASE_LOCAL_IDS;
        LAS float* rt = (LAS float*)ldsl; LAS unsigned* cnt = (LAS unsigned*)(ldsl + 65536);
        for (int idx = tid; idx < DM * NE; idx += NWAVES * 64) { const int k = idx >> 3, e = idx & 7; rt[e * DM + k] = args.in[I_OD_ROUTER][idx]; }
        __syncthreads();
        const GAS f32x4* gr = (const GAS f32x4*)args.in[I_OD_FFN_NORM] + lane;
        for (int c = (int)blockIdx.x; c < 256; c += G) {
            if (tid < 8) cnt[tid] = 0u;
            __syncthreads();
            for (int i = 0; i < 8; ++i) { const int row = 64 * c + 8 * wave + i;
                const GAS v2u* xr = (const GAS v2u*)(HB + (size_t)row * DM) + lane; f32x4 v[8]; float s = 0.f;
#pragma unroll
                for (int j = 0; j < 8; ++j) { const v2u a = xr[64 * j]; v[j] = (f32x4){bflo(a.x), bfhi(a.x), bflo(a.y), bfhi(a.y)}; s += (v[j].x * v[j].x + v[j].y * v[j].y) + (v[j].z * v[j].z + v[j].w * v[j].w); }
                const float rstd = 1.0f / sqrtf(wave_sum(s) * (1.f / DM) + 1e-6f);
#pragma unroll
                for (int j = 0; j < 8; ++j) { const f32x4 gg = gr[64 * j]; v[j] = (v[j] * rstd) * gg; }
                if (lane == 0) ((float*)(ws + WS_RSTD))[row] = rstd;
                float lg[8];
#pragma unroll
                for (int e = 0; e < 8; ++e) { float a = 0.f;
#pragma unroll
                    for (int j = 0; j < 8; ++j) { const f32x4 w = *(const LAS f32x4*)(rt + e * DM + 4 * lane + 256 * j); a += (v[j].x * w.x + v[j].y * w.y) + (v[j].z * w.z + v[j].w * w.w); }
                    lg[e] = wave_sum(a); }
                int e1 = 0; float l1 = lg[0];
#pragma unroll
                for (int e = 1; e < 8; ++e) if (lg[e] > l1) { l1 = lg[e]; e1 = e; }
                int e2 = -1; float l2 = -__builtin_inff();
#pragma unroll
                for (int e = 0; e < 8; ++e) if (e != e1 && lg[e] > l2) { l2 = lg[e]; e2 = e; }
                const float g1 = 1.0f / (1.0f + expf(l2 - l1)), g2 = 1.0f - g1;
                if (lane == 0) { *(GAS v4u*)(ws + WS_ROUTE + (size_t)row * 16) = (v4u){(unsigned)e1, (unsigned)e2, __builtin_bit_cast(unsigned, g1), __builtin_bit_cast(unsigned, g2)};
                    __hip_atomic_fetch_add(cnt + e1, 1u, __ATOMIC_RELAXED, __HIP_MEMORY_SCOPE_WORKGROUP); __hip_atomic_fetch_add(cnt + e2, 1u, __ATOMIC_RELAXED, __HIP_MEMORY_SCOPE_WORKGROUP); } }
            __syncthreads();
            if (tid < 8) ((unsigned*)(ws + WS_CNTG))[c * 8 + tid] = cnt[tid];
            __syncthreads(); }
        SEAM(16);
    }
    if (IN(17)) { PHASE_LOCAL_IDS;
        const unsigned* cntg = (const unsigned*)(ws + WS_CNTG); LAS unsigned* red = (LAS unsigned*)ldsl; LAS unsigned* red2 = red + 512; LAS unsigned* T = red + 1024; LAS unsigned* P = red + 1032;
        LAS unsigned* st = red + 1040; LAS unsigned* rl = red + 1056; LAS unsigned* posl = red + 1056 + 256;
        bf16* As = (bf16*)(ws + WS_AS); float* gates = (float*)(ws + WS_GATES); unsigned* tokpos = (unsigned*)(ws + WS_TOKPOS);
        const float gsc = 1.0f / (((const float*)(ws + WS_SCL))[4] * H8_SCALE);
        const float wsc1 = ((const float*)(ws + WS_SCL))[3] * (1.f / 127.f);
        for (int c = (int)blockIdx.x; c < 256; c += G) {
            { const int e = tid & 7, part = tid >> 3; unsigned tot = 0u, pre = 0u; for (int cc = part; cc < 256; cc += 64) { const unsigned x = cntg[cc * 8 + e]; tot += x; if (cc < c) pre += x; } red[part * 8 + e] = tot; red2[part * 8 + e] = pre; }
            if (tid < 64) { const v4u r = *(const GAS v4u*)(ws + WS_ROUTE + (size_t)(64 * c + tid) * 16); rl[tid * 4 + 0] = r.x; rl[tid * 4 + 1] = r.y; rl[tid * 4 + 2] = r.z; rl[tid * 4 + 3] = r.w; }
            __syncthreads();
            if (tid < 8) { unsigned a = 0u, b = 0u; for (int q = 0; q < 64; ++q) { a += red[q * 8 + tid]; b += red2[q * 8 + tid]; } T[tid] = a; P[tid] = b; }
            __syncthreads();
            if (tid < 8) { unsigned s0 = 0u; for (int e = 0; e < tid; ++e) s0 += (T[e] + 255u) & ~255u; st[tid] = s0;
                unsigned run = s0 + P[tid]; for (int r = 0; r < 64; ++r) { if (rl[r * 4 + 0] == (unsigned)tid) posl[r * 2 + 0] = run++; if (rl[r * 4 + 1] == (unsigned)tid) posl[r * 2 + 1] = run++; }
                if (c == 0) ((unsigned*)(ws + WS_TOT))[tid] = T[tid]; }
            __syncthreads();
            for (int i = 0; i < 8; ++i) { const int r = 8 * wave + i, row = 64 * c + r; const GAS v4u* src = (const GAS v4u*)((const bf16*)(ws + WS_XN) + (size_t)row * DM) + lane;
                const v4u x[4] = {src[0], src[64], src[128], src[192]}; const float rs = ((const float*)(ws + WS_RSTD))[row];
                float am = 0.f;
#pragma unroll
                for (int j = 0; j < 4; ++j) { am = fmaxf(am, fmaxf(fmaxf(fabsf(bflo(x[j].x)), fabsf(bfhi(x[j].x))), fmaxf(fabsf(bflo(x[j].y)), fabsf(bfhi(x[j].y))))); am = fmaxf(am, fmaxf(fmaxf(fabsf(bflo(x[j].z)), fabsf(bfhi(x[j].z))), fmaxf(fabsf(bflo(x[j].w)), fabsf(bfhi(x[j].w))))); }
#pragma unroll
                for (int o = 32; o > 0; o >>= 1) am = fmaxf(am, __shfl_xor(am, o));
                am = fmaxf(am, 1e-30f); const float qs = 127.f / am, rowf = (am * (1.f / 127.f)) * rs * wsc1;
                v2u q[4];
#pragma unroll
                for (int j = 0; j < 4; ++j) { q[j].x = pki8x4(bflo(x[j].x) * qs, bfhi(x[j].x) * qs, bflo(x[j].y) * qs, bfhi(x[j].y) * qs); q[j].y = pki8x4(bflo(x[j].z) * qs, bfhi(x[j].z) * qs, bflo(x[j].w) * qs, bfhi(x[j].w) * qs); }
                const v2u q0 = q[0], q1 = q[1], q2 = q[2], q3 = q[3];
#pragma unroll
                for (int sl = 0; sl < 2; ++sl) { const unsigned p = posl[r * 2 + sl]; GAS v2u* dst = (GAS v2u*)((unsigned char*)As + (size_t)p * DM) + lane; dst[0] = q0; dst[64] = q1; dst[128] = q2; dst[192] = q3;
                    if (lane == 0) { gates[p] = __builtin_bit_cast(float, rl[r * 4 + 2 + sl]) * gsc; tokpos[row * 2 + sl] = p; ((float*)(ws + WS_RSTDS))[p] = rowf;   } } }
            { const unsigned e = (unsigned)wave, te = T[e], pad = ((te + 255u) & ~255u) - te;
              if ((unsigned)c < pad) { const unsigned p = st[e] + te + (unsigned)c; GAS v2u* dst = (GAS v2u*)((unsigned char*)As + (size_t)p * DM) + lane; const v2u z = (v2u){0u, 0u}; dst[0] = z; dst[64] = z; dst[128] = z; dst[192] = z; if (lane == 0) { gates[p] = 0.f; ((float*)(ws + WS_RSTDS))[p] = 0.f; } } }
            __syncthreads(); }
        SEAM(17);
    }
    if (IN(18)) { PHASE_LOCAL_IDS;
        pg8::Gemm g{(const bf16*)(ws + WS_AS), (const bf16*)(ws + WS_WGU1), MPAD, NE * 2 * FF, DM / 2, DM / 2}; pg8::GroupedOrder so; so.init((const unsigned*)(ws + WS_TOT), 2 * FF / 256, G, (int)blockIdx.x);
        pg8::EpiSwiGLU<true> E{(bf16*)(ws + WS_HMS), FF, 2 * FF / 256, (const float*)(ws + WS_RSTDS), H8_SCALE};
        pg8::gemm_phase<pg8::EpiSwiGLU<true>, pg8::GroupedOrder, true, true, 2>(ldsl, g, so, E);
        SEAM(18);
    }
    if (IN(19)) { PHASE_LOCAL_IDS;
        pg8::GroupedOrder so; so.init((const unsigned*)(ws + WS_TOT), DM / 256, G, (int)blockIdx.x);
        const int full = (so.nwg / G) * G, left = so.nwg - full; const bool halves = left > 0 && 2 * left <= G;
        if (halves) so.hi = full;
        { pg8::Gemm g{(const bf16*)(ws + WS_HMS), (const bf16*)(ws + WS_WD1), MPAD, NE * DM, FF / 2, FF / 2};
          pg8::EpiMoEDown E{(bf16*)(ws + WS_YS), (const float*)(ws + WS_GATES), DM / 256};
          pg8::gemm_phase<pg8::EpiMoEDown, pg8::GroupedOrder, true, true, 1>(ldsl, g, so, E); }
        if (halves) { __syncthreads();
          pg8::Gemm g{(const bf16*)(ws + WS_HMS), (const bf16*)(ws + WS_WD1), MPAD, NE * DM, FF / 4, FF / 2};
          pg8::GroupedSplitOrder<1> ss{so, full, 2 * left, FF / 2};
          pg8::EpiMoEDownPart E{(float*)(ws + WS_PART), (unsigned*)(ctl + CW_SPLIT), DM / 256, FF / 2};
          pg8::gemm_phase<pg8::EpiMoEDownPart, pg8::GroupedSplitOrder<1>, true, true, 1>(ldsl, g, ss, E); }
        SEAM(19);
    }
    if (IN(20)) { PHASE_LOCAL_IDS;
        const bf16* Y = (const bf16*)(ws + WS_YS); const unsigned* split = (const unsigned*)(ctl + CW_SPLIT); const float* PART = (const float*)(ws + WS_PART); const float* gates = (const float*)(ws + WS_GATES); const unsigned* tokpos = (const unsigned*)(ws + WS_TOKPOS); const GAS f32x4* gr = (const GAS f32x4*)args.in[I_FINAL_NORM] + lane;
        unsigned bad = __hip_atomic_load(ctl + CW_TMO, RLX_AGENT) | __hip_atomic_load(ctl + CW_BAR + XB_TMO, RLX_AGENT);
        for (int m = gw; m < S; m += NGW) { const unsigned p0 = tokpos[m * 2], p1 = tokpos[m * 2 + 1];
            GAS f32x4* xo = (GAS f32x4*)(args.out + (size_t)m * DM) + lane; const GAS v2u* hr = (const GAS v2u*)(HB + (size_t)m * DM) + lane; const GAS v2u* y0 = (const GAS v2u*)(Y + (size_t)p0 * DM) + lane; const GAS v2u* y1 = (const GAS v2u*)(Y + (size_t)p1 * DM) + lane;
            f32x4 v[8]; float s = 0.f;
            const v4u fa = *(const GAS v4u*)(split + (p0 >> 8) * 8), fb = *(const GAS v4u*)(split + (p0 >> 8) * 8 + 4), fc = *(const GAS v4u*)(split + (p1 >> 8) * 8), fd = *(const GAS v4u*)(split + (p1 >> 8) * 8 + 4);
            const unsigned anysplit = (fa.x | fa.y | fa.z | fa.w) | (fb.x | fb.y | fb.z | fb.w) | (fc.x | fc.y | fc.z | fc.w) | (fd.x | fd.y | fd.z | fd.w);
            if (__builtin_expect(anysplit == 0u, 1)) {
#pragma unroll
                for (int j = 0; j < 8; ++j) { const v2u a = y0[64 * j], b = y1[64 * j], hh = hr[64 * j]; v[j] = (f32x4){(bflo(hh.x) + bflo(a.x)) + bflo(b.x), (bfhi(hh.x) + bfhi(a.x)) + bfhi(b.x), (bflo(hh.y) + bflo(a.y)) + bflo(b.y), (bfhi(hh.y) + bfhi(a.y)) + bfhi(b.y)}; }
            } else {
#pragma unroll
                for (int j = 0; j < 8; ++j) { f32x4 add = (f32x4){0.f, 0.f, 0.f, 0.f};
#pragma unroll
                    for (int sl = 0; sl < 2; ++sl) { const unsigned p = sl ? p1 : p0; const unsigned xs = split[(p >> 8) * 8 + j];
                        if (xs) { const GAS f32x4* q = (const GAS f32x4*)(PART + ((size_t)(xs - 1u) << 18) + (size_t)(p & 255u) * 256) + lane; add = add + (q[0] + q[16384]) * gates[p]; }
                        else { const v2u a = (sl ? y1 : y0)[64 * j]; add = add + (f32x4){bflo(a.x), bfhi(a.x), bflo(a.y), bfhi(a.y)}; } }
                    { const v2u hh = hr[64 * j]; v[j] = (f32x4){bflo(hh.x), bfhi(hh.x), bflo(hh.y), bfhi(hh.y)} + add; } }
            }
#pragma unroll
            for (int j = 0; j < 8; ++j) s += (v[j].x * v[j].x + v[j].y * v[j].y) + (v[j].z * v[j].z + v[j].w * v[j].w);
            float rstd = 1.0f / sqrtf(wave_sum(s) * (1.f / DM) + 1e-6f); if (bad) rstd = __builtin_nanf("");
#pragma unroll
            for (int j = 0; j < 8; ++j) xo[64 * j] = (v[j] * rstd) * gr[64 * j]; }
    }
#undef IN
#undef SEAM
#undef GRID_BAR
}

extern "C" void kernel_launch(void* const* d_in, const int* in_sizes, int n_in, void* d_out, int out_size, void* d_ws, size_t ws_size, hipStream_t stream) {
    static int grid = 0;
    if (grid == 0) {
        if (n_in != 27 || in_sizes[0] != S * DM || out_size != S * DM || ws_size < WS_END) { fprintf(stderr, "kernel_launch: shape/workspace mismatch (n_in %d, in0 %d, out %d, ws %zu, need %zu); nothing launched\n", n_in, n_in > 0 ? in_sizes[0] : -1, out_size, ws_size, (size_t)WS_END); grid = -1; return; }
        int dev = 0, cus = 0, per_cu = 0;
        if (hipGetDevice(&dev) != hipSuccess || hipDeviceGetAttribute(&cus, hipDeviceAttributeMultiprocessorCount, dev) != hipSuccess) { fprintf(stderr, "kernel_launch: device query failed\n"); grid = -1; return; }
        if (hipFuncSetAttribute((const void*)mk_fwd, hipFuncAttributeMaxDynamicSharedMemorySize, LDS_BYTES) != hipSuccess) { fprintf(stderr, "kernel_launch: hipFuncSetAttribute failed\n"); grid = -1; return; }
        if (hipOccupancyMaxActiveBlocksPerMultiprocessor(&per_cu, (const void*)mk_fwd, NWAVES * 64, LDS_BYTES) != hipSuccess || per_cu < 1) fprintf(stderr, "kernel_launch: note: occupancy query reports %d workgroups per CU\n", per_cu);
        (void)hipGetLastError();
        grid = cus;
    }
    if (grid < 0) return;
    if (hipMemsetAsync((char*)d_ws + WS_CTL, 0, CTL_ZERO_BYTES, stream) != hipSuccess) { fprintf(stderr, "kernel_launch: hipMemsetAsync failed\n"); return; }
    Args a{};
    for (int i = 0; i < 27; ++i) a.in[i] = (const float*)d_in[i];
    a.out = (float*)d_out; a.ws = (unsigned char*)d_ws;
#if MK_PER_PHASE
#ifndef MK_PROBE_MASK
#define MK_PROBE_MASK 0
#endif
    for (int p = 0; p < NPH; ++p) { a.ph_lo = p; a.ph_hi = p + 1; const int reps = ((MK_PROBE_MASK >> p) & 1) ? 5 : 1;
        for (int r = 0; r < reps; ++r) hipLaunchKernelGGL(mk_fwd, dim3(grid), dim3(NWAVES * 64), LDS_BYTES, stream, a); }
#else
    a.ph_lo = 0; a.ph_hi = NPH; hipLaunchKernelGGL(mk_fwd, dim3(grid), dim3(NWAVES * 64), LDS_BYTES, stream, a);
#endif
    const hipError_t le = hipPeekAtLastError();
    if (le != hipSuccess) fprintf(stderr, "kernel_launch: launch failed: %s\n", hipGetErrorName(le));
}
```

```cpp
#include <hip/hip_runtime.h>
#include <cstdio>
#include <cstdint>
namespace pg8 {
#define PG8_LAS __attribute__((address_space(3)))
typedef unsigned short bf16_t;
typedef short bf16x8 __attribute__((ext_vector_type(8)));
typedef float f32x4 __attribute__((ext_vector_type(4)));
typedef unsigned u32x4 __attribute__((ext_vector_type(4)));
typedef int i32x4 __attribute__((ext_vector_type(4)));
typedef int i32x8 __attribute__((ext_vector_type(8)));
constexpr int BM = 256, BK = 64, HALF = 128, HTB = HALF * BK * 2  , STAGE_BYTES = 8 * HTB, NXCD = 8, WGM = 4;

__host__ __device__ __forceinline__ int lds_byte(int r, int c) { const int st = (r >> 4) * 2 + (c >> 5), rr = r & 15, cc = c & 31, ob = rr * 64 + cc * 2; return st * 1024 + (ob ^ (((ob >> 9) & 1) << 5)); }
__host__ __device__ __forceinline__ void stage_rc(int b, int& R, int& C) { const int st = b / 1024, sb = b % 1024, swz = sb ^ (((sb >> 9) & 1) << 5); R = (st >> 1) * 16 + swz / 64; C = (st & 1) * 32 + (swz % 64) / 2; }
__host__ __device__ __forceinline__ int perm32(int rho) { const int n = rho >> 4, i = rho & 15; return 8 * (i >> 2) + 4 * n + (i & 3); }

struct Unit { int pm, pn, ko, aux; };
struct Gemm { const bf16_t* A; const bf16_t* Bt; int M, N, K, ld; };

struct StaticOrder {
    int nM, nN, nwg, G, c;
    __host__ __device__ void init(int M, int N, int G_, int c_) { nM = M / BM; nN = N / BM; nwg = nM * nN; G = G_; c = c_; }
    __host__ __device__ bool next(int i, Unit& u) const {
        const long L = (long)i * G + c; if (L >= nwg) return false;
        int wgid = (int)L; { const int q = nwg / NXCD, r = nwg % NXCD, xcd = wgid % NXCD, off = wgid / NXCD; wgid = (xcd < r ? xcd * (q + 1) : r * (q + 1) + (xcd - r) * q) + off; }
        const int nig = WGM * nN, gid = wgid / nig, fm = gid * WGM, gsz = (nM - fm) < WGM ? (nM - fm) : WGM;
        u.pm = fm + ((wgid % nig) % gsz); u.pn = (wgid % nig) / gsz; return true;
    }
    __device__ __forceinline__ void a_ready(const Unit&) const {}
    __device__ __forceinline__ void done(const Unit&) const {}
};

__device__ __forceinline__ float sat8(float x) { return __builtin_amdgcn_fmed3f(x, -448.f, 448.f); }
__device__ __forceinline__ unsigned pk8x4(float a, float b, float c, float d) { int w = __builtin_amdgcn_cvt_pk_fp8_f32(sat8(a), sat8(b), 0, false); w = __builtin_amdgcn_cvt_pk_fp8_f32(sat8(c), sat8(d), w, true); return (unsigned)w; }
__device__ __forceinline__ unsigned cvt_pk_bf16(float lo, float hi) { unsigned r; asm volatile("v_cvt_pk_bf16_f32 %0, %1, %2" : "=v"(r) : "v"(lo), "v"(hi)); return r; }
typedef float f32x2 __attribute__((ext_vector_type(2)));
__device__ __forceinline__ f32x2 gelu_pk(f32x2 v) {
    const f32x2 av = __builtin_elementwise_abs(v), d = av * 0.2316418882f + 1.0f;
    f32x2 t; t.x = __builtin_amdgcn_rcpf(d.x); t.y = __builtin_amdgcn_rcpf(d.y);
    f32x2 q = t * 0.5307027145f + (-0.7265760135f); q = q * t + 0.7107068705f; q = q * t + (-0.142248368f); q = q * t + 0.127414796f; q = q * t;
    const f32x2 s = (v * v) * (-0.72134752044f);
    f32x2 e; e.x = __builtin_amdgcn_exp2f(s.x); e.y = __builtin_amdgcn_exp2f(s.y);
    const f32x2 m = v * (q * e), r = v - m;
    f32x2 o; o.x = v.x < 0.f ? m.x : r.x; o.y = v.y < 0.f ? m.y : r.y; return o;
}

template <int ACT  > struct EpiBf16 {
    static constexpr bool PERM = true, AFTER_DRAIN = false; static_assert(ACT == 0 || ACT == 1, "EpiBf16: ACT is 0 (none) or 1 (gelu_pk)");
    bf16_t* O; int ldc; const float* bias; int split_cols; size_t split_stride; float scale0;
    __device__ __forceinline__ void operator()(const f32x4 (&acc)[2][2][4][2], const Unit& u, int wr, int wc, int fr, int fq) const {
        const int row0 = u.pm * BM + wr * 64 + fr; int colt = u.pn * BM; bf16_t* base = O;
        float sc = 1.f; if (split_cols) { const int t = colt / split_cols; base += (size_t)t * split_stride; colt -= t * split_cols; if (t == 0) sc = scale0; }
        const int col0 = colt + wc * 32 + 8 * fq, bcol0 = u.pn * BM + wc * 32 + 8 * fq;
        f32x4 bv[2][2];
#pragma unroll
        for (int bj = 0; bj < 2; ++bj)
#pragma unroll
            for (int n = 0; n < 2; ++n) bv[bj][n] = bias ? *(const f32x4*)(bias + bcol0 + bj * HALF + 4 * n) : (f32x4){0.f, 0.f, 0.f, 0.f};
#pragma unroll
        for (int ai = 0; ai < 2; ++ai)
#pragma unroll
            for (int m = 0; m < 4; ++m) { bf16_t* rowp = base + (size_t)(row0 + ai * HALF + m * 16) * ldc + col0;
#pragma unroll
                for (int bj = 0; bj < 2; ++bj) { f32x4 v0 = acc[ai][bj][m][0] + bv[bj][0], v1 = acc[ai][bj][m][1] + bv[bj][1];
                    if (ACT == 1) { f32x2 a = gelu_pk((f32x2){v0[0], v0[1]}), b = gelu_pk((f32x2){v0[2], v0[3]}), c = gelu_pk((f32x2){v1[0], v1[1]}), d = gelu_pk((f32x2){v1[2], v1[3]});
                        v0 = (f32x4){a.x, a.y, b.x, b.y}; v1 = (f32x4){c.x, c.y, d.x, d.y}; }
                    v0 = v0 * sc; v1 = v1 * sc; u32x4 w; w.x = cvt_pk_bf16(v0[0], v0[1]); w.y = cvt_pk_bf16(v0[2], v0[3]); w.z = cvt_pk_bf16(v1[0], v1[1]); w.w = cvt_pk_bf16(v1[2], v1[3]);
                    *(u32x4*)(rowp + bj * HALF) = w; } }
    }
};

template <class Epi, class Sched, bool ALIGN_EPI = false, bool SP2 = false, int QM = 0>
__device__ __forceinline__ void gemm_phase(PG8_LAS unsigned char* lds, const Gemm g, const Sched& S, const Epi& E) {
    constexpr bool F8 = (QM == 1), I8 = (QM == 2);
    const int tid = threadIdx.x, wid = __builtin_amdgcn_readfirstlane(tid >> 6), lane = tid & 63, wr = wid >> 2, wc = wid & 3, fr = lane & 15, fq = lane >> 4;
    const int K = g.K, nt = K / BK, ld = g.ld ? g.ld : g.K;
    unsigned voffA[2], voffB[2];
#pragma unroll
    for (int i = 0; i < 2; ++i) { int R, C; stage_rc(tid * 16 + i * 8192, R, C); const int Rb = Epi::PERM ? ((R & ~31) + perm32(R & 31)) : R;
        voffA[i] = (unsigned)(R * ld + C) * 2u; voffB[i] = (unsigned)(Rb * ld + C) * 2u; }
    const size_t kstep = (size_t)(BK * 2);
    const size_t hstep = (size_t)HALF * ld * 2;
    const size_t tstep = 2 * hstep;
    const unsigned ldsw = (unsigned)wid * 1024u;
    const int aoff = lds_byte(wr * 64 + fr, fq * 8), boff = lds_byte(wc * 32 + fr, fq * 8);
#define PG8_SA(b, h) (((b) * 2 + (h)) * HTB)
#define PG8_SB(b, h) ((4 + (b) * 2 + (h)) * HTB)
#define PG8_STAGE(bufoff, gbase, voff) do { _Pragma("unroll") for (int _i = 0; _i < 2; ++_i) \
        __builtin_amdgcn_global_load_lds((const unsigned*)((const char*)(gbase) + (voff)[_i]), (PG8_LAS unsigned*)(lds + (bufoff) + ldsw + _i * 8192), 16, 0, 0); } while (0)
#define PG8_RD8(p_) __builtin_shufflevector(*(const PG8_LAS i32x4*)(p_), *(const PG8_LAS i32x4*)((p_) + 1024), 0, 1, 2, 3, 4, 5, 6, 7)
#define PG8_LDA(dst, b, h) do { if constexpr (F8) { _Pragma("unroll") for (int m = 0; m < 4; ++m) dst##8[m] = PG8_RD8(lds + PG8_SA(b, h) + aoff + m * 2048); }                                       \
        else { _Pragma("unroll") for (int m = 0; m < 4; ++m) _Pragma("unroll") for (int k = 0; k < 2; ++k) dst[m][k] = *(const PG8_LAS bf16x8*)(lds + PG8_SA(b, h) + aoff + m * 2048 + k * 1024); } } while (0)
#define PG8_LDB(dst, b, h) do { if constexpr (F8) { _Pragma("unroll") for (int n = 0; n < 2; ++n) dst##8[n] = PG8_RD8(lds + PG8_SB(b, h) + boff + n * 2048); }                                       \
        else { _Pragma("unroll") for (int n = 0; n < 2; ++n) _Pragma("unroll") for (int k = 0; k < 2; ++k) dst[n][k] = *(const PG8_LAS bf16x8*)(lds + PG8_SB(b, h) + boff + n * 2048 + k * 1024); } } while (0)
#define PG8_MMA(ai, bj, At, Bt) do { __builtin_amdgcn_s_setprio(1); _Pragma("unroll") for (int m = 0; m < 4; ++m) _Pragma("unroll") for (int n = 0; n < 2; ++n) {                               \
        if constexpr (F8) asm volatile("v_mfma_f32_16x16x128_f8f6f4 %0, %1, %2, %0" : "+v"(acc[ai][bj][m][n]) : "v"(Bt##8[n]), "v"(At##8[m]));     \
        else if constexpr (I8) { _Pragma("unroll") for (int k = 0; k < 2; ++k) acc[ai][bj][m][n] = __builtin_bit_cast(f32x4, __builtin_amdgcn_mfma_i32_16x16x64_i8(__builtin_bit_cast(i32x4, Bt[n][k]), __builtin_bit_cast(i32x4, At[m][k]), __builtin_bit_cast(i32x4, acc[ai][bj][m][n]), 0, 0, 0)); } \
        else { _Pragma("unroll") for (int k = 0; k < 2; ++k) acc[ai][bj][m][n] = __builtin_amdgcn_mfma_f32_16x16x32_bf16(Bt[n][k], At[m][k], acc[ai][bj][m][n], 0, 0, 0); } }                \
        __builtin_amdgcn_s_setprio(0); } while (0)
#define PG8_WAIT_V(n) asm volatile("s_waitcnt vmcnt(" #n ")" ::: "memory")
#define PG8_WAIT_L(n) asm volatile("s_waitcnt lgkmcnt(" #n ")" ::: "memory")
#define PG8_BAR __builtin_amdgcn_s_barrier()
#define PG8_SCHED __builtin_amdgcn_sched_barrier(0)
    Unit cur, nxt; int ui = 0; cur.ko = 0; nxt.ko = 0; cur.aux = 0; nxt.aux = 0;
    if (!S.next(0, cur)) return;
    f32x4 acc[2][2][4][2];
#pragma unroll
    for (int a = 0; a < 2; ++a)
#pragma unroll
        for (int b = 0; b < 2; ++b)
#pragma unroll
            for (int m = 0; m < 4; ++m)
#pragma unroll
                for (int n = 0; n < 2; ++n) acc[a][b][m][n] = (f32x4){0.f, 0.f, 0.f, 0.f};
    bf16x8 At[4][2], B0[2][2], B1[2][2]; i32x8 At8[4], B08[2], B18[2]; (void)At; (void)B0; (void)B1; (void)At8; (void)B08; (void)B18;
    const char* cA = (const char*)g.A + (size_t)cur.pm * tstep + cur.ko; const char* cB = (const char*)g.Bt + (size_t)cur.pn * tstep + cur.ko;
    S.a_ready(cur);
    if constexpr (SP2) {
        PG8_STAGE(PG8_SB(0, 0), cB, voffB); PG8_STAGE(PG8_SB(0, 1), cB + hstep, voffB); PG8_STAGE(PG8_SA(0, 0), cA, voffA); PG8_STAGE(PG8_SA(0, 1), cA + hstep, voffA);
        if (wr == 1) PG8_BAR;
        PG8_WAIT_V(2); PG8_BAR;
        PG8_STAGE(PG8_SB(1, 0), cB + kstep, voffB); PG8_STAGE(PG8_SA(1, 0), cA + kstep, voffA); PG8_STAGE(PG8_SB(1, 1), cB + hstep + kstep, voffB);
        PG8_WAIT_V(6); PG8_BAR;
    } else {
        PG8_STAGE(PG8_SB(0, 0), cB, voffB); PG8_STAGE(PG8_SA(0, 0), cA, voffA); PG8_STAGE(PG8_SB(0, 1), cB + hstep, voffB); PG8_STAGE(PG8_SA(0, 1), cA + hstep, voffA);
        if (wr == 1) PG8_BAR;
        PG8_WAIT_V(4); PG8_BAR;
        PG8_STAGE(PG8_SB(1, 0), cB + kstep, voffB); PG8_STAGE(PG8_SA(1, 0), cA + kstep, voffA); PG8_STAGE(PG8_SB(1, 1), cB + hstep + kstep, voffB);
        PG8_WAIT_V(6); PG8_BAR;
    }
    for (;;) {
        const bool has_next = S.next(ui + 1, nxt);
        const char* nA = has_next ? (const char*)g.A + (size_t)nxt.pm * tstep + nxt.ko : cA; const char* nB = has_next ? (const char*)g.Bt + (size_t)nxt.pn * tstep + nxt.ko : cB;
        for (int t = 0; t < nt; t += 2) {
            const bool last = (t == nt - 2);
            const char* a1 = cA + (size_t)(t + 1) * kstep;
            const char* a2 = last ? nA : cA + (size_t)(t + 2) * kstep; const char* b2 = last ? nB : cB + (size_t)(t + 2) * kstep;
            const char* a3 = a2 + kstep; const char* b3 = b2 + kstep;
            if (last && has_next) S.a_ready(nxt);
            if constexpr (SP2) {
            PG8_LDB(B0, 0, 0); PG8_LDB(B1, 0, 1); PG8_SCHED; PG8_LDA(At, 0, 0); PG8_STAGE(PG8_SA(1, 1), a1 + hstep, voffA);
            PG8_WAIT_V(8); PG8_WAIT_L(0); PG8_BAR; PG8_MMA(0, 0, At, B0); PG8_MMA(0, 1, At, B1); PG8_BAR; PG8_SCHED;
            PG8_LDA(At, 0, 1); PG8_STAGE(PG8_SB(0, 0), b2, voffB); PG8_STAGE(PG8_SB(0, 1), b2 + hstep, voffB); PG8_STAGE(PG8_SA(0, 0), a2, voffA);
            PG8_WAIT_V(8); PG8_WAIT_L(0); PG8_BAR; PG8_MMA(1, 0, At, B0); PG8_MMA(1, 1, At, B1); PG8_BAR; PG8_SCHED;
            PG8_LDB(B0, 1, 0); PG8_LDB(B1, 1, 1); PG8_SCHED; PG8_LDA(At, 1, 0); PG8_STAGE(PG8_SA(0, 1), a2 + hstep, voffA);
            PG8_WAIT_V(8); PG8_WAIT_L(0); PG8_BAR; PG8_MMA(0, 0, At, B0); PG8_MMA(0, 1, At, B1); PG8_BAR; PG8_SCHED;
            PG8_LDA(At, 1, 1); PG8_STAGE(PG8_SB(1, 0), b3, voffB); PG8_STAGE(PG8_SB(1, 1), b3 + hstep, voffB); PG8_STAGE(PG8_SA(1, 0), a3, voffA);
            PG8_WAIT_V(8); PG8_WAIT_L(0); PG8_BAR; PG8_MMA(1, 0, At, B0); PG8_MMA(1, 1, At, B1); PG8_BAR; PG8_SCHED;
            } else {
            PG8_LDB(B0, 0, 0); PG8_SCHED; PG8_LDA(At, 0, 0); PG8_STAGE(PG8_SA(1, 1), a1 + hstep, voffA);
            PG8_WAIT_L(8); PG8_BAR; PG8_WAIT_L(0); PG8_MMA(0, 0, At, B0); PG8_BAR; PG8_SCHED;
            PG8_LDB(B1, 0, 1); PG8_STAGE(PG8_SB(0, 0), b2, voffB);
            PG8_BAR; PG8_WAIT_L(0); PG8_MMA(0, 1, At, B1); PG8_BAR;
            PG8_LDA(At, 0, 1); PG8_STAGE(PG8_SA(0, 0), a2, voffA);
            PG8_BAR; PG8_WAIT_L(0); PG8_MMA(1, 0, At, B0); PG8_BAR; PG8_SCHED;
            PG8_STAGE(PG8_SB(0, 1), b2 + hstep, voffB);
            PG8_WAIT_V(6); PG8_BAR; PG8_MMA(1, 1, At, B1); PG8_BAR;
            PG8_LDB(B0, 1, 0); PG8_SCHED; PG8_LDA(At, 1, 0); PG8_STAGE(PG8_SA(0, 1), a2 + hstep, voffA);
            PG8_WAIT_L(8); PG8_BAR; PG8_WAIT_L(0); PG8_MMA(0, 0, At, B0); PG8_BAR; PG8_SCHED;
            PG8_LDB(B1, 1, 1); PG8_STAGE(PG8_SB(1, 0), b3, voffB);
            PG8_BAR; PG8_WAIT_L(0); PG8_MMA(0, 1, At, B1); PG8_BAR;
            PG8_LDA(At, 1, 1); PG8_STAGE(PG8_SA(1, 0), a3, voffA);
            PG8_BAR; PG8_WAIT_L(0); PG8_MMA(1, 0, At, B0); PG8_BAR; PG8_SCHED;
            PG8_STAGE(PG8_SB(1, 1), b3 + hstep, voffB);
            PG8_WAIT_V(6); PG8_BAR; PG8_MMA(1, 1, At, B1); PG8_BAR;
            }
        }
        if constexpr (ALIGN_EPI) { if (wr == 0) PG8_BAR; }
        if constexpr (F8) asm volatile("s_nop 15\n\ts_nop 15" ::: "memory");
        if constexpr (I8) {
#pragma unroll
            for (int a = 0; a < 2; ++a)
#pragma unroll
                for (int b = 0; b < 2; ++b)
#pragma unroll
                    for (int m = 0; m < 4; ++m)
#pragma unroll
                        for (int n = 0; n < 2; ++n) { const i32x4 iv = __builtin_bit_cast(i32x4, acc[a][b][m][n]); acc[a][b][m][n] = (f32x4){(float)iv[0], (float)iv[1], (float)iv[2], (float)iv[3]}; } }
        if constexpr (!Epi::AFTER_DRAIN) { E(acc, cur, wr, wc, fr, fq); S.done(cur); }
        if (!has_next) break;
#pragma unroll
        for (int a = 0; a < 2; ++a)
#pragma unroll
            for (int b = 0; b < 2; ++b)
#pragma unroll
                for (int m = 0; m < 4; ++m)
#pragma unroll
                    for (int n = 0; n < 2; ++n) acc[a][b][m][n] = (f32x4){0.f, 0.f, 0.f, 0.f};
        if constexpr (F8) asm volatile("s_nop 7" ::: "memory");
        cur = nxt; cA = nA; cB = nB; ++ui;
        if constexpr (ALIGN_EPI) { if (wr == 1) PG8_BAR; }
    }
    PG8_WAIT_V(0);
    if constexpr (!ALIGN_EPI) { if (wr == 0) PG8_BAR; }
    PG8_BAR;
    if constexpr (Epi::AFTER_DRAIN) { E.fused(acc, cur, wr, wc, fr, fq, lds, wid, lane); S.done(cur); }
#undef PG8_SA
#undef PG8_SB
#undef PG8_STAGE
#undef PG8_LDA
#undef PG8_LDB
#undef PG8_MMA
#undef PG8_RD8
#undef PG8_WAIT_V
#undef PG8_WAIT_L
#undef PG8_BAR
#undef PG8_SCHED
}
}
namespace pg8 {
__device__ __forceinline__ u32x4 pack8bf(const f32x4 v0, const f32x4 v1) { u32x4 w; w.x = cvt_pk_bf16(v0[0], v0[1]); w.y = cvt_pk_bf16(v0[2], v0[3]); w.z = cvt_pk_bf16(v1[0], v1[1]); w.w = cvt_pk_bf16(v1[2], v1[3]); return w; }

struct EpiQRope {
    static constexpr bool PERM = true, AFTER_DRAIN = false;
    bf16_t* Qb; const float* cs;
    __device__ __forceinline__ void operator()(const f32x4 (&acc)[2][2][4][2], const Unit& u, int wr, int wc, int fr, int fq) const {
        const int row0 = u.pm * BM + wr * 64 + fr;
        if (u.pn < 4) {
#pragma unroll
            for (int ai = 0; ai < 2; ++ai)
#pragma unroll
                for (int m = 0; m < 4; ++m) { bf16_t* rowp = Qb + (size_t)(row0 + ai * HALF + m * 16) * 1536 + wc * 32 + 8 * fq;
#pragma unroll
                    for (int bj = 0; bj < 2; ++bj) *(u32x4*)(rowp + (2 * u.pn + bj) * 192) = pack8bf(acc[ai][bj][m][0], acc[ai][bj][m][1]); }
        } else {
            const int head = 4 * (u.pn - 4) + wc, i0 = 8 * fq;
#pragma unroll
            for (int ai = 0; ai < 2; ++ai)
#pragma unroll
                for (int m = 0; m < 4; ++m) { const int row = row0 + ai * HALF + m * 16; const float* c = cs + (size_t)row * 64 + i0;
                    const f32x4 c0 = *(const f32x4*)c, c1 = *(const f32x4*)(c + 4), s0 = *(const f32x4*)(c + 32), s1 = *(const f32x4*)(c + 36);
                    const f32x4 x1a = acc[ai][0][m][0], x1b = acc[ai][0][m][1], x2a = acc[ai][1][m][0], x2b = acc[ai][1][m][1];
                    const f32x4 o1a = x1a * c0 - x2a * s0, o1b = x1b * c1 - x2b * s1, o2a = x2a * c0 + x1a * s0, o2b = x2b * c1 + x1b * s1;
                    bf16_t* rowp = Qb + (size_t)row * 1536 + head * 192 + 128 + i0;
                    *(u32x4*)(rowp) = pack8bf(o1a, o1b); *(u32x4*)(rowp + 32) = pack8bf(o2a, o2b); }
        }
    }
};
struct EpiKV {
    static constexpr bool PERM = true, AFTER_DRAIN = false;
    bf16_t* KV;
    __device__ __forceinline__ void operator()(const f32x4 (&acc)[2][2][4][2], const Unit& u, int wr, int wc, int fr, int fq) const {
        const int row0 = u.pm * BM + wr * 64 + fr, d = wc * 32 + 8 * fq;
#pragma unroll
        for (int ai = 0; ai < 2; ++ai)
#pragma unroll
            for (int m = 0; m < 4; ++m) { const size_t row = (size_t)(row0 + ai * HALF + m * 16);
                *(u32x4*)(KV + row * 2560 + u.pn * 320 + d) = pack8bf(acc[ai][0][m][0], acc[ai][0][m][1]);
                *(u32x4*)(KV + row * 2560 + u.pn * 320 + 192 + d) = pack8bf(acc[ai][1][m][0], acc[ai][1][m][1]); }
    }
};
template <bool BASE_F32, bool RSC = false> struct EpiResB {
    static constexpr bool PERM = true, AFTER_DRAIN = false;
    const float* basef; bf16_t* hb; float* ps; int ldc; const float* rsc;
    __device__ __forceinline__ void operator()(const f32x4 (&acc)[2][2][4][2], const Unit& u, int wr, int wc, int fr, int fq) const {
        const int row0 = u.pm * BM + wr * 64 + fr, col0 = u.pn * BM + wc * 32 + 8 * fq;
#pragma unroll
        for (int ai = 0; ai < 2; ++ai) {
            f32x4 bf[BASE_F32 ? 4 : 1][2][2]; u32x4 bh[BASE_F32 ? 1 : 4][2];
#pragma unroll
            for (int m = 0; m < 4; ++m) { const size_t off = (size_t)(row0 + ai * HALF + m * 16) * ldc + col0;
#pragma unroll
                for (int bj = 0; bj < 2; ++bj) { if (BASE_F32) { bf[BASE_F32 ? m : 0][bj][0] = *(const f32x4*)(basef + off + bj * HALF); bf[BASE_F32 ? m : 0][bj][1] = *(const f32x4*)(basef + off + bj * HALF + 4); }
                                                 else bh[BASE_F32 ? 0 : m][bj] = *(const u32x4*)(hb + off + bj * HALF); } }
#pragma unroll
            for (int m = 0; m < 4; ++m) { const int row = row0 + ai * HALF + m * 16; const size_t off = (size_t)row * ldc + col0; float ss = 0.f; const float rf = RSC ? rsc[row] : 1.f;
#pragma unroll
                for (int bj = 0; bj < 2; ++bj) { f32x4 b0, b1;
                    if (BASE_F32) { b0 = bf[BASE_F32 ? m : 0][bj][0]; b1 = bf[BASE_F32 ? m : 0][bj][1]; }
                    else { const u32x4 w = bh[BASE_F32 ? 0 : m][bj];
                        b0 = (f32x4){__builtin_bit_cast(float, w.x << 16), __builtin_bit_cast(float, w.x & 0xffff0000u), __builtin_bit_cast(float, w.y << 16), __builtin_bit_cast(float, w.y & 0xffff0000u)};
                        b1 = (f32x4){__builtin_bit_cast(float, w.z << 16), __builtin_bit_cast(float, w.z & 0xffff0000u), __builtin_bit_cast(float, w.w << 16), __builtin_bit_cast(float, w.w & 0xffff0000u)}; }
                    const f32x4 v0 = RSC ? b0 + acc[ai][bj][m][0] * rf : b0 + acc[ai][bj][m][0], v1 = RSC ? b1 + acc[ai][bj][m][1] * rf : b1 + acc[ai][bj][m][1];
                    ss += ((v0[0] * v0[0] + v0[1] * v0[1]) + (v0[2] * v0[2] + v0[3] * v0[3])) + ((v1[0] * v1[0] + v1[1] * v1[1]) + (v1[2] * v1[2] + v1[3] * v1[3]));
                    *(u32x4*)(hb + off + bj * HALF) = pack8bf(v0, v1); }
                ss += __shfl_xor(ss, 16); ss += __shfl_xor(ss, 32);
                if (fq == 0) ps[(size_t)row * 32 + u.pn * 4 + wc] = ss; }
            asm volatile("" ::: "memory"); }
    }
};
struct EpiBf16Row {
    static constexpr bool PERM = true, AFTER_DRAIN = false;
    bf16_t* O; int ldc; const float* rstd;
    __device__ __forceinline__ void operator()(const f32x4 (&acc)[2][2][4][2], const Unit& u, int wr, int wc, int fr, int fq) const {
        const int row0 = u.pm * BM + wr * 64 + fr, col0 = u.pn * BM + wc * 32 + 8 * fq;
        float rs[2][4];
#pragma unroll
        for (int ai = 0; ai < 2; ++ai)
#pragma unroll
            for (int m = 0; m < 4; ++m) rs[ai][m] = rstd[row0 + ai * HALF + m * 16];
#pragma unroll
        for (int ai = 0; ai < 2; ++ai)
#pragma unroll
            for (int m = 0; m < 4; ++m) { const int row = row0 + ai * HALF + m * 16; const float r = rs[ai][m]; bf16_t* rowp = O + (size_t)row * ldc + col0;
#pragma unroll
                for (int bj = 0; bj < 2; ++bj) *(u32x4*)(rowp + bj * HALF) = pack8bf(acc[ai][bj][m][0] * r, acc[ai][bj][m][1] * r); }
    }
};
template <bool OUT8 = false> struct EpiSwiGLU {
    static constexpr bool PERM = true, AFTER_DRAIN = false;
    bf16_t* Hm; int ldh; int ntn; const float* rstd; float osc;
    __device__ __forceinline__ void operator()(const f32x4 (&acc)[2][2][4][2], const Unit& u, int wr, int wc, int fr, int fq) const {
        const int row0 = u.pm * BM + wr * 64 + fr, col = (u.pn % ntn) * 128 + wc * 32 + 8 * fq;
        float rs[2][4];
#pragma unroll
        for (int ai = 0; ai < 2; ++ai)
#pragma unroll
            for (int m = 0; m < 4; ++m) rs[ai][m] = rstd[row0 + ai * HALF + m * 16];
#pragma unroll
        for (int ai = 0; ai < 2; ++ai)
#pragma unroll
            for (int m = 0; m < 4; ++m) { f32x4 h[2]; const float r = rs[ai][m];
#pragma unroll
                for (int n = 0; n < 2; ++n) { const f32x4 g = acc[ai][0][m][n] * r, up = acc[ai][1][m][n] * r;
#pragma unroll
                    for (int e = 0; e < 4; ++e) { const float s = __builtin_amdgcn_rcpf(1.0f + __builtin_amdgcn_exp2f(-1.4426950408889634f * g[e])); h[n][e] = g[e] * s * up[e]; } }
                if constexpr (OUT8) { typedef unsigned u32x2 __attribute__((ext_vector_type(2)));
                    u32x2 w; w.x = pk8x4(h[0][0] * osc, h[0][1] * osc, h[0][2] * osc, h[0][3] * osc); w.y = pk8x4(h[1][0] * osc, h[1][1] * osc, h[1][2] * osc, h[1][3] * osc);
                    *(u32x2*)((unsigned char*)Hm + (size_t)(row0 + ai * HALF + m * 16) * ldh + col) = w; }
                else *(u32x4*)(Hm + (size_t)(row0 + ai * HALF + m * 16) * ldh + col) = pack8bf(h[0], h[1]); }
    }
};
struct EpiMoEDown {
    static constexpr bool PERM = true, AFTER_DRAIN = false;
    bf16_t* Y; const float* gate; int ntn;
    __device__ __forceinline__ void operator()(const f32x4 (&acc)[2][2][4][2], const Unit& u, int wr, int wc, int fr, int fq) const {
        const int row0 = u.pm * BM + wr * 64 + fr, col0 = (u.pn % ntn) * BM + wc * 32 + 8 * fq;
        float gs[2][4];
#pragma unroll
        for (int ai = 0; ai < 2; ++ai)
#pragma unroll
            for (int m = 0; m < 4; ++m) gs[ai][m] = gate[row0 + ai * HALF + m * 16];
#pragma unroll
        for (int ai = 0; ai < 2; ++ai)
#pragma unroll
            for (int m = 0; m < 4; ++m) { const int row = row0 + ai * HALF + m * 16; const float gt = gs[ai][m]; bf16_t* rowp = Y + (size_t)row * 2048 + col0;
#pragma unroll
                for (int bj = 0; bj < 2; ++bj) *(u32x4*)(rowp + bj * HALF) = pack8bf(acc[ai][bj][m][0] * gt, acc[ai][bj][m][1] * gt); }
    }
};
struct EpiPartF32 {
    static constexpr bool PERM = true, AFTER_DRAIN = false;
    float* out; int ncols, kbytes, rows; const float* rstd;
    __device__ __forceinline__ void operator()(const f32x4 (&acc)[2][2][4][2], const Unit& u, int wr, int wc, int fr, int fq) const {
        const int row0 = u.pm * BM + wr * 64 + fr, col = wc * 32 + 8 * fq, kq = u.ko / kbytes;
        if (col < ncols) {
            float rs[2][4];
#pragma unroll
            for (int ai = 0; ai < 2; ++ai)
#pragma unroll
                for (int m = 0; m < 4; ++m) rs[ai][m] = rstd ? rstd[row0 + ai * HALF + m * 16] : 1.f;
#pragma unroll
            for (int ai = 0; ai < 2; ++ai)
#pragma unroll
                for (int m = 0; m < 4; ++m) { const int row = row0 + ai * HALF + m * 16; const float r = rs[ai][m]; float* p = out + ((size_t)kq * rows + (size_t)row) * ncols + col; *(f32x4*)p = acc[ai][0][m][0] * r; *(f32x4*)(p + 4) = acc[ai][0][m][1] * r; }
        }
    }
};
struct SplitKOrder {
    int G, c, PN, kbytes;
    __device__ __forceinline__ bool next(int i, Unit& u) const { const int L = i * G + c; if (L >= 256) return false; u.pm = L >> 2; u.pn = PN; u.ko = (L & 3) * kbytes; return true; }
    __device__ __forceinline__ void a_ready(const Unit&) const {}
    __device__ __forceinline__ void done(const Unit&) const {}
};
struct GroupedOrder {
    int nN, nwg, G, c, MT, t1, t2, t3, t4, t5, t6, t7, hi;
    __device__ __forceinline__ void init(const unsigned* tot, int nN_, int G_, int c_) {
        int t = 0; nN = nN_; G = G_; c = c_;
        t += (int)((tot[0] + 255u) >> 8); t1 = t; t += (int)((tot[1] + 255u) >> 8); t2 = t; t += (int)((tot[2] + 255u) >> 8); t3 = t; t += (int)((tot[3] + 255u) >> 8); t4 = t;
        t += (int)((tot[4] + 255u) >> 8); t5 = t; t += (int)((tot[5] + 255u) >> 8); t6 = t; t += (int)((tot[6] + 255u) >> 8); t7 = t; t += (int)((tot[7] + 255u) >> 8); MT = t; nwg = MT * nN; hi = nwg;
    }
    __device__ __forceinline__ bool next(int i, Unit& u) const { const long L = (long)i * G + c; if (L >= hi) return false; map((int)L, u); return true; }
    __device__ __forceinline__ void map(int L, Unit& u) const {
        int wgid = L; { const int q = nwg / NXCD, r = nwg % NXCD, xcd = wgid % NXCD, off = wgid / NXCD; wgid = (xcd < r ? xcd * (q + 1) : r * (q + 1) + (xcd - r) * q) + off; }
        const int tq = wgid / nN;
        const int e = (tq >= t1) + (tq >= t2) + (tq >= t3) + (tq >= t4) + (tq >= t5) + (tq >= t6) + (tq >= t7);
        const int te = e == 0 ? 0 : e == 1 ? t1 : e == 2 ? t2 : e == 3 ? t3 : e == 4 ? t4 : e == 5 ? t5 : e == 6 ? t6 : t7, tn = e == 0 ? t1 : e == 1 ? t2 : e == 2 ? t3 : e == 3 ? t4 : e == 4 ? t5 : e == 5 ? t6 : e == 6 ? t7 : MT;
        const int local = wgid - te * nN, nig = WGM * nN, gid = local / nig, fm = te + gid * WGM, gsz = (tn - fm) < WGM ? (tn - fm) : WGM, x = local - gid * nig;
        u.pm = fm + x % gsz; u.pn = e * nN + x / gsz;
    }
    __device__ __forceinline__ void a_ready(const Unit&) const {}
    __device__ __forceinline__ void done(const Unit&) const {}
};
template <int LOG> struct GroupedSplitOrder {
    GroupedOrder b; int first, nq, kbytes;
    __device__ __forceinline__ bool next(int i, Unit& u) const { const int Lq = i * b.G + b.c; if (Lq >= nq) return false; b.map(first + (Lq >> LOG), u); u.ko = (Lq & ((1 << LOG) - 1)) * kbytes; u.aux = Lq >> LOG; return true; }
    __device__ __forceinline__ void a_ready(const Unit&) const {}
    __device__ __forceinline__ void done(const Unit&) const {}
};
struct EpiMoEDownPart {
    static constexpr bool PERM = true, AFTER_DRAIN = false;
    float* part; unsigned* split; int ntn, kbytes;
    __device__ __forceinline__ void operator()(const f32x4 (&acc)[2][2][4][2], const Unit& u, int wr, int wc, int fr, int fq) const {
        const int kq = u.ko / kbytes, pn = u.pn % ntn; float* base = part + ((size_t)(u.aux * 4 + kq) << 16) + (size_t)(wr * 64 + fr) * 256 + wc * 32 + 8 * fq;
        if (kq == 0 && wr == 0 && wc == 0 && fr == 0 && fq == 0) split[u.pm * ntn + pn] = (unsigned)u.aux + 1u;
#pragma unroll
        for (int ai = 0; ai < 2; ++ai)
#pragma unroll
            for (int m = 0; m < 4; ++m) { float* rowp = base + (size_t)(ai * HALF + m * 16) * 256;
#pragma unroll
                for (int bj = 0; bj < 2; ++bj) { *(f32x4*)(rowp + bj * HALF) = acc[ai][bj][m][0]; *(f32x4*)(rowp + bj * HALF + 4) = acc[ai][bj][m][1]; } }
    }
};
}
#include <cmath>
#define ATT_PV_SPLIT 1
namespace att {
typedef unsigned short bf16_t;
typedef short bf16x8 __attribute__((ext_vector_type(8)));
typedef short s16x4 __attribute__((ext_vector_type(4)));
typedef float f32x16 __attribute__((ext_vector_type(16)));
typedef float f32x4 __attribute__((ext_vector_type(4)));
typedef unsigned u32x4 __attribute__((ext_vector_type(4)));
constexpr int NW = 8, QBLK = 32, KVBLK = 64, QB = NW * QBLK, DV = 128, SHM_V = KVBLK * DV * 2;
constexpr float THR = 40.f;
#define ATT_SBAR() __builtin_amdgcn_sched_barrier(0)
__device__ __forceinline__ int v_st(int k, int c) { const int kk = (k & ~0xC) | ((k & 4) << 1) | ((k & 8) >> 1); return ((kk >> 3) * 4 + (c >> 5)) * 512 + ((kk & 7) * 32 + (c & 31)) * 2; }
__device__ __forceinline__ int v_rd_base(int lane) { return ((lane & 3) << 3) | (((lane >> 2) & 3) << 6) | (((lane >> 4) & 1) << 5) | (((lane >> 5) & 1) << 8); }
constexpr int v_rd_off(int d0, int ks, int half) { return d0 * 512 + ks * 4096 + half * 2048; }
__device__ __forceinline__ int crow(int r, int hi) { return (r & 3) + 8 * (r >> 2) + 4 * hi; }
__device__ __forceinline__ unsigned cvtpk(float lo, float hi) { unsigned r; asm volatile("v_cvt_pk_bf16_f32 %0, %1, %2" : "=v"(r) : "v"(lo), "v"(hi)); return r; }
__device__ __forceinline__ bf16x8 ld8(const bf16_t* p) { return *reinterpret_cast<const bf16x8*>(p); }
__device__ __forceinline__ void mask_tile(f32x16& p0, f32x16& p1, int dq) {
    const float NEG = -__builtin_inff();
#define ATT_MSK(x, c_) asm volatile("v_cmp_gt_i32 vcc, %2, %1\n\tv_cndmask_b32 %0, %0, %3, vcc" : "+v"(x) : "v"(dq), "n"(c_), "v"(NEG) : "vcc")
#pragma unroll
    for (int r = 0; r < 16; ++r) { const int c = (r & 3) + 8 * (r >> 2); ATT_MSK(p0[r], c); ATT_MSK(p1[r], c + 32); }
#undef ATT_MSK
}
__device__ __forceinline__ void partialSM(f32x16& p0, f32x16& p1, float& m_reg, float& mn, float& alpha, const float SCALE) {
    float pmax = p0[0];
#pragma unroll
    for (int r = 1; r < 16; ++r) pmax = fmaxf(pmax, p0[r]);
#pragma unroll
    for (int r = 0; r < 16; ++r) pmax = fmaxf(pmax, p1[r]);
    { auto rr = __builtin_amdgcn_permlane32_swap(__float_as_uint(pmax), __float_as_uint(pmax), false, false);
      pmax = fmaxf(__uint_as_float(rr[0]), __uint_as_float(rr[1])); }
    const float C2 = 1.4426950408889634f * SCALE;
    if (__builtin_expect(__all((pmax - m_reg) * SCALE <= THR), 1)) { mn = m_reg; alpha = 1.f; }
    else { mn = fmaxf(m_reg, pmax); alpha = __builtin_amdgcn_exp2f((m_reg - mn) * C2); m_reg = mn; }
    const float mnL = -mn * C2;
#pragma unroll
    for (int r = 0; r < 16; ++r) p0[r] = fmaf(p0[r], C2, mnL);
#pragma unroll
    for (int r = 0; r < 16; ++r) p1[r] = fmaf(p1[r], C2, mnL);
#pragma unroll
    for (int r = 0; r < 16; ++r) p0[r] = __builtin_amdgcn_exp2f(p0[r]);
}
__device__ __forceinline__ void finishSM(f32x16& p0, f32x16& p1, float alpha, float& l_reg, bf16x8& pa0, bf16x8& pa1, bf16x8& pa2, bf16x8& pa3) {
#pragma unroll
    for (int r = 0; r < 16; ++r) p1[r] = __builtin_amdgcn_exp2f(p1[r]);
    float ps = 0;
#pragma unroll
    for (int r = 0; r < 16; ++r) ps += p0[r];
#pragma unroll
    for (int r = 0; r < 16; ++r) ps += p1[r];
    { auto rr = __builtin_amdgcn_permlane32_swap(__float_as_uint(ps), __float_as_uint(ps), false, false);
      ps = __uint_as_float(rr[0]) + __uint_as_float(rr[1]); }
    l_reg = l_reg * alpha + ps;
#define ATT_PK4(P, B_, OUT) do { unsigned a0 = cvtpk(P[B_+0], P[B_+1]), a1 = cvtpk(P[B_+2], P[B_+3]);                          \
        unsigned b0 = cvtpk(P[B_+4], P[B_+5]), b1 = cvtpk(P[B_+6], P[B_+7]);                                             \
        auto r0 = __builtin_amdgcn_permlane32_swap(a0, b0, false, false); auto r1 = __builtin_amdgcn_permlane32_swap(a1, b1, false, false); \
        u32x4 w = {r0[0], r1[0], r0[1], r1[1]}; OUT = *reinterpret_cast<bf16x8*>(&w); } while (0)
    ATT_PK4(p0, 0, pa0); ATT_PK4(p0, 8, pa1); ATT_PK4(p1, 0, pa2); ATT_PK4(p1, 8, pa3);
#undef ATT_PK4
}
template <int VB>
__device__ __forceinline__ void pv_tile(f32x16* o, int vb0, bf16x8 pa0, bf16x8 pa1, bf16x8 pa2, bf16x8 pa3) {
#define ATT_TRRD(dst, off) asm volatile("ds_read_b64_tr_b16 %0, %1 offset:%2" : "=&v"(dst) : "v"(vb0), "i"(off) : "memory")
#ifndef ATT_PV_SPLIT
#define ATT_PV_SPLIT 0
#endif
#if ATT_PV_SPLIT
#define ATT_PV_D0(d0) do { s16x4 l0, l1, h0, h1; constexpr int b_ = VB * SHM_V + v_rd_off(d0, 0, 0); \
        ATT_TRRD(l0, b_); ATT_TRRD(h0, b_ + 2048); ATT_TRRD(l1, b_ + 4096); ATT_TRRD(h1, b_ + 6144); \
        asm volatile("s_waitcnt lgkmcnt(0)" ::: "memory"); ATT_SBAR();   \
        o[d0] = __builtin_amdgcn_mfma_f32_32x32x16_bf16(pa0, (bf16x8){l0[0], l0[1], l0[2], l0[3], h0[0], h0[1], h0[2], h0[3]}, o[d0], 0, 0, 0);   \
        o[d0] = __builtin_amdgcn_mfma_f32_32x32x16_bf16(pa1, (bf16x8){l1[0], l1[1], l1[2], l1[3], h1[0], h1[1], h1[2], h1[3]}, o[d0], 0, 0, 0);   \
        ATT_SBAR(); ATT_TRRD(l0, b_ + 8192); ATT_TRRD(h0, b_ + 10240); ATT_TRRD(l1, b_ + 12288); ATT_TRRD(h1, b_ + 14336); \
        asm volatile("s_waitcnt lgkmcnt(0)" ::: "memory"); ATT_SBAR();   \
        o[d0] = __builtin_amdgcn_mfma_f32_32x32x16_bf16(pa2, (bf16x8){l0[0], l0[1], l0[2], l0[3], h0[0], h0[1], h0[2], h0[3]}, o[d0], 0, 0, 0);   \
        o[d0] = __builtin_amdgcn_mfma_f32_32x32x16_bf16(pa3, (bf16x8){l1[0], l1[1], l1[2], l1[3], h1[0], h1[1], h1[2], h1[3]}, o[d0], 0, 0, 0); } while (0)
#else
#define ATT_PV_D0(d0) do { s16x4 l0, l1, l2, l3, h0, h1, h2, h3; constexpr int b_ = VB * SHM_V + v_rd_off(d0, 0, 0); \
        ATT_TRRD(l0, b_); ATT_TRRD(h0, b_ + 2048); ATT_TRRD(l1, b_ + 4096); ATT_TRRD(h1, b_ + 6144); ATT_TRRD(l2, b_ + 8192); ATT_TRRD(h2, b_ + 10240); ATT_TRRD(l3, b_ + 12288); ATT_TRRD(h3, b_ + 14336); \
        asm volatile("s_waitcnt lgkmcnt(0)" ::: "memory"); ATT_SBAR();   \
        o[d0] = __builtin_amdgcn_mfma_f32_32x32x16_bf16(pa0, (bf16x8){l0[0], l0[1], l0[2], l0[3], h0[0], h0[1], h0[2], h0[3]}, o[d0], 0, 0, 0);   \
        o[d0] = __builtin_amdgcn_mfma_f32_32x32x16_bf16(pa1, (bf16x8){l1[0], l1[1], l1[2], l1[3], h1[0], h1[1], h1[2], h1[3]}, o[d0], 0, 0, 0);   \
        o[d0] = __builtin_amdgcn_mfma_f32_32x32x16_bf16(pa2, (bf16x8){l2[0], l2[1], l2[2], l2[3], h2[0], h2[1], h2[2], h2[3]}, o[d0], 0, 0, 0);   \
        o[d0] = __builtin_amdgcn_mfma_f32_32x32x16_bf16(pa3, (bf16x8){l3[0], l3[1], l3[2], l3[3], h3[0], h3[1], h3[2], h3[3]}, o[d0], 0, 0, 0); } while (0)
#endif
    ATT_PV_D0(0); ATT_PV_D0(1); ATT_PV_D0(2); ATT_PV_D0(3);
#undef ATT_PV_D0
#undef ATT_TRRD
}

template <int VB>
__device__ __forceinline__ void pv_sm(f32x16* o, int vb0, bf16x8 pa0, bf16x8 pa1, bf16x8 pa2, bf16x8 pa3, f32x16& p0, f32x16& p1, float& m_reg, float& mn, float& alpha, const float SCALE) {
#define ATT_TRRD(dst, off) asm volatile("ds_read_b64_tr_b16 %0, %1 offset:%2" : "=&v"(dst) : "v"(vb0), "i"(off) : "memory")
#define ATT_RD4(base_) ATT_TRRD(l0, base_); ATT_TRRD(h0, base_ + 2048); ATT_TRRD(l1, base_ + 4096); ATT_TRRD(h1, base_ + 6144)
#define ATT_MM2(d0, pa_, pb_) do { asm volatile("s_waitcnt lgkmcnt(0)" : "+v"(l0), "+v"(h0), "+v"(l1), "+v"(h1) :: "memory"); ATT_SBAR();                        \
        o[d0] = __builtin_amdgcn_mfma_f32_32x32x16_bf16(pa_, (bf16x8){l0[0], l0[1], l0[2], l0[3], h0[0], h0[1], h0[2], h0[3]}, o[d0], 0, 0, 0);   \
        o[d0] = __builtin_amdgcn_mfma_f32_32x32x16_bf16(pb_, (bf16x8){l1[0], l1[1], l1[2], l1[3], h1[0], h1[1], h1[2], h1[3]}, o[d0], 0, 0, 0); ATT_SBAR(); } while (0)
    const float C2 = 1.4426950408889634f * SCALE;
    s16x4 l0, l1, h0, h1; constexpr int b0_ = VB * SHM_V;
    ATT_RD4(b0_ + v_rd_off(0, 0, 0));
    float ma = fmaxf(fmaxf(p0[0], p0[1]), p0[2]);
#pragma unroll
    for (int r = 3; r < 15; r += 2) ma = fmaxf(fmaxf(ma, p0[r]), p0[r + 1]);
    ma = fmaxf(ma, p0[15]);
    ATT_MM2(0, pa0, pa1);
    ATT_RD4(b0_ + v_rd_off(0, 0, 0) + 8192);
    float mb = fmaxf(fmaxf(p1[0], p1[1]), p1[2]);
#pragma unroll
    for (int r = 3; r < 15; r += 2) mb = fmaxf(fmaxf(mb, p1[r]), p1[r + 1]);
    mb = fmaxf(mb, p1[15]);
    ATT_MM2(0, pa2, pa3);
    ATT_RD4(b0_ + v_rd_off(1, 0, 0));
    float pmax = fmaxf(ma, mb);
    { auto rr = __builtin_amdgcn_permlane32_swap(__float_as_uint(pmax), __float_as_uint(pmax), false, false); pmax = fmaxf(__uint_as_float(rr[0]), __uint_as_float(rr[1])); }
    const bool keep = __all((pmax - m_reg) * SCALE <= THR);
    mn = keep ? m_reg : fmaxf(m_reg, pmax); alpha = __builtin_amdgcn_exp2f((m_reg - mn) * C2); m_reg = mn;
    const float mnL = -mn * C2;
#define ATT_VFMA(x) asm volatile("v_fma_f32 %0, %0, %1, %2" : "+v"(x) : "s"(C2), "v"(mnL))
#define ATT_VEXP(x) asm volatile("v_exp_f32 %0, %0" : "+v"(x))
    ATT_MM2(1, pa0, pa1);
    ATT_RD4(b0_ + v_rd_off(1, 0, 0) + 8192);
#pragma unroll
    for (int r = 0; r < 16; ++r) ATT_VFMA(p0[r]);
    ATT_MM2(1, pa2, pa3);
    ATT_RD4(b0_ + v_rd_off(2, 0, 0));
#pragma unroll
    for (int r = 0; r < 16; ++r) ATT_VFMA(p1[r]);
#pragma unroll
    for (int r = 0; r < 4; ++r) ATT_VEXP(p0[r]);
    ATT_MM2(2, pa0, pa1);
    ATT_RD4(b0_ + v_rd_off(2, 0, 0) + 8192);
#pragma unroll
    for (int r = 4; r < 8; ++r) ATT_VEXP(p0[r]);
    ATT_MM2(2, pa2, pa3);
    ATT_RD4(b0_ + v_rd_off(3, 0, 0));
#pragma unroll
    for (int r = 8; r < 12; ++r) ATT_VEXP(p0[r]);
    ATT_MM2(3, pa0, pa1);
    ATT_RD4(b0_ + v_rd_off(3, 0, 0) + 8192);
#pragma unroll
    for (int r = 12; r < 16; ++r) ATT_VEXP(p0[r]);
    ATT_MM2(3, pa2, pa3);
#undef ATT_VFMA
#undef ATT_VEXP
#undef ATT_MM2
#undef ATT_RD4
#undef ATT_TRRD
}

template <int DQK, int LDQ, int LDKV, int LDO, int BIAS, int QL, class TOut>
struct Body {
    static constexpr int RB = DQK * 2, SHM_K = KVBLK * RB, NKL = (DQK == 192) ? 4 : 2, ND0 = DQK / 16, ND0R = ND0 - QL;
    static constexpr bool TAB = (BIAS == 1 || BIAS == 2);
    static constexpr int OFF_K = 2 * SHM_V, OFF_WS = OFF_K + 2 * SHM_K, OFF_B = OFF_WS + NW * 64 * 4, OFF_Q = OFF_B + 512, LDS_BYTES = OFF_Q + NW * QL * 1024;
    struct Ref { const bf16_t* Q; const bf16_t* K; const bf16_t* V; TOut* O; const float* kb; float bs; int P0, jlo; };
    struct Seam { bf16x8 qr[ND0R > 0 ? ND0R : 1]; bf16x8 st_v0, st_v1; bf16x8 st_k[NKL]; float st_b; };
    template <int KB>
    static __device__ __forceinline__ void qkt(f32x16& p0, f32x16& p1, const char* K_lds, const char* B_lds, const char* Q_lds, int r32, int hi, const bf16x8* qr, float bs, float lb) {
        if (BIAS == 1) { p0 = *reinterpret_cast<const f32x16*>(B_lds + KB * 256 + hi * 128); p1 = *reinterpret_cast<const f32x16*>(B_lds + KB * 256 + hi * 128 + 64); }
        else if (BIAS == 3) {
            const float bs8 = 8.f * bs, bs32 = 32.f * bs;
            p0[0] = lb; p0[1] = p0[0] + bs; p0[2] = p0[1] + bs; p0[3] = p0[2] + bs;
#pragma unroll
            for (int r = 4; r < 16; ++r) p0[r] = p0[r - 4] + bs8;
#pragma unroll
            for (int r = 0; r < 16; ++r) p1[r] = p0[r] + bs32;
        }
        else { p0 = f32x16{}; p1 = f32x16{}; }
        const char* kb[4];
#pragma unroll
        for (int dd = 0; dd < 4; ++dd) kb[dd] = K_lds + KB * SHM_K + r32 * RB + ((dd * 32 + hi * 16) ^ ((r32 & 7) << 4));
#pragma unroll
        for (int d0 = 0; d0 < ND0; ++d0) { const char* a = kb[d0 & 3] + (d0 >> 2) * 128;
            bf16x8 b0 = *reinterpret_cast<const bf16x8*>(a);
            bf16x8 b1 = *reinterpret_cast<const bf16x8*>(a + 32 * RB);
            bf16x8 q; if (d0 < ND0R) q = qr[d0 < ND0R ? d0 : 0]; else q = *reinterpret_cast<const bf16x8*>(Q_lds + (d0 - ND0R) * 1024);
            p0 = __builtin_amdgcn_mfma_f32_32x32x16_bf16(b0, q, p0, 0, 0, 0);
            p1 = __builtin_amdgcn_mfma_f32_32x32x16_bf16(b1, q, p1, 0, 0, 0); }
    }
    static __device__ __forceinline__ void add_bias(f32x16& p0, f32x16& p1, const char* B_lds, int kbuf, int hi) {
#pragma unroll
        for (int g = 0; g < 4; ++g) { const f32x4 b0 = *reinterpret_cast<const f32x4*>(B_lds + kbuf * 256 + hi * 128 + g * 16), b1 = *reinterpret_cast<const f32x4*>(B_lds + kbuf * 256 + hi * 128 + 64 + g * 16);
            p0[4 * g + 0] += b0[0]; p0[4 * g + 1] += b0[1]; p0[4 * g + 2] += b0[2]; p0[4 * g + 3] += b0[3]; p1[4 * g + 0] += b1[0]; p1[4 * g + 1] += b1[1]; p1[4 * g + 2] += b1[2]; p1[4 * g + 3] += b1[3]; }
    }
#define ATT_VMW() asm volatile("s_waitcnt vmcnt(0)" ::: "memory")
#define ATT_VMWN(n) asm volatile("s_waitcnt vmcnt(%0)" :: "i"(n) : "memory")
#define ATT_SLOAD(Kp, Vp, Bp, k0) do { const size_t o_ = (size_t)((k0) + sr) * LDKV + sc; S.st_v0 = ld8((Vp) + o_); S.st_v1 = ld8((Vp) + o_ + 32 * LDKV);              \
        if (DQK >= 128 || sc < 64) { S.st_k[0] = ld8((Kp) + o_); S.st_k[1] = ld8((Kp) + o_ + 32 * LDKV); }                                                             \
        if (DQK == 192) { if (sc < 64) { S.st_k[NKL - 2] = ld8((Kp) + o_ + 128); S.st_k[NKL - 1] = ld8((Kp) + o_ + 32 * LDKV + 128); } }                                \
        if (TAB) { S.st_b = (Bp)[(k0) + lane]; } } while (0)
#define ATT_SWRITE_K(bf) do { if (DQK >= 128 || sc < 64) { *(bf16x8*)(K_lds + (bf) * SHM_K + kws) = S.st_k[0]; *(bf16x8*)(K_lds + (bf) * SHM_K + kws + 32 * RB) = S.st_k[1]; }   \
        if (DQK == 192) { if (sc < 64) { *(bf16x8*)(K_lds + (bf) * SHM_K + kws + 256) = S.st_k[NKL - 2]; *(bf16x8*)(K_lds + (bf) * SHM_K + kws + 32 * RB + 256) = S.st_k[NKL - 1]; } }  \
        if (TAB) { *(float*)(B_lds + (bf) * 256 + bws) = S.st_b; } } while (0)
#define ATT_SWRITE_V(bf) do { *(bf16x8*)(V_lds + (bf) * SHM_V + vst0) = S.st_v0; *(bf16x8*)(V_lds + (bf) * SHM_V + vst1) = S.st_v1; } while (0)
#define ATT_QLOAD(Qp) do { _Pragma("unroll") for (int d0 = 0; d0 < ND0R; ++d0) S.qr[d0] = ld8((Qp) + (size_t)(wid * QBLK + r32) * LDQ + d0 * 16 + hi * 8); } while (0)
#define ATT_QSPILL(Qp) do { if (QL > 0) { bf16x8 t_[QL > 0 ? QL : 1]; _Pragma("unroll") for (int j_ = 0; j_ < QL; ++j_) t_[j_] = ld8((Qp) + (size_t)(wid * QBLK + r32) * LDQ + (ND0R + j_) * 16 + hi * 8);   \
        _Pragma("unroll") for (int j_ = 0; j_ < QL; ++j_) *(bf16x8*)(Q_lds + j_ * 1024) = t_[j_]; } } while (0)
    static __device__ __forceinline__ void prime(const Ref& cur, char* lds, Seam& S) {
        const int tid = threadIdx.x, wid = __builtin_amdgcn_readfirstlane(tid >> 6), lane = tid & 63, r32 = lane & 31, hi = lane >> 5;
        const int sr = tid >> 4, sc = (tid & 15) * 8, kws = sr * RB + (sc >> 6) * 128 + (((sc & 63) * 2) ^ ((sr & 7) << 4));
        const int bws = ((((lane & 31) >> 2) & 1) * 32 + (lane >> 5) * 16 + (lane & 3) + 4 * ((lane & 31) >> 3)) * 4; (void)bws;
        char* K_lds = lds + OFF_K; char* B_lds = lds + OFF_B; (void)B_lds; char* Q_lds = lds + OFF_Q + wid * (QL * 1024) + lane * 16; (void)Q_lds;
        const int kb0 = cur.jlo * KVBLK;
        ATT_QLOAD(cur.Q);
        ATT_SLOAD(cur.K, cur.V, cur.kb, kb0); ATT_VMW(); ATT_SWRITE_K(0); ATT_QSPILL(cur.Q);
        __syncthreads();
    }
    template <class NF>
    static __device__ __forceinline__ void block(const Ref& cur, NF& nf, char* lds, Seam& S, const float SCALE) {
        const int tid = threadIdx.x, wid = __builtin_amdgcn_readfirstlane(tid >> 6), lane = tid & 63, r32 = lane & 31, hi = lane >> 5;
        const int j_lo = cur.jlo, j_hi = (cur.P0 + QB - 1) / KVBLK + 1;
        const int NT = j_hi - j_lo;
        const int qlo = cur.P0 + wid * QBLK, qm = qlo + r32 - 4 * hi;
        char* V_lds = lds; char* K_lds = lds + OFF_K; char* B_lds = lds + OFF_B; (void)B_lds; char* Q_lds = lds + OFF_Q + wid * (QL * 1024) + lane * 16; (void)Q_lds;
        float* ws = (float*)(lds + OFF_WS) + wid * 64; float* li_l = ws, * al_l = ws + 32;
        float m_reg = -1e30f, l_reg = 0; f32x16 o[4] = {};
        const int sr = tid >> 4, sc = (tid & 15) * 8, vst0 = v_st(sr, sc), vst1 = v_st(32 + sr, sc);
        const int kws = sr * RB + (sc >> 6) * 128 + (((sc & 63) * 2) ^ ((sr & 7) << 4));
        const int bws = ((((lane & 31) >> 2) & 1) * 32 + (lane >> 5) * 16 + (lane & 3) + 4 * ((lane & 31) >> 3)) * 4; (void)bws;
        const int vb0 = (int)(uintptr_t)V_lds + v_rd_base(lane);
        const bf16_t* Kh = cur.K; const bf16_t* Vh = cur.V; const float* Bh = cur.kb; const float bs = cur.bs; (void)bs;
#define ATT_RESC(a) do { if (__any((a) < 1.f)) { if (hi == 0) al_l[r32] = (a); asm volatile("s_waitcnt lgkmcnt(0)" ::: "memory");              \
                     _Pragma("unroll") for (int d_ = 0; d_ < 4; ++d_) _Pragma("unroll") for (int r = 0; r < 16; ++r) o[d_][r] *= al_l[crow(r, hi)]; } } while (0)
#define ATT_KBASE(t) ((j_lo + (t)) * KVBLK)
#define ATT_LB(t) ((BIAS == 3) ? bs * (float)(ATT_KBASE(t) - cur.P0 + 4 * hi) : 0.f)
#define ATT_MASKT(P0_, P1_, t, KB_) do { const int kb_ = ATT_KBASE(t); if (BIAS == 2) add_bias(P0_, P1_, B_lds, KB_, hi);                              \
        if (kb_ + KVBLK - 1 > qlo) mask_tile(P0_, P1_, qm - kb_); } while (0)
#define ATT_SEAM_K0() do { ATT_VMWN(ND0R); ATT_SWRITE_K(0); ATT_SBAR(); } while (0)
        f32x16 pA0, pA1, pB0, pB1; float mnA, mnB, alA, alB; bf16x8 pa0, pa1, pa2, pa3;
        ATT_SWRITE_V(0); ATT_SBAR();
        if (NT > 1) { ATT_SLOAD(Kh, Vh, Bh, ATT_KBASE(1)); }
        ATT_SBAR(); qkt<0>(pA0, pA1, K_lds, B_lds, Q_lds, r32, hi, S.qr, bs, ATT_LB(0));
        ATT_MASKT(pA0, pA1, 0, 0); partialSM(pA0, pA1, m_reg, mnA, alA, SCALE);
        if (NT > 1) { ATT_VMW(); ATT_SWRITE_V(1); ATT_SWRITE_K(1); }
        __syncthreads();
#define ATT_HALF_STEP(PX0, PX1, mnX, alX, PY0, PY1, alY, t, KB, VB, SB) do {                                                      \
        ATT_SBAR(); qkt<KB>(PX0, PX1, K_lds, B_lds, Q_lds, r32, hi, S.qr, bs, ATT_LB(t));                                                    \
        finishSM(PY0, PY1, alY, l_reg, pa0, pa1, pa2, pa3); ATT_SBAR();                                                           \
        if ((t) + 1 < NT) { ATT_SLOAD(Kh, Vh, Bh, ATT_KBASE((t) + 1)); ATT_SBAR(); }                                              \
        ATT_MASKT(PX0, PX1, (t), KB); ATT_SBAR(); pv_sm<VB>(o, vb0, pa0, pa1, pa2, pa3, PX0, PX1, m_reg, mnX, alX, SCALE);                        \
        __syncthreads();                                                                                                      \
        if ((t) + 1 < NT) { ATT_VMW(); ATT_SWRITE_V(SB); ATT_SWRITE_K(SB); }                                                      \
        ATT_RESC(alX); __syncthreads(); } while (0)
        bool issued = false;
        for (int t = 1; t + 1 < NT; t += 2) {
            if (!issued && t + 8 >= NT) { nf.issue(); issued = true; }
            ATT_HALF_STEP(pB0, pB1, mnB, alB, pA0, pA1, alA, t, 1, 0, 0);
            ATT_HALF_STEP(pA0, pA1, mnA, alA, pB0, pB1, alB, t + 1, 0, 1, 1);
        }
        const bool even = (NT & 1) == 0;
        if (even) { ATT_SBAR(); qkt<1>(pB0, pB1, K_lds, B_lds, Q_lds, r32, hi, S.qr, bs, ATT_LB(NT - 1)); ATT_SBAR(); }
        if (!issued) nf.issue();
        const Ref nxt = nf.get(cur); const int kbn = nxt.jlo * KVBLK;
        ATT_SLOAD(nxt.K, nxt.V, nxt.kb, kbn); ATT_SBAR();
        ATT_QLOAD(nxt.Q);
        ATT_SBAR();
        finishSM(pA0, pA1, alA, l_reg, pa0, pa1, pa2, pa3); ATT_SBAR();
        pv_tile<0>(o, vb0, pa0, pa1, pa2, pa3);
        if (even) { ATT_MASKT(pB0, pB1, NT - 1, 1); partialSM(pB0, pB1, m_reg, mnB, alB, SCALE); __syncthreads(); ATT_RESC(alB);
            finishSM(pB0, pB1, alB, l_reg, pa0, pa1, pa2, pa3); ATT_SBAR(); pv_tile<1>(o, vb0, pa0, pa1, pa2, pa3); }
        ATT_SBAR(); ATT_SEAM_K0();
        if (hi == 0) li_l[r32] = l_reg; asm volatile("s_waitcnt lgkmcnt(0)" ::: "memory");
        float rli[16];
#pragma unroll
        for (int r = 0; r < 16; ++r) rli[r] = __builtin_amdgcn_rcpf(li_l[crow(r, hi)]);
        TOut* Ow = cur.O + (size_t)(wid * QBLK) * LDO;
        if constexpr (sizeof(TOut) == 4) {
#pragma unroll
            for (int r = 0; r < 16; ++r) { const int orow = crow(r, hi);
#pragma unroll
                for (int d0 = 0; d0 < 4; ++d0) Ow[(size_t)orow * LDO + d0 * 32 + r32] = o[d0][r] * rli[r]; }
        } else {
            const bool odd = (r32 & 1) != 0; bf16_t* Ob = (bf16_t*)Ow + (odd ? 32 + r32 - 1 : r32);
#pragma unroll
            for (int r = 0; r < 16; ++r) { const int orow = crow(r, hi); const float v0 = o[0][r] * rli[r], v1 = o[1][r] * rli[r], v2 = o[2][r] * rli[r], v3 = o[3][r] * rli[r];
                const float s01 = odd ? v0 : v1, s23 = odd ? v2 : v3;
                const float g01 = __builtin_bit_cast(float, __builtin_amdgcn_update_dpp(0, __builtin_bit_cast(int, s01), 0xB1, 0xF, 0xF, false));
                const float g23 = __builtin_bit_cast(float, __builtin_amdgcn_update_dpp(0, __builtin_bit_cast(int, s23), 0xB1, 0xF, 0xF, false));
                const unsigned w01 = odd ? cvtpk(g01, v1) : cvtpk(v0, g01), w23 = odd ? cvtpk(g23, v3) : cvtpk(v2, g23);
                *(unsigned*)(Ob + (size_t)orow * LDO) = w01; *(unsigned*)(Ob + (size_t)orow * LDO + 64) = w23; }
        }
        ATT_QSPILL(nxt.Q);
        __syncthreads();
#undef ATT_RESC
#undef ATT_KBASE
#undef ATT_LB
#undef ATT_MASKT
#undef ATT_SEAM_K0
#undef ATT_HALF_STEP
    }
#undef ATT_VMW
#undef ATT_VMWN
#undef ATT_SLOAD
#undef ATT_SWRITE_K
#undef ATT_SWRITE_V
#undef ATT_QLOAD
#undef ATT_QSPILL
};
template <class B> struct StaticNext { typename B::Ref nxt; __device__ __forceinline__ void issue() {} __device__ __forceinline__ typename B::Ref get(const typename B::Ref&) { return nxt; } };
template <class B, class Dec>
__device__ __forceinline__ void stream(char* lds, int nblk, const Dec& dec, const float scale) {
    if (nblk <= 0) return;
    typename B::Ref cur = dec(0); typename B::Seam S;
    B::prime(cur, lds, S);
    for (int n = 0; n < nblk; ++n) {
        StaticNext<B> nf; nf.nxt = (n + 1 < nblk) ? dec(n + 1) : cur;
        B::block(cur, nf, lds, S, scale);
        cur = nf.nxt;
    }
}
template <class B, class Dec> struct QueueNext {
    unsigned* ctr; volatile __attribute__((address_space(3))) unsigned* slot; const Dec* dec; int total; unsigned claim; bool more; int pnext;
    __device__ __forceinline__ void issue() { if (threadIdx.x == 0) claim = __hip_atomic_fetch_add(ctr, 1u, __ATOMIC_RELAXED, __HIP_MEMORY_SCOPE_AGENT); }
    __device__ __forceinline__ typename B::Ref get(const typename B::Ref& cur) {
        if (threadIdx.x == 0) slot[2] = claim;
        __syncthreads();
        const int p = (int)slot[2]; more = p < total; pnext = p;
        return more ? (*dec)(p) : cur; }
    __device__ __forceinline__ typename B::Ref get_last() const { return (*dec)(pnext); }
};
template <class B, class Dec>
__device__ __forceinline__ void stream_dyn(char* lds, int total, unsigned* ctr, volatile __attribute__((address_space(3))) unsigned* slot, const Dec& dec, const float scale) {
    if (threadIdx.x == 0) slot[0] = __hip_atomic_fetch_add(ctr, 1u, __ATOMIC_RELAXED, __HIP_MEMORY_SCOPE_AGENT);
    __syncthreads();
    const int pc = (int)slot[0];
    if (pc >= total) return;
    typename B::Ref cur = dec(pc); typename B::Seam S;
    B::prime(cur, lds, S);
    QueueNext<B, Dec> nf; nf.ctr = ctr; nf.slot = slot; nf.dec = &dec; nf.total = total; nf.claim = 0u; nf.more = false;
    for (;;) {
        B::block(cur, nf, lds, S, scale);
        if (!nf.more) break;
        cur = nf.get_last(); }
}
#undef ATT_SBAR
}
#define GAS __attribute__((address_space(1)))
#define LAS __attribute__((address_space(3)))
typedef unsigned short bf16;
typedef unsigned v4u __attribute__((ext_vector_type(4)));
typedef float f32x4 __attribute__((ext_vector_type(4)));
typedef short bf16x8 __attribute__((ext_vector_type(8)));
typedef GAS unsigned gu32;
typedef GAS unsigned long long gu64;
#define RLX_AGENT __ATOMIC_RELAXED, __HIP_MEMORY_SCOPE_AGENT
#define LDS_WAIT() asm volatile("s_waitcnt lgkmcnt(0)" ::: "memory")
#define VM_WAIT() asm volatile("s_waitcnt vmcnt(0)" ::: "memory")
__device__ __forceinline__ unsigned long long rt() { return __builtin_amdgcn_s_memrealtime(); }
__device__ __forceinline__ unsigned f2bf(float f) { unsigned u = __builtin_bit_cast(unsigned, f); return (u + 0x7fffu + ((u >> 16) & 1u)) >> 16; }
__device__ __forceinline__ unsigned pk2(float lo, float hi) { return f2bf(lo) | (f2bf(hi) << 16); }

#define XB_TMO      128
#define XB_XCNT(j)  (256  + 64 * (j))
#define XB_XSUB(j)  (1280 + 64 * (j))
#define XB_XGEN(j)  (2304 + 64 * (j))
#define XB_TOP      3328
#define XB_TOPGEN   3392
#define XCD_BAR_WORDS 3456
#define XB_SPIN_CAP (1u << 18)

__device__ __forceinline__ unsigned xb_ld(unsigned* p)              { return __hip_atomic_load(p, __ATOMIC_RELAXED, __HIP_MEMORY_SCOPE_AGENT); }
__device__ __forceinline__ unsigned xb_add(unsigned* p, unsigned v) { return __hip_atomic_fetch_add(p, v, __ATOMIC_RELAXED, __HIP_MEMORY_SCOPE_AGENT); }
__device__ __forceinline__ unsigned xb_xcc_id() { return (unsigned)__builtin_amdgcn_s_getreg((3 << 11) | 20) & 0xFu; }
#define XB_SPIN(cond, bar) do { unsigned _sp = 0; while (cond) { __builtin_amdgcn_s_sleep(1); \
    if ((++_sp & 255u) == 0u) { if (xb_ld(&(bar)[XB_TMO])) break; if (_sp > XB_SPIN_CAP) { atomicAdd(&(bar)[XB_TMO], 1u); break; } } } } while (0)

struct XcdBarrier {
    unsigned* bar; unsigned x;
    volatile LAS unsigned* st;
};

__device__ __forceinline__ XcdBarrier xcd_barrier_post(unsigned* bar, volatile LAS unsigned* st) {
    XcdBarrier b; b.bar = bar; b.x = xb_xcc_id(); b.st = st;
    if (threadIdx.x == 0) (void)xb_add(&bar[XB_XCNT(b.x)], 1u);
    return b;
}
__device__ __forceinline__ void xcd_barrier_complete(unsigned* bar, unsigned x, unsigned& nloc, unsigned& nx) {
    const unsigned G = gridDim.x * gridDim.y * gridDim.z;
    unsigned sum, cnt, mine, sp = 0u;
    for (;;) {
        sum = 0u; cnt = 0u; mine = 0u;
#pragma unroll
        for (unsigned j = 0; j < 16; ++j) { const unsigned c = xb_ld(&bar[XB_XCNT(j)]); sum += c; cnt += (c > 0u) ? 1u : 0u; mine = (j == x) ? c : mine; }
        if (sum == G) break;
        __builtin_amdgcn_s_sleep(1);
        if ((++sp & 255u) == 0u) { if (xb_ld(&bar[XB_TMO])) break; if (sp > XB_SPIN_CAP) { atomicAdd(&bar[XB_TMO], 1u); break; } }
    }
    nloc = mine > 0u ? mine : 1u; nx = cnt > 0u ? cnt : 1u;
}

__device__ __forceinline__ void xcd_barrier(const XcdBarrier& b) {
    asm volatile("s_waitcnt vmcnt(0)" ::: "memory");
    __syncthreads();
    if (threadIdx.x == 0) {
        unsigned* bar = b.bar;
        __builtin_amdgcn_s_waitcnt(0);
        unsigned nloc = b.st[0], nx = b.st[1];
        if (nloc == 0u) { xcd_barrier_complete(bar, b.x, nloc, nx); b.st[0] = nloc; b.st[1] = nx; }
        const unsigned old = xb_add(&bar[XB_XSUB(b.x)], 1u);
        const unsigned gen = old / nloc;
        if (old + 1u == (gen + 1u) * nloc) {
            __builtin_amdgcn_fence(__ATOMIC_RELEASE, "agent");
            asm volatile("s_waitcnt vmcnt(0)" ::: "memory");
            const unsigned og = xb_add(&bar[XB_TOP], 1u);
            const unsigned tg = og / nx;
            if (og + 1u == (tg + 1u) * nx) xb_add(&bar[XB_TOPGEN], 1u);
            else XB_SPIN(xb_ld(&bar[XB_TOPGEN]) == tg, bar);
            __builtin_amdgcn_fence(__ATOMIC_ACQUIRE, "agent");
            xb_add(&bar[XB_XGEN(b.x)], 1u);
            asm volatile("s_waitcnt vmcnt(0)" ::: "memory");
        } else {
            XB_SPIN(xb_ld(&bar[XB_XGEN(b.x)]) == gen, bar);
            __builtin_amdgcn_fence(__ATOMIC_ACQUIRE, "agent");
            asm volatile("s_waitcnt vmcnt(0)" ::: "memory");
        }
    }
    __syncthreads();
}
constexpr int NWAVES = 8;
#ifndef MK_PER_PHASE
#define MK_PER_PHASE 0
#endif
constexpr int NPH = 21;

constexpr int S = 16384, DM = 2048, FF = 5632, NE = 8;
constexpr int N_IN0 = 4160, N_IN0P = 4352, N_IN1 = 6160, N_IN1P = 6400, NP0 = 4096;
constexpr float SCALE_A = 0.125f, SCALE_B = 0.07216878364870322f, SCALE_C = 0.08838834764831845f;

constexpr size_t MiB = 1u << 20;
constexpr size_t WS_CTL = 0, CTL_ZERO_BYTES = 1 * MiB;
constexpr size_t WS_ROPE = 1 * MiB, WS_KBC = 6 * MiB, WS_LOGF = 7 * MiB, WS_CSUM = 8 * MiB, WS_ROUTE = 8 * MiB + 512 * 1024, WS_CNTG = 9 * MiB, WS_TOT = 9 * MiB + 64 * 1024, WS_SCL = 9 * MiB + 64 * 1024 + 1024  ,
                 WS_TOKPOS = 9 * MiB + 512 * 1024, WS_GATES = 10 * MiB, WS_STATA = 5 * MiB, WS_STATC = 5 * MiB + 64 * 1024, WS_FPART = 11 * MiB, WS_KPART = 1096 * MiB, WS_PART = 880 * MiB,
                 WS_PS = 1 * MiB  , WS_RSTD = 5 * MiB + 256 * 1024, WS_RSTDS = 5 * MiB + 512 * 1024;
constexpr size_t WS_WIN0 = 16 * MiB, WS_WUQ = 33 * MiB, WS_WUKV = 35 * MiB, WS_WOUT0 = 37 * MiB, WS_WGU0 = 45 * MiB, WS_WD0 = 89 * MiB, WS_WIN1 = 111 * MiB, WS_WOUT1 = 136 * MiB,
                 WS_WGU1 = 144 * MiB, WS_WD1 = 496 * MiB;
constexpr size_t WS_XN = 672 * MiB;
constexpr size_t WS_PROJ0 = 736 * MiB, WS_CQN = 872 * MiB, WS_CKVN = 888 * MiB, WS_KF = 904 * MiB  , WS_QB = 984 * MiB, WS_OA = 1032 * MiB, WS_MIX = 1160 * MiB, WS_HMID0 = 736 * MiB;
constexpr size_t WS_A8 = 984 * MiB  , WS_QKV1 = 736 * MiB, WS_O1 = 928 * MiB, WS_AS = 736 * MiB, WS_HMS = 1024 * MiB, WS_YS = 736 * MiB;
constexpr size_t WS_END = 1398 * MiB;
constexpr int MPAD = 34816;
static_assert(WS_WD1 + (size_t)NE * DM * FF * 2 <= WS_XN && WS_HMS + (size_t)MPAD * FF * 2 <= WS_END && WS_YS + (size_t)MPAD * DM * 4 <= WS_HMS && WS_MIX + (size_t)S * DM * 2 <= WS_END, "d_ws map");
constexpr int CW_TMO = 0, CW_CODE = 1, CW_BAR = 4096, CW_QA = 8192, CW_QC = 8256, CW_SPLIT = 12288;

constexpr int RING_BYTES = 150528;
constexpr int LDSCTL_OFF = RING_BYTES, MISC_OFF = LDSCTL_OFF + 320;
constexpr int LDS_BYTES = RING_BYTES + 512;
static_assert(MISC_OFF + 128 <= LDS_BYTES, "LDS map");

typedef unsigned v2u __attribute__((ext_vector_type(2)));
__device__ __forceinline__ float bflo(unsigned w) { return __builtin_bit_cast(float, w << 16); }
__device__ __forceinline__ float bfhi(unsigned w) { return __builtin_bit_cast(float, w & 0xffff0000u); }
__device__ __forceinline__ float wave_sum(float v) {
#pragma unroll
    for (int o = 1; o < 64; o <<= 1) v += __shfl_xor(v, o);
    return v;
}
__device__ const float ROPE_INV[32] = {1.000000000e+00f, 7.498942614e-01f, 5.623413324e-01f, 4.216965139e-01f, 3.162277639e-01f, 2.371373773e-01f, 1.778279394e-01f, 1.333521307e-01f,
    1.000000015e-01f, 7.498941571e-02f, 5.623413250e-02f, 4.216965288e-02f, 3.162277490e-02f, 2.371373773e-02f, 1.778279431e-02f, 1.333521493e-02f, 9.999999776e-03f, 7.498941850e-03f,
    5.623413250e-03f, 4.216964822e-03f, 3.162277630e-03f, 2.371373586e-03f, 1.778279431e-03f, 1.333521446e-03f, 1.000000047e-03f, 7.498942432e-04f, 5.623413017e-04f, 4.216965172e-04f,
    3.162277571e-04f, 2.371373703e-04f, 1.778279402e-04f, 1.333521504e-04f};

struct Args { const float* in[27]; float* out; unsigned char* ws; int ph_lo, ph_hi; };
enum { I_X = 0, I_EV_ATTN_NORM, I_EV_W_IN, I_EV_Q_NORM, I_EV_W_UQ, I_EV_KV_NORM, I_EV_W_UKV, I_EV_LQ1, I_EV_LK1, I_EV_LQ2, I_EV_LK2, I_EV_SUBLN, I_EV_W_OUT, I_EV_FFN_NORM, I_EV_W_GATE, I_EV_W_UP,
       I_EV_W_DOWN, I_OD_ATTN_NORM, I_OD_W_IN, I_OD_FBIAS, I_OD_W_OUT, I_OD_FFN_NORM, I_OD_ROUTER, I_OD_W_GATE, I_OD_W_UP, I_OD_W_DOWN, I_FINAL_NORM };

__device__ __forceinline__ int rowmap(int type, int n) {
    if (type == 1) return (n >> 7) * 256 + (n & 127);
    if (type == 2) return (n >> 7) * 256 + 128 + (n & 127);
    if (type == 3) { const int h = n / 192, w = n - h * 192; if (w < 128) return h * 128 + w; const int i = w & 31, half = (w - 128) >> 5; return (4 + (h >> 2)) * 256 + half * 128 + (h & 3) * 32 + i; }
    return n;
}
using pg8::pk8x4;
constexpr float H8_SCALE = 8.f;
__device__ __forceinline__ unsigned pki8x4(float a, float b, float c, float d) {
    const int ia = (int)__builtin_rintf(__builtin_amdgcn_fmed3f(a, -127.f, 127.f)), ib = (int)__builtin_rintf(__builtin_amdgcn_fmed3f(b, -127.f, 127.f)), ic = (int)__builtin_rintf(__builtin_amdgcn_fmed3f(c, -127.f, 127.f)), id = (int)__builtin_rintf(__builtin_amdgcn_fmed3f(d, -127.f, 127.f));
    return ((unsigned)ia & 255u) | (((unsigned)ib & 255u) << 8) | (((unsigned)ic & 255u) << 16) | ((unsigned)id << 24); }
template <bool PAIR, bool GAIN>
__device__ __forceinline__ float w_clip_t(const float* Wa, const float* Wb, int N, const float* gain, int lane) {
    f32x4 a[16], b[PAIR ? 16 : 1]; float g[GAIN ? 16 : 1];
#pragma unroll
    for (int k = 0; k < 16; ++k) { a[k] = *(const GAS f32x4*)(Wa + (size_t)k * N + 4 * lane); if (PAIR) b[PAIR ? k : 0] = *(const GAS f32x4*)(Wb + (size_t)k * N + 4 * lane); if (GAIN) g[GAIN ? k : 0] = gain[k]; }
    float ss = 0.f;
#pragma unroll
    for (int k = 0; k < 16; ++k) { const float gg = GAIN ? g[GAIN ? k : 0] : 1.f; const f32x4 x = a[k] * gg; ss += (x.x * x.x + x.y * x.y) + (x.z * x.z + x.w * x.w);
        if (PAIR) { const f32x4 y = b[PAIR ? k : 0] * gg; ss += (y.x * y.x + y.y * y.y) + (y.z * y.z + y.w * y.w); } }
    return fmaxf(4.f * sqrtf(wave_sum(ss) * (PAIR ? 1.f / 8192.f : 1.f / 4096.f)), 1e-30f);
}
__device__ __forceinline__ float w_clip(const float* Wa, const float* Wb, int N, const float* gain, int lane) {
    if (Wb) return gain ? w_clip_t<true, true>(Wa, Wb, N, gain, lane) : w_clip_t<true, false>(Wa, Wb, N, gain, lane);
    return gain ? w_clip_t<false, true>(Wa, Wb, N, gain, lane) : w_clip_t<false, false>(Wa, Wb, N, gain, lane);
}
__device__ __forceinline__ float w_clip_experts(const float* Wa, const float* Wb, int K, int N, const float* gain, int lane) {
    f32x4 a[NE][2], b[NE][2]; const float g0 = gain ? gain[0] : 1.f, g1 = gain ? gain[1] : 1.f;
#pragma unroll
    for (int e = 0; e < NE; ++e)
#pragma unroll
        for (int k = 0; k < 2; ++k) { a[e][k] = *(const GAS f32x4*)(Wa + ((size_t)e * K + k) * N + 4 * lane); b[e][k] = *(const GAS f32x4*)(Wb + ((size_t)e * K + k) * N + 4 * lane); }
    float c = 0.f;
#pragma unroll
    for (int e = 0; e < NE; ++e) { float ss = 0.f;
#pragma unroll
        for (int k = 0; k < 2; ++k) { const float g = k ? g1 : g0; const f32x4 x = a[e][k] * g, y = b[e][k] * g;
            ss += ((x.x * x.x + x.y * x.y) + (x.z * x.z + x.w * x.w)) + ((y.x * y.x + y.y * y.y) + (y.z * y.z + y.w * y.w)); }
        c = fmaxf(c, wave_sum(ss)); }
    return fmaxf(4.f * sqrtf(c * (1.f / 1024.f)), 1e-30f);
}
__device__ __forceinline__ float w8_scale_experts(const float* W, int K, int N, int lane) {
    f32x4 a[NE][2];
#pragma unroll
    for (int e = 0; e < NE; ++e)
#pragma unroll
        for (int k = 0; k < 2; ++k) a[e][k] = *(const GAS f32x4*)(W + ((size_t)e * K + k) * N + 4 * lane);
    float c = 0.f;
#pragma unroll
    for (int e = 0; e < NE; ++e) { float ss = 0.f;
#pragma unroll
        for (int k = 0; k < 2; ++k) { const f32x4 x = a[e][k]; ss += (x.x * x.x + x.y * x.y) + (x.z * x.z + x.w * x.w); }
        c = fmaxf(c, wave_sum(ss)); }
    return exp2f(floorf(log2f(2.f / fmaxf(sqrtf(c * (1.f / 512.f)), 1e-30f))));
}
struct TrJob { const float* W; int K, N; bf16* WT; int type, nbn, per, rows_per; const float* gain; int f8; float qs; int nb_lo; };
__device__ __forceinline__ void tr_load(const TrJob& J, int it, int lane, f32x4 (&v)[16]) {
    const int s = it / J.per, r = it - s * J.per, kb = r / J.nbn, nb = J.nb_lo + (r - kb * J.nbn);
    const int k0 = 64 * kb, n0 = 64 * nb, n4 = (lane & 15) * 4, kq = lane >> 4; const float* W = J.W + (size_t)s * J.K * J.N;
#pragma unroll
    for (int j = 0; j < 16; ++j) { const int k = 4 * j + kq; v[j] = (n0 + n4 < J.N) ? *(const GAS f32x4*)(W + (size_t)(k0 + k) * J.N + n0 + n4) : (f32x4){0.f, 0.f, 0.f, 0.f}; }
}
__device__ __forceinline__ void tr_store(const TrJob& J, int it, int lane, const f32x4 (&v)[16], LAS float* scr) {
    const int s = it / J.per, r = it - s * J.per, kb = r / J.nbn, nb = J.nb_lo + (r - kb * J.nbn);
    const int k0 = 64 * kb, n0 = 64 * nb, n4 = (lane & 15) * 4, kq = lane >> 4; bf16* WT = J.WT + (size_t)s * J.rows_per * J.K;
#pragma unroll
    for (int j = 0; j < 16; ++j) { const int k = 4 * j + kq; LAS float* d = scr + k * 65 + n4; d[0] = v[j].x; d[1] = v[j].y; d[2] = v[j].z; d[3] = v[j].w; }
    LDS_WAIT(); asm volatile("" ::: "memory");
    if (J.f8) {
        const int c4 = lane & 3; f32x4 g[4] = {(f32x4){1.f, 1.f, 1.f, 1.f}, (f32x4){1.f, 1.f, 1.f, 1.f}, (f32x4){1.f, 1.f, 1.f, 1.f}, (f32x4){1.f, 1.f, 1.f, 1.f}};
        if (J.gain) {
#pragma unroll
            for (int t = 0; t < 4; ++t) g[t] = *(const GAS f32x4*)(J.gain + k0 + 16 * c4 + 4 * t); }
#pragma unroll
        for (int t = 0; t < 4; ++t) g[t] = g[t] * J.qs;
#pragma unroll
        for (int i = 0; i < 4; ++i) { const int n = 16 * i + (lane >> 2); const LAS float* q = scr + (16 * c4) * 65 + n; v4u o;
            if (J.f8 == 2) { o.x = pki8x4(q[0 * 65] * g[0].x, q[1 * 65] * g[0].y, q[2 * 65] * g[0].z, q[3 * 65] * g[0].w); o.y = pki8x4(q[4 * 65] * g[1].x, q[5 * 65] * g[1].y, q[6 * 65] * g[1].z, q[7 * 65] * g[1].w);
                             o.z = pki8x4(q[8 * 65] * g[2].x, q[9 * 65] * g[2].y, q[10 * 65] * g[2].z, q[11 * 65] * g[2].w); o.w = pki8x4(q[12 * 65] * g[3].x, q[13 * 65] * g[3].y, q[14 * 65] * g[3].z, q[15 * 65] * g[3].w); }
            else { o.x = pk8x4(q[0 * 65] * g[0].x, q[1 * 65] * g[0].y, q[2 * 65] * g[0].z, q[3 * 65] * g[0].w); o.y = pk8x4(q[4 * 65] * g[1].x, q[5 * 65] * g[1].y, q[6 * 65] * g[1].z, q[7 * 65] * g[1].w);
                   o.z = pk8x4(q[8 * 65] * g[2].x, q[9 * 65] * g[2].y, q[10 * 65] * g[2].z, q[11 * 65] * g[2].w); o.w = pk8x4(q[12 * 65] * g[3].x, q[13 * 65] * g[3].y, q[14 * 65] * g[3].z, q[15 * 65] * g[3].w); }
            if (n0 + n < ((J.N + 31) & ~31)) *(GAS v4u*)((unsigned char*)J.WT + ((size_t)s * J.rows_per + rowmap(J.type, n0 + n)) * J.K + k0 + 16 * c4) = o; }
    } else {
        const int c = lane & 7;
        f32x4 g0 = (f32x4){1.f, 1.f, 1.f, 1.f}, g1 = g0; if (J.gain) { g0 = *(const GAS f32x4*)(J.gain + k0 + 8 * c); g1 = *(const GAS f32x4*)(J.gain + k0 + 8 * c + 4); }
#pragma unroll
        for (int i = 0; i < 8; ++i) { const int n = 8 * i + (lane >> 3); const LAS float* q = scr + (8 * c) * 65 + n;
            const float f0 = q[0 * 65] * g0.x, f1 = q[1 * 65] * g0.y, f2 = q[2 * 65] * g0.z, f3 = q[3 * 65] * g0.w, f4 = q[4 * 65] * g1.x, f5 = q[5 * 65] * g1.y, f6 = q[6 * 65] * g1.z, f7 = q[7 * 65] * g1.w;
            v4u o; o.x = pg8::cvt_pk_bf16(f0, f1); o.y = pg8::cvt_pk_bf16(f2, f3); o.z = pg8::cvt_pk_bf16(f4, f5); o.w = pg8::cvt_pk_bf16(f6, f7);
            if (n0 + n < ((J.N + 31) & ~31)) *(GAS v4u*)(WT + (size_t)rowmap(J.type, n0 + n) * J.K + k0 + 8 * c) = o; }
    }
    LDS_WAIT(); asm volatile("" ::: "memory");
}
__device__ __forceinline__ void tr_matrix(const float* W, int K, int N, int NS, int rows_per, bf16* WT, int type, LAS float* scr, int gw, int NGW, int lane, const float* gain = nullptr, int f8 = 0, float qs = 0.f, int nb_lo = 0) {
    TrJob J; J.gain = gain; J.f8 = f8; J.qs = qs; J.nb_lo = nb_lo; J.W = W; J.K = K; J.N = N; J.WT = WT; J.type = type; J.nbn = (N + 63) / 64 - nb_lo; J.per = J.nbn * (K / 64); J.rows_per = rows_per;
    const int total = J.per * NS; int it = gw; if (it >= total) return;
    f32x4 va[16], vb[16];
    tr_load(J, it, lane, va);
    for (;;) {
        const int it2 = it + NGW; const bool h2 = it2 < total; if (h2) tr_load(J, it2, lane, vb);
        tr_store(J, it, lane, va, scr);
        if (!h2) break;
        const int it3 = it2 + NGW; const bool h3 = it3 < total; if (h3) tr_load(J, it3, lane, va);
        tr_store(J, it2, lane, vb, scr);
        if (!h3) break;
        it = it3;
    }
}
__device__ __forceinline__ void rms_row_bf16(const float* xrow, const float* g, bf16* orow, float eps, int lane, unsigned char* o8row = nullptr, float* cst = nullptr, float wsc = 0.f) {
    const GAS f32x4* xr = (const GAS f32x4*)xrow + lane; const GAS f32x4* gr = (const GAS f32x4*)g + lane;
    f32x4 v[8]; float s = 0.f;
#pragma unroll
    for (int j = 0; j < 8; ++j) { v[j] = xr[64 * j]; s += (v[j].x * v[j].x + v[j].y * v[j].y) + (v[j].z * v[j].z + v[j].w * v[j].w); }
    const float rstd = 1.0f / sqrtf(wave_sum(s) * (1.f / DM) + eps);
    GAS unsigned long long* o8 = (GAS unsigned long long*)orow + lane; float am = 0.f;
#pragma unroll
    for (int j = 0; j < 8; ++j) { const f32x4 gg = gr[64 * j]; const f32x4 y = (v[j] * rstd) * gg; o8[64 * j] = (unsigned long long)pk2(y.x, y.y) | ((unsigned long long)pk2(y.z, y.w) << 32);
        v[j] = y; am = fmaxf(am, fmaxf(fmaxf(fabsf(y.x), fabsf(y.y)), fmaxf(fabsf(y.z), fabsf(y.w)))); }
    if (o8row) {
#pragma unroll
        for (int o = 32; o > 0; o >>= 1) am = fmaxf(am, __shfl_xor(am, o));
        am = fmaxf(am, 1e-30f); const float qs = 127.f / am; GAS unsigned* q = (GAS unsigned*)o8row + lane;
#pragma unroll
        for (int j = 0; j < 8; ++j) q[64 * j] = pki8x4(v[j].x * qs, v[j].y * qs, v[j].z * qs, v[j].w * qs);
        if (lane == 0) *cst = (am * (1.f / 127.f)) * wsc; }
}
__device__ __forceinline__ void rstd_rows(const float* ps, float* rstd, int b, int G, int tid) {
    for (int row = b * (NWAVES * 64) + tid; row < S; row += G * NWAVES * 64) { const GAS f32x4* p = (const GAS f32x4*)(ps + (size_t)row * 32); float s = 0.f;
#pragma unroll
        for (int j = 0; j < 8; ++j) { const f32x4 v = p[j]; s += (v.x + v.y) + (v.z + v.w); }
        rstd[row] = 1.0f / sqrtf(s * (1.f / DM) + 1e-6f); }
}
__device__ __forceinline__ void rows_i8(const bf16* H, const float* ps, float* rstd, unsigned char* A8, float* cst, const float wsc, int gw, int NGW, int lane) {
    for (int row = gw; row < S; row += NGW) {
        const float rs = 1.0f / sqrtf(wave_sum(lane < 32 ? ps[(size_t)row * 32 + lane] : 0.f) * (1.f / DM) + 1e-6f);
        const GAS v4u* src = (const GAS v4u*)(H + (size_t)row * DM) + lane; const v4u x[4] = {src[0], src[64], src[128], src[192]}; float am = 0.f;
#pragma unroll
        for (int j = 0; j < 4; ++j) { am = fmaxf(am, fmaxf(fmaxf(fabsf(bflo(x[j].x)), fabsf(bfhi(x[j].x))), fmaxf(fabsf(bflo(x[j].y)), fabsf(bfhi(x[j].y))))); am = fmaxf(am, fmaxf(fmaxf(fabsf(bflo(x[j].z)), fabsf(bfhi(x[j].z))), fmaxf(fabsf(bflo(x[j].w)), fabsf(bfhi(x[j].w))))); }
#pragma unroll
        for (int o = 32; o > 0; o >>= 1) am = fmaxf(am, __shfl_xor(am, o));
        am = fmaxf(am, 1e-30f); const float qs = 127.f / am;
        GAS v2u* dst = (GAS v2u*)(A8 + (size_t)row * DM) + lane;
#pragma unroll
        for (int j = 0; j < 4; ++j) { v2u o; o.x = pki8x4(bflo(x[j].x) * qs, bfhi(x[j].x) * qs, bflo(x[j].y) * qs, bfhi(x[j].y) * qs); o.y = pki8x4(bflo(x[j].z) * qs, bfhi(x[j].z) * qs, bflo(x[j].w) * qs, bfhi(x[j].w) * qs); dst[64 * j] = o; }
        if (lane == 0) { rstd[row] = rs; cst[row] = (am * (1.f / 127.f)) * rs * wsc; } }
}
__device__ __forceinline__ void rms512_bf16(const bf16* src, const float* g, bf16* dst, int lane) {
    const v4u raw = *(const GAS v4u*)(src + 8 * lane);
    float x[8] = {bflo(raw.x), bfhi(raw.x), bflo(raw.y), bfhi(raw.y), bflo(raw.z), bfhi(raw.z), bflo(raw.w), bfhi(raw.w)};
    float s = 0.f;
#pragma unroll
    for (int e = 0; e < 8; ++e) s += x[e] * x[e];
    const float rstd = 1.0f / sqrtf(wave_sum(s) * (1.f / 512.f) + 1e-6f);
    const f32x4 g0 = *(const GAS f32x4*)(g + 8 * lane), g1 = *(const GAS f32x4*)(g + 8 * lane + 4);
    v4u o; o.x = pk2(x[0] * rstd * g0.x, x[1] * rstd * g0.y); o.y = pk2(x[2] * rstd * g0.z, x[3] * rstd * g0.w); o.z = pk2(x[4] * rstd * g1.x, x[5] * rstd * g1.y); o.w = pk2(x[6] * rstd * g1.z, x[7] * rstd * g1.w);
    *(GAS v4u*)(dst + 8 * lane) = o;
}
__device__ __forceinline__ void sincos_d(float ang, float& sn, float& cs) {
    const double t0 = (double)ang * 0.15915494309189535; const double t = t0 - __builtin_rint(t0); const double x = t * 6.283185307179586, x2 = x * x;
    double sp = -1.0 / 51090942171709440000.0;
    sp = sp * x2 + 1.0 / 121645100408832000.0; sp = sp * x2 - 1.0 / 355687428096000.0; sp = sp * x2 + 1.0 / 1307674368000.0; sp = sp * x2 - 1.0 / 6227020800.0; sp = sp * x2 + 1.0 / 39916800.0;
    sp = sp * x2 - 1.0 / 362880.0; sp = sp * x2 + 1.0 / 5040.0; sp = sp * x2 - 1.0 / 120.0; sp = sp * x2 + 1.0 / 6.0; sp = sp * x2 - 1.0; sn = (float)(-sp * x);
    double cp = 1.0 / 1124000727777607680000.0;
    cp = cp * x2 - 1.0 / 2432902008176640000.0; cp = cp * x2 + 1.0 / 6402373705728000.0; cp = cp * x2 - 1.0 / 20922789888000.0; cp = cp * x2 + 1.0 / 87178291200.0; cp = cp * x2 - 1.0 / 479001600.0;
    cp = cp * x2 + 1.0 / 3628800.0; cp = cp * x2 - 1.0 / 40320.0; cp = cp * x2 + 1.0 / 720.0; cp = cp * x2 - 1.0 / 24.0; cp = cp * x2 + 0.5; cp = cp * x2 - 1.0; cs = (float)(-cp);
}

typedef att::Body<64, NP0, NP0, 2048, 3, 0, bf16> BodyA;
typedef att::Body<192, 1536, 2560, 2048, 0, 8, bf16> BodyB;
typedef att::Body<128, 6144, 6144, 2048, 1, 2, bf16> BodyC;
struct DecB { const bf16* Qb; const bf16* KV; bf16* MIX; int vcu, G;
    __device__ __forceinline__ BodyB::Ref operator()(int n) const { const int it = vcu + (n >> 1) * G, h = it >> 5, x = it & 31, qb = (n & 1) ? 63 - x : x;
        BodyB::Ref r; r.Q = Qb + (size_t)(qb * 256) * 1536 + h * 192; r.K = KV + h * 320; r.V = KV + h * 320 + 192; r.O = MIX + (size_t)(qb * 256) * 2048 + 1024 + h * 128; r.kb = nullptr; r.bs = 0.f; r.P0 = qb * 256; r.jlo = 0; return r; } };
static_assert(BodyA::LDS_BYTES <= RING_BYTES && BodyB::LDS_BYTES <= RING_BYTES && BodyC::LDS_BYTES <= RING_BYTES, "attention LDS");
static_assert(BodyA::LDS_BYTES <= 143360 && BodyC::LDS_BYTES <= 143360 && 143360 + 4096 <= RING_BYTES, "sorted keys above the list-driven bodies");

constexpr float SKIP_THRESH = 106.0f;
constexpr int KEYS_OFF = 143360;
template <int MODE>
__device__ __forceinline__ int build_list(LAS unsigned char* scr, volatile LAS unsigned* list, const float* stats, const float* kbtab, float scale, int vcu, int G, int tid) {
    LAS float* KmH = (LAS float*)scr; LAS float* red = (LAS float*)(scr + 256); LAS unsigned* keys = (LAS unsigned*)(scr + KEYS_OFF); LAS float* te = (LAS float*)(scr + 16384);
    { const int vh = tid & 15, part = tid >> 4; float m = 0.f; for (int c = part; c < 256; c += 32) m = fmaxf(m, stats[c * 32 + 16 + vh]); red[part * 16 + vh] = m; }
    if (MODE == 1) {
#pragma unroll
        for (int i = 0; i < 8; ++i) { const int idx = tid + 512 * i; te[idx] = kbtab[(size_t)(idx >> 8) * S + 64 * (idx & 255) + 63]; } }
    __syncthreads();
    if (tid < 16) { float m = 0.f; for (int q = 0; q < 32; ++q) m = fmaxf(m, red[q * 16 + tid]); KmH[tid] = m; }
    __syncthreads();
#pragma unroll 1
    for (int it = tid; it < 1024; it += NWAVES * 64) { const int vh = it >> 6, qb = it & 63, P0 = qb * 256;
        float q2 = 0.f;
#pragma unroll
        for (int i = 0; i < 4; ++i) q2 = fmaxf(q2, stats[(4 * qb + i) * 32 + vh]);
        const float Bq = scale * sqrtf(q2 * KmH[vh]) * 1.01f + 0.05f, thr = SKIP_THRESH + 2.f * Bq;
        int jlo;
        if (MODE == 0) { const float slope = 1.0f / (float)(2 << (vh >> 1)); const float X = (float)P0 - thr / slope - 63.f; jlo = X > 0.f ? (int)floorf(X * (1.f / 64.f)) : 0; }
        else { int lo = 0, hi = 4 * qb;
            const float base = qb > 0 ? te[vh * 256 + 4 * qb - 1] : 0.f;
            while (lo < hi) { const int mid = (lo + hi) >> 1; if (scale * (te[vh * 256 + mid] - base) >= -thr) hi = mid; else lo = mid + 1; }
            jlo = lo; }
        jlo = jlo < 0 ? 0 : (jlo > 4 * qb ? 4 * qb : jlo);
        keys[it] = ((unsigned)(4 * (qb + 1) - jlo) << 10) | (unsigned)(1023 - it); }
    __syncthreads();
#pragma unroll 1
    for (int k = 2; k <= 1024; k <<= 1)
#pragma unroll 1
        for (int j = k >> 1; j > 0; j >>= 1) { const int i = ((tid & ~(j - 1)) << 1) | (tid & (j - 1)), l = i | j; const unsigned a = keys[i], b = keys[l]; const bool up = (i & k) == 0;
            if ((a < b) == up) { keys[i] = b; keys[l] = a; }
            __syncthreads(); }
    return 1024;
}
struct DecAL { const bf16* proj; bf16* OA; volatile LAS unsigned* keys;
    __device__ __forceinline__ BodyA::Ref operator()(int n) const { const unsigned key = (unsigned)__builtin_amdgcn_readfirstlane((int)keys[n]); const int it = 1023 - (int)(key & 1023u), vh = it >> 6, qb = it & 63, h = vh >> 1; const unsigned e = (unsigned)(4 * (qb + 1) - (int)(key >> 10)) << 16;
        BodyA::Ref r; r.Q = proj + (size_t)(qb * 256) * NP0 + vh * 64; r.K = proj + 1024 + vh * 64; r.V = proj + 2048 + h * 128; r.O = OA + (size_t)(qb * 256) * 2048 + vh * 128; r.kb = nullptr; r.bs = 4.0f / (float)(1 << h); r.P0 = qb * 256; r.jlo = (int)(e >> 16); return r; } };
struct DecCL { const bf16* QKV; bf16* O1; const float* kb; volatile LAS unsigned* keys;
    __device__ __forceinline__ BodyC::Ref operator()(int n) const { const unsigned key = (unsigned)__builtin_amdgcn_readfirstlane((int)keys[n]); const int it = 1023 - (int)(key & 1023u), h = it >> 6, qb = it & 63; const unsigned e = (unsigned)(4 * (qb + 1) - (int)(key >> 10)) << 16;
        BodyC::Ref r; r.Q = QKV + (size_t)(qb * 256) * 6144 + h * 128; r.K = QKV + 2048 + h * 128; r.V = QKV + 4096 + h * 128; r.O = O1 + (size_t)(qb * 256) * 2048 + h * 128; r.kb = kb + h * S; r.bs = 0.f; r.P0 = qb * 256; r.jlo = (int)(e >> 16); return r; } };

__global__ void __launch_bounds__(NWAVES * 64, 2) mk_fwd(Args args) {
    extern __shared__ __attribute__((aligned(16))) unsigned char lds[];
    LAS unsigned char* const ldsl = (LAS unsigned char*)lds;
    volatile LAS unsigned* const MISC = (volatile LAS unsigned*)(ldsl + MISC_OFF);
    const int tid = threadIdx.x, lane = tid & 63, wave = __builtin_amdgcn_readfirstlane(tid >> 6);
    const int G = gridDim.x; const int vcu = (G % 8 == 0) ? ((int)blockIdx.x % 8) * (G / 8) + (int)blockIdx.x / 8 : (int)blockIdx.x;
    unsigned char* const ws = args.ws;
    gu32* const ctl = (gu32*)(ws + WS_CTL);
    for (int u = tid; u < (LDS_BYTES - LDSCTL_OFF) / 4; u += NWAVES * 64) ((LAS unsigned*)(ldsl + LDSCTL_OFF))[u] = 0u;
    __syncthreads();
#if MK_PER_PHASE
    XcdBarrier bar; bar.bar = (unsigned*)(ctl + CW_BAR); bar.x = 0; bar.st = nullptr; (void)bar;
#define GRID_BAR() do { } while (0)
#else
    XcdBarrier bar = xcd_barrier_post((unsigned*)(ctl + CW_BAR), MISC + 8);
#define GRID_BAR() xcd_barrier(bar)
#endif
    const int lo = args.ph_lo, hi = args.ph_hi;
#define IN(k) (lo <= (k) && (k) < hi)
#define PHASE_LOCAL_IDS int tid_ph_ = (int)threadIdx.x; asm volatile("" : "+v"(tid_ph_)); const int tid = tid_ph_, lane = tid & 63; (void)tid; (void)lane
#define SEAM(k) do { if (IN((k) + 1)) GRID_BAR(); } while (0)
    const int gw = vcu * NWAVES + wave, NGW = G * NWAVES;
    bf16* const HB = (bf16*)(ws + WS_XN);

    if (IN(0)) { PHASE_LOCAL_IDS;
        LAS float* scr = (LAS float*)(ldsl + wave * 16640);
        LAS float* scl = (LAS float*)(ldsl + 139264);
        if (wave == 0) { const float c0 = w_clip(args.in[I_EV_W_IN], nullptr, N_IN0, nullptr, lane), c1 = w_clip(args.in[I_EV_W_GATE], args.in[I_EV_W_UP], FF, args.in[I_EV_FFN_NORM], lane),
                                     c2 = w_clip(args.in[I_OD_W_IN], nullptr, N_IN1, args.in[I_OD_ATTN_NORM], lane), c3 = w_clip_experts(args.in[I_OD_W_GATE], args.in[I_OD_W_UP], DM, FF, args.in[I_OD_FFN_NORM], lane),
                                     c4 = w8_scale_experts(args.in[I_OD_W_DOWN], FF, DM, lane);
            if (lane == 0) { scl[0] = c0; scl[1] = c1; scl[2] = c2; scl[3] = c3; scl[4] = c4;
                if (blockIdx.x == 0) { float* t = (float*)(ws + WS_SCL); t[0] = c0; t[1] = c1; t[2] = c2; t[3] = c3; t[4] = c4; } } }
        __syncthreads();
        const float clip_in0 = scl[0], clip_gu0 = scl[1], clip_in1 = scl[2], clip_gu1 = scl[3], scale_d1 = scl[4];
        { const float qsi = 127.f / clip_in0;
          tr_matrix(args.in[I_EV_W_IN], DM, N_IN0, 1, 0, (bf16*)(ws + WS_WIN0), 0, scr, gw, NGW, lane, nullptr, 2, qsi);
          tr_matrix(args.in[I_EV_W_IN], DM, N_IN0, 1, 0, (bf16*)(ws + WS_WIN0), 0, scr, gw, NGW, lane, nullptr, 0, 0.f, 64); }
        tr_matrix(args.in[I_EV_W_UQ], 512, 1536, 1, 0, (bf16*)(ws + WS_WUQ), 3, scr, gw, NGW, lane);
        tr_matrix(args.in[I_EV_W_UKV], 512, 2048, 1, 0, (bf16*)(ws + WS_WUKV), 0, scr, gw, NGW, lane);
        tr_matrix(args.in[I_EV_W_OUT], DM, DM, 1, 0, (bf16*)(ws + WS_WOUT0), 0, scr, gw, NGW, lane);
        const float qs0 = 127.f / clip_gu0;
        tr_matrix(args.in[I_EV_W_GATE], DM, FF, 1, 0, (bf16*)(ws + WS_WGU0), 1, scr, gw, NGW, lane, args.in[I_EV_FFN_NORM], 2, qs0);
        tr_matrix(args.in[I_EV_W_UP], DM, FF, 1, 0, (bf16*)(ws + WS_WGU0), 2, scr, gw, NGW, lane, args.in[I_EV_FFN_NORM], 2, qs0);
        tr_matrix(args.in[I_EV_W_DOWN], FF, DM, 1, 0, (bf16*)(ws + WS_WD0), 0, scr, gw, NGW, lane);
        { const float qsi = 127.f / clip_in1;
          tr_matrix(args.in[I_OD_W_IN], DM, N_IN1, 1, 0, (bf16*)(ws + WS_WIN1), 0, scr, gw, NGW, lane, args.in[I_OD_ATTN_NORM], 2, qsi);
          tr_matrix(args.in[I_OD_W_IN], DM, N_IN1, 1, 0, (bf16*)(ws + WS_WIN1), 0, scr, gw, NGW, lane, args.in[I_OD_ATTN_NORM], 0, 0.f, 96); }
        tr_matrix(args.in[I_OD_W_OUT], DM, DM, 1, 0, (bf16*)(ws + WS_WOUT1), 0, scr, gw, NGW, lane);
        const float qs1 = 127.f / clip_gu1;
        tr_matrix(args.in[I_OD_W_GATE], DM, FF, NE, 2 * FF, (bf16*)(ws + WS_WGU1), 1, scr, gw, NGW, lane, args.in[I_OD_FFN_NORM], 2, qs1);
        tr_matrix(args.in[I_OD_W_UP], DM, FF, NE, 2 * FF, (bf16*)(ws + WS_WGU1), 2, scr, gw, NGW, lane, args.in[I_OD_FFN_NORM], 2, qs1);
        tr_matrix(args.in[I_OD_W_DOWN], FF, DM, NE, DM, (bf16*)(ws + WS_WD1), 0, scr, gw, NGW, lane, nullptr, 1, scale_d1);
        { const int gt = gw * 64 + lane, NGT = NGW * 64;
          GAS v4u* z0 = (GAS v4u*)((bf16*)(ws + WS_WIN0) + (size_t)N_IN0 * DM); const int n0 = (N_IN0P - N_IN0) * DM / 8;
          for (int i = gt; i < n0; i += NGT) z0[i] = (v4u){0u, 0u, 0u, 0u};
          GAS v4u* z1 = (GAS v4u*)((bf16*)(ws + WS_WIN1) + (size_t)(N_IN1 + 16) * DM); const int n1 = (N_IN1P - N_IN1 - 16) * DM / 8;
          for (int i = gt; i < n1; i += NGT) z1[i] = (v4u){0u, 0u, 0u, 0u};
          float* cs = (float*)(ws + WS_ROPE);
          for (int i = gt; i < S * 32; i += NGT) { const int pos = i >> 5, k = i & 31; const float ang = (float)pos * ROPE_INV[k]; float sn, c; sincos_d(ang, sn, c); cs[pos * 64 + k] = c; cs[pos * 64 + 32 + k] = sn; }
        }
        { const float wsc0 = clip_in0 * (1.f / 127.f);
          for (int m = gw; m < S; m += NGW) rms_row_bf16(args.in[I_X] + (size_t)m * DM, args.in[I_EV_ATTN_NORM], (bf16*)(ws + WS_XN) + (size_t)m * DM, 1e-6f, lane, ws + WS_A8 + (size_t)m * DM, (float*)(ws + WS_RSTDS) + m, wsc0); }
        SEAM(0);
    }
    if (IN(1)) { PHASE_LOCAL_IDS;
        { pg8::Gemm g{(const bf16*)(ws + WS_A8), (const bf16*)(ws + WS_WIN0), S, NP0, DM / 2, DM / 2}; pg8::StaticOrder so; so.init(S, NP0, G, (int)blockIdx.x);
          pg8::EpiBf16Row E{(bf16*)(ws + WS_PROJ0), NP0, (const float*)(ws + WS_RSTDS)};
          pg8::gemm_phase<pg8::EpiBf16Row, pg8::StaticOrder, true, true, 2>(ldsl, g, so, E); }
        __syncthreads();
        { pg8::Gemm g{(const bf16*)(ws + WS_XN), (const bf16*)(ws + WS_WIN0), S, 256, 512, DM}; pg8::SplitKOrder so{G, (int)blockIdx.x, 16, 1024};
          pg8::EpiPartF32 E{(float*)(ws + WS_KPART), 64, 1024, S, nullptr};
          pg8::gemm_phase<pg8::EpiPartF32, pg8::SplitKOrder, true, true>(ldsl, g, so, E); }
        SEAM(1);
    }
    if (IN(2)) { PHASE_LOCAL_IDS;
        const bf16* proj = (const bf16*)(ws + WS_PROJ0); const float* cs = (const float*)(ws + WS_ROPE); bf16* Kf = (bf16*)(ws + WS_KF);
        LAS float* sm = (LAS float*)ldsl; float* statA = (float*)(ws + WS_STATA);
        for (int c = (int)blockIdx.x; c < 256; c += G) { float qmax = 0.f, kmax = 0.f;
            for (int i = 0; i < 8; ++i) { const int m = 64 * c + 8 * wave + i; const bf16* prow = proj + (size_t)m * NP0;
                rms512_bf16(prow + 3072, args.in[I_EV_Q_NORM], (bf16*)(ws + WS_CQN) + (size_t)m * 512, lane);
                rms512_bf16(prow + 3584, args.in[I_EV_KV_NORM], (bf16*)(ws + WS_CKVN) + (size_t)m * 512, lane);
                if (lane < 32) { const float* kp = (const float*)(ws + WS_KPART) + (size_t)m * 64 + lane; const size_t kq = (size_t)S * 64;
                    const float x1 = (kp[0] + kp[kq]) + (kp[2 * kq] + kp[3 * kq]), x2 = (kp[32] + kp[kq + 32]) + (kp[2 * kq + 32] + kp[3 * kq + 32]); const float cc = cs[m * 64 + lane], sn = cs[m * 64 + 32 + lane];
                    const bf16 o1 = (bf16)f2bf(x1 * cc - x2 * sn), o2 = (bf16)f2bf(x2 * cc + x1 * sn); bf16* kr = Kf + (size_t)m * 2560 + 128 + lane;
#pragma unroll
                    for (int h = 0; h < 8; ++h) { kr[h * 320] = o1; kr[h * 320 + 32] = o2; } }
                { const v4u a0 = *(const GAS v4u*)(prow + 16 * lane), a1 = *(const GAS v4u*)(prow + 16 * lane + 8), b0 = *(const GAS v4u*)(prow + 1024 + 16 * lane), b1 = *(const GAS v4u*)(prow + 1024 + 16 * lane + 8);
                  float sq = 0.f, sk = 0.f;
#pragma unroll
                  for (int e = 0; e < 4; ++e) { sq += bflo(a0[e]) * bflo(a0[e]) + bfhi(a0[e]) * bfhi(a0[e]) + bflo(a1[e]) * bflo(a1[e]) + bfhi(a1[e]) * bfhi(a1[e]);
                                                sk += bflo(b0[e]) * bflo(b0[e]) + bfhi(b0[e]) * bfhi(b0[e]) + bflo(b1[e]) * bflo(b1[e]) + bfhi(b1[e]) * bfhi(b1[e]); }
                  sq += __shfl_xor(sq, 1); sq += __shfl_xor(sq, 2); sk += __shfl_xor(sk, 1); sk += __shfl_xor(sk, 2); qmax = fmaxf(qmax, sq); kmax = fmaxf(kmax, sk); } }
            if ((lane & 3) == 0) { sm[wave * 32 + (lane >> 2)] = qmax; sm[wave * 32 + 16 + (lane >> 2)] = kmax; }
            __syncthreads();
            if (tid < 32) { float v = 0.f; for (int q = 0; q < 8; ++q) v = fmaxf(v, sm[q * 32 + tid]); statA[c * 32 + tid] = v; }
            __syncthreads(); }
        SEAM(2);
    }
    if (IN(3)) { PHASE_LOCAL_IDS;
        { pg8::Gemm g{(const bf16*)(ws + WS_CQN), (const bf16*)(ws + WS_WUQ), S, 1536, 512}; pg8::StaticOrder so; so.init(S, 1536, G, (int)blockIdx.x);
          pg8::EpiQRope E{(bf16*)(ws + WS_QB), (const float*)(ws + WS_ROPE)};
          pg8::gemm_phase<pg8::EpiQRope, pg8::StaticOrder, true, true>(ldsl, g, so, E); }
        __syncthreads();
        { pg8::Gemm g{(const bf16*)(ws + WS_CKVN), (const bf16*)(ws + WS_WUKV), S, 2048, 512}; pg8::StaticOrder so; so.init(S, 2048, G, (int)blockIdx.x);
          pg8::EpiKV E{(bf16*)(ws + WS_KF)};
          pg8::gemm_phase<pg8::EpiKV, pg8::StaticOrder, true, true>(ldsl, g, so, E); }
        SEAM(3);
    }
    if (IN(4)) { PHASE_LOCAL_IDS;
        const int nit = (vcu < 256) ? (256 - vcu + G - 1) / G : 0;
        { volatile LAS unsigned* slot = (volatile LAS unsigned*)(ldsl + LDSCTL_OFF);
          const int nb = build_list<0>(ldsl, slot, (const float*)(ws + WS_STATA), nullptr, SCALE_A, vcu, G, tid);
          DecAL d{(const bf16*)(ws + WS_PROJ0), (bf16*)(ws + WS_OA), (volatile LAS unsigned*)(ldsl + KEYS_OFF)}; att::stream_dyn<BodyA, DecAL>((char*)lds, nb, (unsigned*)(ctl + CW_QA), slot, d, SCALE_A); }
        __syncthreads();
        { DecB d{(const bf16*)(ws + WS_QB), (const bf16*)(ws + WS_KF), (bf16*)(ws + WS_MIX), vcu, G}; att::stream<BodyB, DecB>((char*)lds, 2 * nit, d, SCALE_B); }
        SEAM(4);
    }
    if (IN(5)) { PHASE_LOCAL_IDS;
        const float a1 = wave_sum(args.in[I_EV_LQ1][lane] * args.in[I_EV_LK1][lane]), a2 = wave_sum(args.in[I_EV_LQ2][lane] * args.in[I_EV_LK2][lane]);
        const float lam = expf(a1) - expf(a2) + 0.2f;
        const bf16* OA = (const bf16*)(ws + WS_OA); bf16* MIX = (bf16*)(ws + WS_MIX); const int h = lane >> 3, d0 = (lane & 7) * 16;
        f32x4 sg[4];
#pragma unroll
        for (int q = 0; q < 4; ++q) sg[q] = *(const GAS f32x4*)(args.in[I_EV_SUBLN] + d0 + 4 * q) * 0.8f;
        for (int m = gw; m < S; m += NGW) { const bf16* p0 = OA + (size_t)m * 2048 + (2 * h) * 128 + d0; f32x4 d[4]; float ss = 0.f;
            const v4u a0 = *(const GAS v4u*)p0, a1 = *(const GAS v4u*)(p0 + 8), b0 = *(const GAS v4u*)(p0 + 128), b1 = *(const GAS v4u*)(p0 + 136);
            d[0] = (f32x4){bflo(a0.x) - lam * bflo(b0.x), bfhi(a0.x) - lam * bfhi(b0.x), bflo(a0.y) - lam * bflo(b0.y), bfhi(a0.y) - lam * bfhi(b0.y)};
            d[1] = (f32x4){bflo(a0.z) - lam * bflo(b0.z), bfhi(a0.z) - lam * bfhi(b0.z), bflo(a0.w) - lam * bflo(b0.w), bfhi(a0.w) - lam * bfhi(b0.w)};
            d[2] = (f32x4){bflo(a1.x) - lam * bflo(b1.x), bfhi(a1.x) - lam * bfhi(b1.x), bflo(a1.y) - lam * bflo(b1.y), bfhi(a1.y) - lam * bfhi(b1.y)};
            d[3] = (f32x4){bflo(a1.z) - lam * bflo(b1.z), bfhi(a1.z) - lam * bfhi(b1.z), bflo(a1.w) - lam * bflo(b1.w), bfhi(a1.w) - lam * bfhi(b1.w)};
#pragma unroll
            for (int q = 0; q < 4; ++q) ss += (d[q].x * d[q].x + d[q].y * d[q].y) + (d[q].z * d[q].z + d[q].w * d[q].w);
            ss += __shfl_xor(ss, 1); ss += __shfl_xor(ss, 2); ss += __shfl_xor(ss, 4);
            const float rstd = 1.0f / sqrtf(ss * (1.f / 128.f) + 1e-5f);
            v4u o0, o1; { const f32x4 y0 = d[0] * rstd * sg[0], y1 = d[1] * rstd * sg[1], y2 = d[2] * rstd * sg[2], y3 = d[3] * rstd * sg[3];
              o0.x = pk2(y0.x, y0.y); o0.y = pk2(y0.z, y0.w); o0.z = pk2(y1.x, y1.y); o0.w = pk2(y1.z, y1.w); o1.x = pk2(y2.x, y2.y); o1.y = pk2(y2.z, y2.w); o1.z = pk2(y3.x, y3.y); o1.w = pk2(y3.z, y3.w); }
            GAS v4u* dst = (GAS v4u*)(MIX + (size_t)m * 2048 + h * 128 + d0); dst[0] = o0; dst[1] = o1; }
        SEAM(5);
    }
    if (IN(6)) { PHASE_LOCAL_IDS;
        pg8::Gemm g{(const bf16*)(ws + WS_MIX), (const bf16*)(ws + WS_WOUT0), S, DM, DM}; pg8::StaticOrder so; so.init(S, DM, G, (int)blockIdx.x);
        pg8::EpiResB<true> E{args.in[I_X], HB, (float*)(ws + WS_PS), DM};
        pg8::gemm_phase<pg8::EpiResB<true>, pg8::StaticOrder, true, true>(ldsl, g, so, E);
        SEAM(6);
    }
    if (IN(7)) { PHASE_LOCAL_IDS;
        rows_i8(HB, (const float*)(ws + WS_PS), (float*)(ws + WS_RSTD), ws + WS_A8, (float*)(ws + WS_RSTDS), ((const float*)(ws + WS_SCL))[1] * (1.f / 127.f), gw, NGW, lane);
        SEAM(7);
    }
    if (IN(8)) { PHASE_LOCAL_IDS;
        pg8::Gemm g{(const bf16*)(ws + WS_A8), (const bf16*)(ws + WS_WGU0), S, 2 * FF, DM / 2, DM / 2}; pg8::StaticOrder so; so.init(S, 2 * FF, G, (int)blockIdx.x);
        pg8::EpiSwiGLU<false> E{(bf16*)(ws + WS_HMID0), FF, 2 * FF / 256, (const float*)(ws + WS_RSTDS), 1.f};
        pg8::gemm_phase<pg8::EpiSwiGLU<false>, pg8::StaticOrder, true, true, 2>(ldsl, g, so, E);
        SEAM(8);
    }
    if (IN(9)) { PHASE_LOCAL_IDS;
        pg8::Gemm g{(const bf16*)(ws + WS_HMID0), (const bf16*)(ws + WS_WD0), S, DM, FF}; pg8::StaticOrder so; so.init(S, DM, G, (int)blockIdx.x);
        pg8::EpiResB<false> E{nullptr, HB, (float*)(ws + WS_PS), DM};
        pg8::gemm_phase<pg8::EpiResB<false>, pg8::StaticOrder, true, true>(ldsl, g, so, E);
        SEAM(9);
    }
    if (IN(10)) { PHASE_LOCAL_IDS;
        rows_i8(HB, (const float*)(ws + WS_PS), (float*)(ws + WS_RSTD), ws + WS_A8, (float*)(ws + WS_RSTDS), ((const float*)(ws + WS_SCL))[2] * (1.f / 127.f), gw, NGW, lane);
        SEAM(10);
    }
    if (IN(11)) { PHASE_LOCAL_IDS;
        { pg8::Gemm g{(const bf16*)(ws + WS_A8), (const bf16*)(ws + WS_WIN1), S, 6144, DM / 2, DM / 2}; pg8::StaticOrder so; so.init(S, 6144, G, (int)blockIdx.x);
          pg8::EpiBf16Row E{(bf16*)(ws + WS_QKV1), 6144, (const float*)(ws + WS_RSTDS)};
          pg8::gemm_phase<pg8::EpiBf16Row, pg8::StaticOrder, true, true, 2>(ldsl, g, so, E); }
        __syncthreads();
        { pg8::Gemm g{(const bf16*)(ws + WS_XN), (const bf16*)(ws + WS_WIN1), S, 256, 512, DM}; pg8::SplitKOrder so{G, (int)blockIdx.x, 24, 1024};
          pg8::EpiPartF32 E{(float*)(ws + WS_FPART), 16, 1024, S, (const float*)(ws + WS_RSTD)};
          pg8::gemm_phase<pg8::EpiPartF32, pg8::SplitKOrder, true, true>(ldsl, g, so, E); }
        SEAM(11);
    }
    if (IN(12)) { PHASE_LOCAL_IDS;
        float* logf = (float*)(ws + WS_LOGF); float* csum = (float*)(ws + WS_CSUM); LAS float* red = (LAS float*)ldsl;
        const bf16* qkv = (const bf16*)(ws + WS_QKV1); float* statC = (float*)(ws + WS_STATC); LAS float* sm = red + 1024;
        for (int c = (int)blockIdx.x; c < 256; c += G) { const int r = tid >> 4, h = tid & 15;
            { const float* fp = (const float*)(ws + WS_FPART); const size_t kq = (size_t)S * 16; const float fb = args.in[I_OD_FBIAS][h]; float lsum = 0.f;
#pragma unroll
              for (int rr = 0; rr < 2; ++rr) { const size_t o = (size_t)(64 * c + 32 * rr + r) * 16 + h; const float x = ((fp[o] + fp[o + kq]) + (fp[o + 2 * kq] + fp[o + 3 * kq])) + fb;
                  const float ls = fminf(x, 0.f) - log1pf(__expf(-fabsf(x))); logf[o] = ls; lsum += ls; }
              red[r * 16 + h] = lsum; }
            float qmax = 0.f, kmax = 0.f;
            for (int i = 0; i < 8; ++i) { const bf16* prow = qkv + (size_t)(64 * c + 8 * wave + i) * 6144 + 32 * lane; float sq = 0.f, sk = 0.f;
#pragma unroll
                for (int j = 0; j < 4; ++j) { const v4u a = *(const GAS v4u*)(prow + 8 * j), b = *(const GAS v4u*)(prow + 2048 + 8 * j);
#pragma unroll
                    for (int e = 0; e < 4; ++e) { sq += bflo(a[e]) * bflo(a[e]) + bfhi(a[e]) * bfhi(a[e]); sk += bflo(b[e]) * bflo(b[e]) + bfhi(b[e]) * bfhi(b[e]); } }
                sq += __shfl_xor(sq, 1); sq += __shfl_xor(sq, 2); sk += __shfl_xor(sk, 1); sk += __shfl_xor(sk, 2); qmax = fmaxf(qmax, sq); kmax = fmaxf(kmax, sk); }
            if ((lane & 3) == 0) { sm[wave * 32 + (lane >> 2)] = qmax; sm[wave * 32 + 16 + (lane >> 2)] = kmax; }
            __syncthreads();
            if (tid < 16) { float s = 0.f; for (int q = 0; q < 32; ++q) s += red[q * 16 + tid]; csum[c * 16 + tid] = s; }
            if (tid < 32) { float v = 0.f; for (int q = 0; q < 8; ++q) v = fmaxf(v, sm[q * 32 + tid]); statC[c * 32 + tid] = v; }
            __syncthreads(); }
        SEAM(12);
    }
    if (IN(13)) { PHASE_LOCAL_IDS;
        const float* logf = (const float*)(ws + WS_LOGF); const float* csum = (const float*)(ws + WS_CSUM); float* kbC = (float*)(ws + WS_KBC);
        LAS float* red = (LAS float*)ldsl; LAS float* pre = red + 512; LAS float* val = red + 1024;
        for (int c = (int)blockIdx.x; c < 256; c += G) { const int part = tid >> 4, h = tid & 15;
            { float s = 0.f; for (int cc = part; cc < c; cc += 32) s += csum[cc * 16 + h]; red[part * 16 + h] = s; }
            val[tid] = logf[(size_t)(64 * c) * 16 + tid]; val[512 + tid] = logf[(size_t)(64 * c) * 16 + 512 + tid];
            __syncthreads();
            if (tid < 16) { float s = 0.f; for (int q = 0; q < 32; ++q) s += red[q * 16 + tid]; pre[tid] = s; }
            __syncthreads();
            if (tid < 16) { float run = pre[tid]; for (int r = 0; r < 64; ++r) { run += val[r * 16 + tid]; val[r * 16 + tid] = run; } }
            __syncthreads();
            { const int r = tid & 63, hh = tid >> 6; kbC[(size_t)hh * S + 64 * c + r] = val[r * 16 + hh] * (-1.0f / SCALE_C); kbC[(size_t)(hh + 8) * S + 64 * c + r] = val[r * 16 + hh + 8] * (-1.0f / SCALE_C); }
            __syncthreads(); }
        SEAM(13);
    }
    if (IN(14)) { PHASE_LOCAL_IDS;
        volatile LAS unsigned* slot = (volatile LAS unsigned*)(ldsl + LDSCTL_OFF);
        const int nb = build_list<1>(ldsl, slot, (const float*)(ws + WS_STATC), (const float*)(ws + WS_KBC), SCALE_C, vcu, G, tid);
        DecCL d{(const bf16*)(ws + WS_QKV1), (bf16*)(ws + WS_O1), (const float*)(ws + WS_KBC), (volatile LAS unsigned*)(ldsl + KEYS_OFF)}; att::stream_dyn<BodyC, DecCL>((char*)lds, nb, (unsigned*)(ctl + CW_QC), slot, d, SCALE_C);
        SEAM(14);
    }
    if (IN(15)) { PHASE_LOCAL_IDS;
        pg8::Gemm g{(const bf16*)(ws + WS_O1), (const bf16*)(ws + WS_WOUT1), S, DM, DM}; pg8::StaticOrder so; so.init(S, DM, G, (int)blockIdx.x);
        pg8::EpiResB<false> E{nullptr, HB, (float*)(ws + WS_PS), DM};
        pg8::gemm_phase<pg8::EpiResB<false>, pg8::StaticOrder, true, true>(ldsl, g, so, E);
        SEAM(15);
    }
    if (IN(16)) { PHASE_LOCAL_IDS;
        LAS float* rt = (LAS float*)ldsl; LAS unsigned* cnt = (LAS unsigned*)(ldsl + 65536);
        for (int idx = tid; idx < DM * NE; idx += NWAVES * 64) { const int k = idx >> 3, e = idx & 7; rt[e * DM + k] = args.in[I_OD_ROUTER][idx]; }
        __syncthreads();
        const GAS f32x4* gr = (const GAS f32x4*)args.in[I_OD_FFN_NORM] + lane;
        for (int c = (int)blockIdx.x; c < 256; c += G) {
            if (tid < 8) cnt[tid] = 0u;
            __syncthreads();
            for (int i = 0; i < 8; ++i) { const int row = 64 * c + 8 * wave + i;
                const GAS v2u* xr = (const GAS v2u*)(HB + (size_t)row * DM) + lane; f32x4 v[8]; float s = 0.f;
#pragma unroll
                for (int j = 0; j < 8; ++j) { const v2u a = xr[64 * j]; v[j] = (f32x4){bflo(a.x), bfhi(a.x), bflo(a.y), bfhi(a.y)}; s += (v[j].x * v[j].x + v[j].y * v[j].y) + (v[j].z * v[j].z + v[j].w * v[j].w); }
                const float rstd = 1.0f / sqrtf(wave_sum(s) * (1.f / DM) + 1e-6f);
#pragma unroll
                for (int j = 0; j < 8; ++j) { const f32x4 gg = gr[64 * j]; v[j] = (v[j] * rstd) * gg; }
                if (lane == 0) ((float*)(ws + WS_RSTD))[row] = rstd;
                float lg[8];
#pragma unroll
                for (int e = 0; e < 8; ++e) { float a = 0.f;
#pragma unroll
                    for (int j = 0; j < 8; ++j) { const f32x4 w = *(const LAS f32x4*)(rt + e * DM + 4 * lane + 256 * j); a += (v[j].x * w.x + v[j].y * w.y) + (v[j].z * w.z + v[j].w * w.w); }
                    lg[e] = wave_sum(a); }
                int e1 = 0; float l1 = lg[0];
#pragma unroll
                for (int e = 1; e < 8; ++e) if (lg[e] > l1) { l1 = lg[e]; e1 = e; }
                int e2 = -1; float l2 = -__builtin_inff();
#pragma unroll
                for (int e = 0; e < 8; ++e) if (e != e1 && lg[e] > l2) { l2 = lg[e]; e2 = e; }
                const float g1 = 1.0f / (1.0f + expf(l2 - l1)), g2 = 1.0f - g1;
                if (lane == 0) { *(GAS v4u*)(ws + WS_ROUTE + (size_t)row * 16) = (v4u){(unsigned)e1, (unsigned)e2, __builtin_bit_cast(unsigned, g1), __builtin_bit_cast(unsigned, g2)};
                    __hip_atomic_fetch_add(cnt + e1, 1u, __ATOMIC_RELAXED, __HIP_MEMORY_SCOPE_WORKGROUP); __hip_atomic_fetch_add(cnt + e2, 1u, __ATOMIC_RELAXED, __HIP_MEMORY_SCOPE_WORKGROUP); } }
            __syncthreads();
            if (tid < 8) ((unsigned*)(ws + WS_CNTG))[c * 8 + tid] = cnt[tid];
            __syncthreads(); }
        SEAM(16);
    }
    if (IN(17)) { PHASE_LOCAL_IDS;
        const unsigned* cntg = (const unsigned*)(ws + WS_CNTG); LAS unsigned* red = (LAS unsigned*)ldsl; LAS unsigned* red2 = red + 512; LAS unsigned* T = red + 1024; LAS unsigned* P = red + 1032;
        LAS unsigned* st = red + 1040; LAS unsigned* rl = red + 1056; LAS unsigned* posl = red + 1056 + 256;
        bf16* As = (bf16*)(ws + WS_AS); float* gates = (float*)(ws + WS_GATES); unsigned* tokpos = (unsigned*)(ws + WS_TOKPOS);
        const float gsc = 1.0f / (((const float*)(ws + WS_SCL))[4] * H8_SCALE);
        const float wsc1 = ((const float*)(ws + WS_SCL))[3] * (1.f / 127.f);
        for (int c = (int)blockIdx.x; c < 256; c += G) {
            { const int e = tid & 7, part = tid >> 3; unsigned tot = 0u, pre = 0u; for (int cc = part; cc < 256; cc += 64) { const unsigned x = cntg[cc * 8 + e]; tot += x; if (cc < c) pre += x; } red[part * 8 + e] = tot; red2[part * 8 + e] = pre; }
            if (tid < 64) { const v4u r = *(const GAS v4u*)(ws + WS_ROUTE + (size_t)(64 * c + tid) * 16); rl[tid * 4 + 0] = r.x; rl[tid * 4 + 1] = r.y; rl[tid * 4 + 2] = r.z; rl[tid * 4 + 3] = r.w; }
            __syncthreads();
            if (tid < 8) { unsigned a = 0u, b = 0u; for (int q = 0; q < 64; ++q) { a += red[q * 8 + tid]; b += red2[q * 8 + tid]; } T[tid] = a; P[tid] = b; }
            __syncthreads();
            if (tid < 8) { unsigned s0 = 0u; for (int e = 0; e < tid; ++e) s0 += (T[e] + 255u) & ~255u; st[tid] = s0;
                unsigned run = s0 + P[tid]; for (int r = 0; r < 64; ++r) { if (rl[r * 4 + 0] == (unsigned)tid) posl[r * 2 + 0] = run++; if (rl[r * 4 + 1] == (unsigned)tid) posl[r * 2 + 1] = run++; }
                if (c == 0) ((unsigned*)(ws + WS_TOT))[tid] = T[tid]; }
            __syncthreads();
            for (int i = 0; i < 8; ++i) { const int r = 8 * wave + i, row = 64 * c + r; const GAS v4u* src = (const GAS v4u*)((const bf16*)(ws + WS_XN) + (size_t)row * DM) + lane;
                const v4u x[4] = {src[0], src[64], src[128], src[192]}; const float rs = ((const float*)(ws + WS_RSTD))[row];
                float am = 0.f;
#pragma unroll
                for (int j = 0; j < 4; ++j) { am = fmaxf(am, fmaxf(fmaxf(fabsf(bflo(x[j].x)), fabsf(bfhi(x[j].x))), fmaxf(fabsf(bflo(x[j].y)), fabsf(bfhi(x[j].y))))); am = fmaxf(am, fmaxf(fmaxf(fabsf(bflo(x[j].z)), fabsf(bfhi(x[j].z))), fmaxf(fabsf(bflo(x[j].w)), fabsf(bfhi(x[j].w))))); }
#pragma unroll
                for (int o = 32; o > 0; o >>= 1) am = fmaxf(am, __shfl_xor(am, o));
                am = fmaxf(am, 1e-30f); const float qs = 127.f / am, rowf = (am * (1.f / 127.f)) * rs * wsc1;
                v2u q[4];
#pragma unroll
                for (int j = 0; j < 4; ++j) { q[j].x = pki8x4(bflo(x[j].x) * qs, bfhi(x[j].x) * qs, bflo(x[j].y) * qs, bfhi(x[j].y) * qs); q[j].y = pki8x4(bflo(x[j].z) * qs, bfhi(x[j].z) * qs, bflo(x[j].w) * qs, bfhi(x[j].w) * qs); }
                const v2u q0 = q[0], q1 = q[1], q2 = q[2], q3 = q[3];
#pragma unroll
                for (int sl = 0; sl < 2; ++sl) { const unsigned p = posl[r * 2 + sl]; GAS v2u* dst = (GAS v2u*)((unsigned char*)As + (size_t)p * DM) + lane; dst[0] = q0; dst[64] = q1; dst[128] = q2; dst[192] = q3;
                    if (lane == 0) { gates[p] = __builtin_bit_cast(float, rl[r * 4 + 2 + sl]) * gsc; tokpos[row * 2 + sl] = p; ((float*)(ws + WS_RSTDS))[p] = rowf;   } } }
            { const unsigned e = (unsigned)wave, te = T[e], pad = ((te + 255u) & ~255u) - te;
              if ((unsigned)c < pad) { const unsigned p = st[e] + te + (unsigned)c; GAS v2u* dst = (GAS v2u*)((unsigned char*)As + (size_t)p * DM) + lane; const v2u z = (v2u){0u, 0u}; dst[0] = z; dst[64] = z; dst[128] = z; dst[192] = z; if (lane == 0) { gates[p] = 0.f; ((float*)(ws + WS_RSTDS))[p] = 0.f; } } }
            __syncthreads(); }
        SEAM(17);
    }
    if (IN(18)) { PHASE_LOCAL_IDS;
        pg8::Gemm g{(const bf16*)(ws + WS_AS), (const bf16*)(ws + WS_WGU1), MPAD, NE * 2 * FF, DM / 2, DM / 2}; pg8::GroupedOrder so; so.init((const unsigned*)(ws + WS_TOT), 2 * FF / 256, G, (int)blockIdx.x);
        pg8::EpiSwiGLU<true> E{(bf16*)(ws + WS_HMS), FF, 2 * FF / 256, (const float*)(ws + WS_RSTDS), H8_SCALE};
        pg8::gemm_phase<pg8::EpiSwiGLU<true>, pg8::GroupedOrder, true, true, 2>(ldsl, g, so, E);
        SEAM(18);
    }
    if (IN(19)) { PHASE_LOCAL_IDS;
        pg8::GroupedOrder so; so.init((const unsigned*)(ws + WS_TOT), DM / 256, G, (int)blockIdx.x);
        const int full = (so.nwg / G) * G, left = so.nwg - full; const bool halves = left > 0 && 2 * left <= G;
        if (halves) so.hi = full;
        { pg8::Gemm g{(const bf16*)(ws + WS_HMS), (const bf16*)(ws + WS_WD1), MPAD, NE * DM, FF / 2, FF / 2};
          pg8::EpiMoEDown E{(bf16*)(ws + WS_YS), (const float*)(ws + WS_GATES), DM / 256};
          pg8::gemm_phase<pg8::EpiMoEDown, pg8::GroupedOrder, true, true, 1>(ldsl, g, so, E); }
        if (halves) { __syncthreads();
          pg8::Gemm g{(const bf16*)(ws + WS_HMS), (const bf16*)(ws + WS_WD1), MPAD, NE * DM, FF / 4, FF / 2};
          pg8::GroupedSplitOrder<1> ss{so, full, 2 * left, FF / 2};
          pg8::EpiMoEDownPart E{(float*)(ws + WS_PART), (unsigned*)(ctl + CW_SPLIT), DM / 256, FF / 2};
          pg8::gemm_phase<pg8::EpiMoEDownPart, pg8::GroupedSplitOrder<1>, true, true, 1>(ldsl, g, ss, E); }
        SEAM(19);
    }
    if (IN(20)) { PHASE_LOCAL_IDS;
        const bf16* Y = (const bf16*)(ws + WS_YS); const unsigned* split = (const unsigned*)(ctl + CW_SPLIT); const float* PART = (const float*)(ws + WS_PART); const float* gates = (const float*)(ws + WS_GATES); const unsigned* tokpos = (const unsigned*)(ws + WS_TOKPOS); const GAS f32x4* gr = (const GAS f32x4*)args.in[I_FINAL_NORM] + lane;
        unsigned bad = __hip_atomic_load(ctl + CW_TMO, RLX_AGENT) | __hip_atomic_load(ctl + CW_BAR + XB_TMO, RLX_AGENT);
        for (int m = gw; m < S; m += NGW) { const unsigned p0 = tokpos[m * 2], p1 = tokpos[m * 2 + 1];
            GAS f32x4* xo = (GAS f32x4*)(args.out + (size_t)m * DM) + lane; const GAS v2u* hr = (const GAS v2u*)(HB + (size_t)m * DM) + lane; const GAS v2u* y0 = (const GAS v2u*)(Y + (size_t)p0 * DM) + lane; const GAS v2u* y1 = (const GAS v2u*)(Y + (size_t)p1 * DM) + lane;
            f32x4 v[8]; float s = 0.f;
            const v4u fa = *(const GAS v4u*)(split + (p0 >> 8) * 8), fb = *(const GAS v4u*)(split + (p0 >> 8) * 8 + 4), fc = *(const GAS v4u*)(split + (p1 >> 8) * 8), fd = *(const GAS v4u*)(split + (p1 >> 8) * 8 + 4);
            const unsigned anysplit = (fa.x | fa.y | fa.z | fa.w) | (fb.x | fb.y | fb.z | fb.w) | (fc.x | fc.y | fc.z | fc.w) | (fd.x | fd.y | fd.z | fd.w);
            if (__builtin_expect(anysplit == 0u, 1)) {
#pragma unroll
                for (int j = 0; j < 8; ++j) { const v2u a = y0[64 * j], b = y1[64 * j], hh = hr[64 * j]; v[j] = (f32x4){(bflo(hh.x) + bflo(a.x)) + bflo(b.x), (bfhi(hh.x) + bfhi(a.x)) + bfhi(b.x), (bflo(hh.y) + bflo(a.y)) + bflo(b.y), (bfhi(hh.y) + bfhi(a.y)) + bfhi(b.y)}; }
            } else {
#pragma unroll
                for (int j = 0; j < 8; ++j) { f32x4 add = (f32x4){0.f, 0.f, 0.f, 0.f};
#pragma unroll
                    for (int sl = 0; sl < 2; ++sl) { const unsigned p = sl ? p1 : p0; const unsigned xs = split[(p >> 8) * 8 + j];
                        if (xs) { const GAS f32x4* q = (const GAS f32x4*)(PART + ((size_t)(xs - 1u) << 18) + (size_t)(p & 255u) * 256) + lane; add = add + (q[0] + q[16384]) * gates[p]; }
                        else { const v2u a = (sl ? y1 : y0)[64 * j]; add = add + (f32x4){bflo(a.x), bfhi(a.x), bflo(a.y), bfhi(a.y)}; } }
                    { const v2u hh = hr[64 * j]; v[j] = (f32x4){bflo(hh.x), bfhi(hh.x), bflo(hh.y), bfhi(hh.y)} + add; } }
            }
#pragma unroll
            for (int j = 0; j < 8; ++j) s += (v[j].x * v[j].x + v[j].y * v[j].y) + (v[j].z * v[j].z + v[j].w * v[j].w);
            float rstd = 1.0f / sqrtf(wave_sum(s) * (1.f / DM) + 1e-6f); if (bad) rstd = __builtin_nanf("");
#pragma unroll
            for (int j = 0; j < 8; ++j) xo[64 * j] = (v[j] * rstd) * gr[64 * j]; }
    }
#undef IN
#undef SEAM
#undef GRID_BAR
}

extern "C" void kernel_launch(void* const* d_in, const int* in_sizes, int n_in, void* d_out, int out_size, void* d_ws, size_t ws_size, hipStream_t stream) {
    static int grid = 0;
    if (grid == 0) {
        if (n_in != 27 || in_sizes[0] != S * DM || out_size != S * DM || ws_size < WS_END) { fprintf(stderr, "kernel_launch: shape/workspace mismatch (n_in %d, in0 %d, out %d, ws %zu, need %zu); nothing launched\n", n_in, n_in > 0 ? in_sizes[0] : -1, out_size, ws_size, (size_t)WS_END); grid = -1; return; }
        int dev = 0, cus = 0, per_cu = 0;
        if (hipGetDevice(&dev) != hipSuccess || hipDeviceGetAttribute(&cus, hipDeviceAttributeMultiprocessorCount, dev) != hipSuccess) { fprintf(stderr, "kernel_launch: device query failed\n"); grid = -1; return; }
        if (hipFuncSetAttribute((const void*)mk_fwd, hipFuncAttributeMaxDynamicSharedMemorySize, LDS_BYTES) != hipSuccess) { fprintf(stderr, "kernel_launch: hipFuncSetAttribute failed\n"); grid = -1; return; }
        if (hipOccupancyMaxActiveBlocksPerMultiprocessor(&per_cu, (const void*)mk_fwd, NWAVES * 64, LDS_BYTES) != hipSuccess || per_cu < 1) fprintf(stderr, "kernel_launch: note: occupancy query reports %d workgroups per CU\n", per_cu);
        (void)hipGetLastError();
        grid = cus;
    }
    if (grid < 0) return;
    if (hipMemsetAsync((char*)d_ws + WS_CTL, 0, CTL_ZERO_BYTES, stream) != hipSuccess) { fprintf(stderr, "kernel_launch: hipMemsetAsync failed\n"); return; }
    Args a{};
    for (int i = 0; i < 27; ++i) a.in[i] = (const float*)d_in[i];
    a.out = (float*)d_out; a.ws = (unsigned char*)d_ws;
#if MK_PER_PHASE
#ifndef MK_PROBE_MASK
#define MK_PROBE_MASK 0
#endif
    for (int p = 0; p < NPH; ++p) { a.ph_lo = p; a.ph_hi = p + 1; const int reps = ((MK_PROBE_MASK >> p) & 1) ? 5 : 1;
        for (int r = 0; r < reps; ++r) hipLaunchKernelGGL(mk_fwd, dim3(grid), dim3(NWAVES * 64), LDS_BYTES, stream, a); }
#else
    a.ph_lo = 0; a.ph_hi = NPH; hipLaunchKernelGGL(mk_fwd, dim3(grid), dim3(NWAVES * 64), LDS_BYTES, stream, a);
#endif
    const hipError_t le = hipPeekAtLastError();
    if (le != hipSuccess) fprintf(stderr, "kernel_launch: launch failed: %s\n", hipGetErrorName(le));
}
```
